# Optimizing an MI355X kernel written in HIP

```python
import jax
import jax.numpy as jnp
from jax import lax
import numpy as np

D_MODEL = 1024
BATCH = 8
SEQ = 4096
DEPTH = 4

HEAD_DIM = 64
SB_HEADS = 8
SB_BLOCK = 128
NSA_HEADS = 8
NSA_KV_GROUPS = 2
NSA_GROUP = NSA_HEADS // NSA_KV_GROUPS
CMP_BLOCK = 32
CMP_HIDDEN = 128
SEL_BLOCK = 64
N_SEL = 16
WINDOW = 512
NSA_BLOCK = 64
N_EXPERTS = 32
TOP_K = 4
D_FF = 1024
SWIGLU_ALPHA = 1.702
SWIGLU_LIMIT = 7.0
PLE_DIM = 256
LN_EPS = 1e-5
DN_ALPHA = (2 * DEPTH) ** 0.25
DN_BETA = (8 * DEPTH) ** -0.25
NEG_INF = -1e30
FORCED_SCORE = 1e6

SB_W = SB_HEADS * HEAD_DIM
NSA_QW = NSA_HEADS * HEAD_DIM
NSA_KVW = NSA_KV_GROUPS * HEAD_DIM
NSA_GATE_W = 3 * NSA_HEADS
IN_SPLITS = (SB_W, SB_W, SB_W, NSA_QW) + (NSA_KVW,) * 6 + (NSA_GATE_W, D_MODEL, D_MODEL)
N_IN = 3 * SB_W + NSA_QW + 6 * NSA_KVW + NSA_GATE_W + 2 * D_MODEL

kernel_name = "hybrid_stickbreak_nsa_moe_deepnorm"


def layer_norm(x, g, b):
    xf = x.astype(jnp.float32)
    mu = jnp.mean(xf, axis=-1, keepdims=True)
    var = jnp.mean(jnp.square(xf - mu), axis=-1, keepdims=True)
    y = (xf - mu) * lax.rsqrt(var + LN_EPS)
    return (y * g.astype(jnp.float32) + b.astype(jnp.float32)).astype(x.dtype)


def split_columns(t):
    parts, start = [], 0
    for width in IN_SPLITS:
        parts.append(t[..., start:start + width])
        start += width
    return parts


def to_heads(t, n):
    B, S, _ = t.shape
    return t.reshape(B, S, n, HEAD_DIM).transpose(0, 2, 1, 3).astype(jnp.float32)


def alibi_slopes():
    return jnp.exp2(-8.0 * jnp.arange(1, NSA_HEADS + 1, dtype=jnp.float32) / NSA_HEADS)


def stick_breaking_attention(q, k, v):
    B, H, S, Dh = q.shape
    scale = Dh ** -0.5
    kpos = jnp.arange(S)

    def block(jb):
        qs = jb * SB_BLOCK
        qb = lax.dynamic_slice_in_dim(q, qs, SB_BLOCK, axis=2)
        tq = qs + jnp.arange(SB_BLOCK)
        mask = kpos[None, :] < tq[:, None]
        z = jnp.einsum('bhqd,bhkd->bhqk', qb, k) * scale
        log_stay = jnp.where(mask, jax.nn.log_sigmoid(-z), 0.0)
        later = lax.cumsum(log_stay, axis=3, reverse=True) - log_stay
        w = jnp.where(mask, jnp.exp(jax.nn.log_sigmoid(z) + later), 0.0)
        return jnp.einsum('bhqk,bhkd->bhqd', w, v)

    o = lax.map(block, jnp.arange(S // SB_BLOCK))
    return jnp.moveaxis(o, 0, 2).reshape(B, H, S, Dh)


def compress_tokens(kv, w1, w2, pe):
    B, G, S, Dh = kv.shape
    blk = kv.reshape(B, G, S // CMP_BLOCK, CMP_BLOCK, Dh) + pe
    hid = jax.nn.silu(jnp.einsum('bgcld,ldh->bgch', blk, w1))
    return jnp.einsum('bgch,hd->bgcd', hid, w2)


def gather_blocks(blocks, idx):
    return jax.vmap(jax.vmap(lambda blk, ix: blk[ix]))(blocks, idx)


def native_sparse_attention(q, k_c, v_c, k_s, v_s, k_w, v_w, gate_logits, w_cmp1, w_cmp2, pe_cmp):
    B, G, R, S, Dh = q.shape
    scale = Dh ** -0.5
    n_cmp = S // CMP_BLOCK
    n_blk = S // SEL_BLOCK
    n_sel = min(N_SEL, n_blk)
    slopes = alibi_slopes().reshape(G, R)[None, :, :, None, None]
    pos = jnp.arange(S)

    kc = compress_tokens(k_c, w_cmp1[0], w_cmp2[0], pe_cmp[0])
    vc = compress_tokens(v_c, w_cmp1[1], w_cmp2[1], pe_cmp[1])
    c_end = jnp.arange(n_cmp) * CMP_BLOCK + (CMP_BLOCK - 1)
    dist_c = pos[:, None] - c_end[None, :]
    mask_c = dist_c >= 0
    s_c = jnp.einsum('bgrtd,bgcd->bgrtc', q, kc) * scale - slopes * dist_c.astype(jnp.float32)
    p_c = jnp.where(mask_c, jax.nn.softmax(jnp.where(mask_c, s_c, NEG_INF), axis=-1), 0.0)
    o_cmp = jnp.einsum('bgrtc,bgcd->bgrtd', p_c, vc)

    imp = p_c.sum(axis=2).reshape(B, G, S, n_blk, SEL_BLOCK // CMP_BLOCK).sum(-1)
    blk = jnp.arange(n_blk)[None, :]
    cur = (pos // SEL_BLOCK)[:, None]
    forced = (blk == 0) | (blk == cur) | (blk == cur - 1)
    valid = blk * SEL_BLOCK <= pos[:, None]
    imp = jnp.where(forced, FORCED_SCORE, jnp.where(valid, imp, NEG_INF))
    _, sel_idx = lax.top_k(imp, n_sel)
    ks_blocks = k_s.reshape(B, G, n_blk, SEL_BLOCK, Dh)
    vs_blocks = v_s.reshape(B, G, n_blk, SEL_BLOCK, Dh)
    kw_pad = jnp.pad(k_w, ((0, 0), (0, 0), (WINDOW, 0), (0, 0)))
    vw_pad = jnp.pad(v_w, ((0, 0), (0, 0), (WINDOW, 0), (0, 0)))
    n_keys = n_sel * SEL_BLOCK

    def block(jb):
        qs = jb * NSA_BLOCK
        qb = lax.dynamic_slice_in_dim(q, qs, NSA_BLOCK, axis=3)
        tq = qs + jnp.arange(NSA_BLOCK)
        idx = lax.dynamic_slice_in_dim(sel_idx, qs, NSA_BLOCK, axis=2)
        kg = gather_blocks(ks_blocks, idx).reshape(B, G, NSA_BLOCK, n_keys, Dh)
        vg = gather_blocks(vs_blocks, idx).reshape(B, G, NSA_BLOCK, n_keys, Dh)
        kpos = (idx[..., None] * SEL_BLOCK + jnp.arange(SEL_BLOCK)).reshape(B, G, NSA_BLOCK, n_keys)
        dist_s = (tq[:, None] - kpos)[:, :, None]
        s_s = jnp.einsum('bgrqd,bgqmd->bgrqm', qb, kg) * scale - slopes * dist_s.astype(jnp.float32)
        p_s = jax.nn.softmax(jnp.where(dist_s >= 0, s_s, NEG_INF), axis=-1)
        o_s = jnp.einsum('bgrqm,bgqmd->bgrqd', p_s, vg)
        kwb = lax.dynamic_slice_in_dim(kw_pad, qs, NSA_BLOCK + WINDOW, axis=2)
        vwb = lax.dynamic_slice_in_dim(vw_pad, qs, NSA_BLOCK + WINDOW, axis=2)
        wpos = qs - WINDOW + jnp.arange(NSA_BLOCK + WINDOW)
        dist_w = tq[:, None] - wpos[None, :]
        mask_w = (dist_w >= 0) & (dist_w < WINDOW) & (wpos[None, :] >= 0)
        s_w = jnp.einsum('bgrqd,bgkd->bgrqk', qb, kwb) * scale - slopes * dist_w.astype(jnp.float32)
        p_w = jax.nn.softmax(jnp.where(mask_w, s_w, NEG_INF), axis=-1)
        o_w = jnp.einsum('bgrqk,bgkd->bgrqd', p_w, vwb)
        return o_s, o_w

    o_sel, o_win = lax.map(block, jnp.arange(S // NSA_BLOCK))
    o_sel = jnp.moveaxis(o_sel, 0, 3).reshape(B, G, R, S, Dh)
    o_win = jnp.moveaxis(o_win, 0, 3).reshape(B, G, R, S, Dh)
    g = jax.nn.sigmoid(gate_logits)
    return g[..., 0:1] * o_cmp + g[..., 1:2] * o_sel + g[..., 2:3] * o_win


def moe_ffn(h, w_router, b_router, w_gu, b_gu, w_down, b_down):
    B, S, D = h.shape
    t = h.reshape(B * S, D)
    logits = (t @ w_router + b_router).astype(jnp.float32)
    top_val, top_idx = lax.top_k(logits, TOP_K)
    top_w = jax.nn.softmax(top_val, axis=-1)
    combine = jnp.sum(jax.nn.one_hot(top_idx, N_EXPERTS, dtype=jnp.float32) * top_w[..., None], axis=1)

    def expert(acc, params):
        wgu, bgu, wd, bd, c = params
        gu = t @ wgu + bgu
        gate = jnp.minimum(gu[:, :D_FF], SWIGLU_LIMIT)
        up = jnp.clip(gu[:, D_FF:], -SWIGLU_LIMIT, SWIGLU_LIMIT)
        act = (up + 1.0) * gate * jax.nn.sigmoid(SWIGLU_ALPHA * gate)
        return acc + c[:, None] * (act @ wd + bd), None

    acc, _ = lax.scan(expert, jnp.zeros_like(t), (w_gu, b_gu, w_down, b_down, combine.T.astype(t.dtype)))
    return acc.reshape(B, S, D)


def decoder_layer(h, p_i, w_in, w_cmp1, w_cmp2, pe_cmp, w_br_sb, w_br_nsa, w_o,
                  ln1_g, ln1_b, ln2_g, ln2_b, w_router, b_router, w_gu, b_gu,
                  w_down, b_down, w_ple_gate, w_ple_proj):
    B, S, _ = h.shape
    f32 = jnp.float32
    (sb_q, sb_k, sb_v, nsa_q, k_cmp, v_cmp, k_sel, v_sel, k_win, v_win,
     nsa_gate, g_sb, g_nsa) = split_columns(h @ w_in)

    y_sb = stick_breaking_attention(to_heads(sb_q, SB_HEADS), to_heads(sb_k, SB_HEADS), to_heads(sb_v, SB_HEADS))
    y_sb = y_sb.transpose(0, 2, 1, 3).reshape(B, S, SB_W).astype(h.dtype)

    q_grp = nsa_q.reshape(B, S, NSA_KV_GROUPS, NSA_GROUP, HEAD_DIM).transpose(0, 2, 3, 1, 4).astype(f32)
    gate_grp = nsa_gate.reshape(B, S, NSA_KV_GROUPS, NSA_GROUP, 3).transpose(0, 2, 3, 1, 4).astype(f32)
    y_nsa = native_sparse_attention(
        q_grp,
        to_heads(k_cmp, NSA_KV_GROUPS), to_heads(v_cmp, NSA_KV_GROUPS),
        to_heads(k_sel, NSA_KV_GROUPS), to_heads(v_sel, NSA_KV_GROUPS),
        to_heads(k_win, NSA_KV_GROUPS), to_heads(v_win, NSA_KV_GROUPS),
        gate_grp, w_cmp1.astype(f32), w_cmp2.astype(f32), pe_cmp.astype(f32))
    y_nsa = y_nsa.transpose(0, 3, 1, 2, 4).reshape(B, S, NSA_QW).astype(h.dtype)

    merged = jax.nn.sigmoid(g_sb) * (y_sb @ w_br_sb) + jax.nn.sigmoid(g_nsa) * (y_nsa @ w_br_nsa)
    h1 = layer_norm(DN_ALPHA * h + merged @ w_o, ln1_g, ln1_b)

    ple = jax.nn.sigmoid(h1 @ w_ple_gate) * (p_i @ w_ple_proj)
    moe_out = moe_ffn(h1, w_router, b_router, w_gu, b_gu, w_down, b_down)
    return layer_norm(DN_ALPHA * h1 + moe_out + ple, ln2_g, ln2_b)


def setup_inputs(seed: int = 0) -> dict:
    key = jax.random.key(seed)
    ks = jax.random.split(key, 21)
    f32 = jnp.float32
    L = DEPTH

    def normal(k, shape, std):
        return jax.random.normal(k, shape, f32) * std

    in_scale = jnp.concatenate(
        [jnp.ones((2 * SB_W,), f32), jnp.full((SB_W,), DN_BETA, f32), jnp.ones((NSA_QW,), f32)]
        + [jnp.ones((NSA_KVW,), f32), jnp.full((NSA_KVW,), DN_BETA, f32)] * 3
        + [jnp.ones((NSA_GATE_W + 2 * D_MODEL,), f32)])
    return {
        "x": normal(ks[0], (BATCH, SEQ, D_MODEL), 1.0),
        "p": normal(ks[1], (DEPTH, BATCH, SEQ, PLE_DIM), 1.0),
        "w_in": normal(ks[2], (L, D_MODEL, N_IN), D_MODEL ** -0.5) * in_scale,
        "w_cmp1": normal(ks[3], (L, 2, CMP_BLOCK, HEAD_DIM, CMP_HIDDEN), (CMP_BLOCK * HEAD_DIM) ** -0.5),
        "w_cmp2": normal(ks[4], (L, 2, CMP_HIDDEN, HEAD_DIM), CMP_HIDDEN ** -0.5),
        "pe_cmp": normal(ks[5], (L, 2, CMP_BLOCK, HEAD_DIM), 0.1),
        "w_br_sb": normal(ks[6], (L, SB_W, D_MODEL), DN_BETA * SB_W ** -0.5),
        "w_br_nsa": normal(ks[7], (L, NSA_QW, D_MODEL), DN_BETA * NSA_QW ** -0.5),
        "w_o": normal(ks[8], (L, D_MODEL, D_MODEL), DN_BETA * D_MODEL ** -0.5),
        "ln1_g": 1.0 + normal(ks[9], (L, D_MODEL), 0.02),
        "ln1_b": normal(ks[10], (L, D_MODEL), 0.02),
        "ln2_g": 1.0 + normal(ks[11], (L, D_MODEL), 0.02),
        "ln2_b": normal(ks[12], (L, D_MODEL), 0.02),
        "w_router": normal(ks[13], (L, D_MODEL, N_EXPERTS), D_MODEL ** -0.5),
        "b_router": normal(ks[14], (L, N_EXPERTS), 0.01),
        "w_gu": normal(ks[15], (L, N_EXPERTS, D_MODEL, 2 * D_FF), DN_BETA * D_MODEL ** -0.5),
        "b_gu": normal(ks[16], (L, N_EXPERTS, 2 * D_FF), 0.01),
        "w_down": normal(ks[17], (L, N_EXPERTS, D_FF, D_MODEL), DN_BETA * D_FF ** -0.5),
        "b_down": normal(ks[18], (L, N_EXPERTS, D_MODEL), 0.01),
        "w_ple_gate": normal(ks[19], (L, D_MODEL, D_MODEL), D_MODEL ** -0.5),
        "w_ple_proj": normal(ks[20], (L, PLE_DIM, D_MODEL), DN_BETA * PLE_DIM ** -0.5),
    }


def reference(x, p, w_in, w_cmp1, w_cmp2, pe_cmp, w_br_sb, w_br_nsa, w_o,
              ln1_g, ln1_b, ln2_g, ln2_b, w_router, b_router, w_gu, b_gu,
              w_down, b_down, w_ple_gate, w_ple_proj):
    h = x
    for i in range(DEPTH):
        h = decoder_layer(h, p[i], w_in[i], w_cmp1[i], w_cmp2[i], pe_cmp[i],
                          w_br_sb[i], w_br_nsa[i], w_o[i],
                          ln1_g[i], ln1_b[i], ln2_g[i], ln2_b[i],
                          w_router[i], b_router[i], w_gu[i], b_gu[i],
                          w_down[i], b_down[i], w_ple_gate[i], w_ple_proj[i])
    return h
```

```cpp
#include <hip/hip_runtime.h>
#include <stdint.h>
#include <cstdio>
#include <cstring>
#include <cstdlib>
#include <vector>

#define XB_TMO      128
#define XB_XCNT(j)  (256  + 64 * (j))
#define XB_XSUB(j)  (1280 + 64 * (j))
#define XB_XGEN(j)  (2304 + 64 * (j))
#define XB_TOP      3328
#define XB_TOPGEN   3392
#define XCD_BAR_WORDS 3456
#define XB_SPIN_CAP (1u << 18)
#define LAS __attribute__((address_space(3)))

__device__ __forceinline__ unsigned xb_ld(unsigned* p)              { return __hip_atomic_load(p, __ATOMIC_RELAXED, __HIP_MEMORY_SCOPE_AGENT); }
__device__ __forceinline__ unsigned xb_add(unsigned* p, unsigned v) { return __hip_atomic_fetch_add(p, v, __ATOMIC_RELAXED, __HIP_MEMORY_SCOPE_AGENT); }
__device__ __forceinline__ unsigned xb_xcc_id() { return (unsigned)__builtin_amdgcn_s_getreg((3 << 11) | 20) & 0xFu; }
#define XB_SPIN(cond, bar) do { unsigned _sp = 0; while (cond) { __builtin_amdgcn_s_sleep(1); \
    if ((++_sp & 255u) == 0u) { if (xb_ld(&(bar)[XB_TMO])) break; if (_sp > XB_SPIN_CAP) { atomicAdd(&(bar)[XB_TMO], 1u); break; } } } } while (0)

struct XcdBarrier {
    unsigned* bar; unsigned x;
    volatile LAS unsigned* st;
};

__device__ __forceinline__ XcdBarrier xcd_barrier_post(unsigned* bar, volatile LAS unsigned* st) {
    XcdBarrier b; b.bar = bar; b.x = xb_xcc_id(); b.st = st;
    if (threadIdx.x == 0) (void)xb_add(&bar[XB_XCNT(b.x)], 1u);
    return b;
}
__device__ __forceinline__ void xcd_barrier_complete(unsigned* bar, unsigned x, unsigned& nloc, unsigned& nx) {
    const unsigned G = gridDim.x * gridDim.y * gridDim.z;
    unsigned sum, cnt, mine, sp = 0u;
    for (;;) {
        sum = 0u; cnt = 0u; mine = 0u;
#pragma unroll
        for (unsigned j = 0; j < 16; ++j) { const unsigned c = xb_ld(&bar[XB_XCNT(j)]); sum += c; cnt += (c > 0u) ? 1u : 0u; mine = (j == x) ? c : mine; }
        if (sum == G) break;
        __builtin_amdgcn_s_sleep(1);
        if ((++sp & 255u) == 0u) { if (xb_ld(&bar[XB_TMO])) break; if (sp > XB_SPIN_CAP) { atomicAdd(&bar[XB_TMO], 1u); break; } }
    }
    nloc = mine > 0u ? mine : 1u; nx = cnt > 0u ? cnt : 1u;
}

__device__ __forceinline__ void xcd_barrier(const XcdBarrier& b) {
    asm volatile("s_waitcnt vmcnt(0)" ::: "memory");
    __syncthreads();
    if (threadIdx.x == 0) {
        unsigned* bar = b.bar;
        __builtin_amdgcn_s_waitcnt(0);
        unsigned nloc = b.st[0], nx = b.st[1];
        if (nloc == 0u) { xcd_barrier_complete(bar, b.x, nloc, nx); b.st[0] = nloc; b.st[1] = nx; }
        const unsigned old = xb_add(&bar[XB_XSUB(b.x)], 1u);
        const unsigned gen = old / nloc;
        if (old + 1u == (gen + 1u) * nloc) {
            __builtin_amdgcn_fence(__ATOMIC_RELEASE, "agent");
            asm volatile("s_waitcnt vmcnt(0)" ::: "memory");
            const unsigned og = xb_add(&bar[XB_TOP], 1u);
            const unsigned tg = og / nx;
            if (og + 1u == (tg + 1u) * nx) xb_add(&bar[XB_TOPGEN], 1u);
            else XB_SPIN(xb_ld(&bar[XB_TOPGEN]) == tg, bar);
            __builtin_amdgcn_fence(__ATOMIC_ACQUIRE, "agent");
            xb_add(&bar[XB_XGEN(b.x)], 1u);
            asm volatile("s_waitcnt vmcnt(0)" ::: "memory");
        } else {
            XB_SPIN(xb_ld(&bar[XB_XGEN(b.x)]) == gen, bar);
            __builtin_amdgcn_fence(__ATOMIC_ACQUIRE, "agent");
            asm volatile("s_waitcnt vmcnt(0)" ::: "memory");
        }
    }
    __syncthreads();
}


typedef unsigned short u16;
typedef __attribute__((ext_vector_type(8))) short bf16x8;
typedef __attribute__((ext_vector_type(4))) float f32x4;
typedef __attribute__((ext_vector_type(4))) unsigned u32x4;
#define MFMA(a, b, c) __builtin_amdgcn_mfma_f32_16x16x32_bf16(a, b, c, 0, 0, 0)

#define TT 32768
#define SS 4096
#define DD 1024
#define NIN 4888
#define C_SBQ 0
#define C_SBK 512
#define C_SBV 1024
#define C_NQ 1536
#define C_KC 2048
#define C_VC 2176
#define C_KS 2304
#define C_VS 2432
#define C_KW 2560
#define C_VW 2688
#define C_NG 2816
#define C_GSB 2840
#define C_GNSA 3864
#define DN_ALPHA 1.681792830507429f
#define NPH_LAYER 12
#define NPHASE (1 + 4 * NPH_LAYER)
#define KSTR 72
#define VSTR 136
#define SSTR 68

struct Params {
    const float *x, *p, *w_in, *w_cmp1, *w_cmp2, *pe_cmp, *w_br_sb, *w_br_nsa, *w_o, *ln1_g, *ln1_b, *ln2_g, *ln2_b,
        *w_router, *b_router, *w_gu, *b_gu, *w_down, *b_down, *w_ple_gate, *w_ple_proj;
    float* out;
    unsigned *bar, *ctr, *ecnt;
    u16 *wt_in, *wt_brs, *wt_brn, *wt_o, *wt_pg, *wt_pp, *wt_gu, *wt_dn, *wt_c1, *wt_c2, *wt_r;
    float *cbias, *hf, *pre1, *h1f, *logits, *ynf, *ent_w;
    u16 *hb, *pb, *yb, *ysb, *ynsa, *merged, *h1b, *h1lo, *ple, *hid, *kvc, *act, *y4;
    int* ent_id;
};

__device__ __forceinline__ u16 f2bf(float f) {
    unsigned u = __float_as_uint(f);
    u += 0x7fffu + ((u >> 16) & 1u);
    return (u16)(u >> 16);
}
__device__ __forceinline__ float bf2f(u16 h) { return __uint_as_float(((unsigned)h) << 16); }
__device__ __forceinline__ void st_bf4(u16* p, float a, float b, float c, float d) {
    uint2 u;
    u.x = (unsigned)f2bf(a) | ((unsigned)f2bf(b) << 16);
    u.y = (unsigned)f2bf(c) | ((unsigned)f2bf(d) << 16);
    *(uint2*)p = u;
}
__device__ __forceinline__ float sigmoidf_(float x) { return 1.f / (1.f + __expf(-x)); }

__shared__ __attribute__((aligned(16))) unsigned char g_smem[62464];
__shared__ int s_item;
__shared__ int s_misc[80];
__shared__ unsigned long long s_mask[4][16];
__shared__ unsigned long long s_union[4];

struct WorkQ {
    unsigned* ctr;
    int nxt;
    __device__ __forceinline__ void init(unsigned* c) {
        ctr = c;
        nxt = 0;
        if (threadIdx.x == 0) nxt = (int)atomicAdd(ctr, 1u);
    }
    __device__ __forceinline__ int next() {
        __syncthreads();
        if (threadIdx.x == 0) s_item = nxt;
        __syncthreads();
        int it = s_item;
        if (threadIdx.x == 0) nxt = (int)atomicAdd(ctr, 1u);
        return it;
    }
};

struct KId {
    __device__ __forceinline__ long operator()(int k) const { return k; }
};
template <class KOA>
__device__ __forceinline__ void gemm_main(f32x4 (&acc)[4][4], const u16* (&ap)[4], const u16* (&bp)[4], int K, KOA koa) {
    u16* sA = (u16*)g_smem;
    u16* sB = sA + 128 * KSTR;
    const int tid = threadIdx.x, lane = tid & 63, wave = tid >> 6;
    const int wn = wave & 1, wm = wave >> 1;
    const int kc = (tid & 7) * 8;
    const int lrow = tid >> 3;
    u32x4 ra[4], rb[4];
    {
        const long oa = koa(kc);
#pragma unroll
        for (int i = 0; i < 4; ++i) {
            ra[i] = *(const u32x4*)(ap[i] + oa);
            rb[i] = *(const u32x4*)(bp[i] + kc);
        }
    }
    for (int k0 = 0; k0 < K; k0 += 64) {
        __syncthreads();
#pragma unroll
        for (int i = 0; i < 4; ++i) {
            *(u32x4*)(sA + (lrow + 32 * i) * KSTR + kc) = ra[i];
            *(u32x4*)(sB + (lrow + 32 * i) * KSTR + kc) = rb[i];
        }
        __syncthreads();
        if (k0 + 64 < K) {
            const long oa = koa(k0 + 64 + kc);
#pragma unroll
            for (int i = 0; i < 4; ++i) {
                ra[i] = *(const u32x4*)(ap[i] + oa);
                rb[i] = *(const u32x4*)(bp[i] + (k0 + 64 + kc));
            }
        }
#pragma unroll
        for (int ks = 0; ks < 2; ++ks) {
            bf16x8 af[4], bfr[4];
#pragma unroll
            for (int j = 0; j < 4; ++j)
                af[j] = *(const bf16x8*)(sA + (wm * 64 + j * 16 + (lane & 15)) * KSTR + ks * 32 + (lane >> 4) * 8);
#pragma unroll
            for (int i = 0; i < 4; ++i)
                bfr[i] = *(const bf16x8*)(sB + (wn * 64 + i * 16 + (lane & 15)) * KSTR + ks * 32 + (lane >> 4) * 8);
#pragma unroll
            for (int i = 0; i < 4; ++i)
#pragma unroll
                for (int j = 0; j < 4; ++j) acc[i][j] = MFMA(bfr[i], af[j], acc[i][j]);
        }
    }
}
__device__ __forceinline__ void acc_zero(f32x4 (&acc)[4][4]) {
#pragma unroll
    for (int i = 0; i < 4; ++i)
#pragma unroll
        for (int j = 0; j < 4; ++j) acc[i][j] = f32x4{0.f, 0.f, 0.f, 0.f};
}
#define EPI_COORDS                                         \
    const int lane_ = threadIdx.x & 63, wave_ = threadIdx.x >> 6; \
    const int wn_ = wave_ & 1, wm_ = wave_ >> 1;
#define EPI_M(j) (wm_ * 64 + (j) * 16 + (lane_ & 15))
#define EPI_N(i) (wn_ * 64 + (i) * 16 + (lane_ >> 4) * 4)

__device__ __forceinline__ void xjob(const Params& p, int j, const float*& src, u16*& dst, int& nb, int& K, int& N) {
    switch (j) {
        case 0: src = p.w_in; dst = p.wt_in; nb = 4; K = 1024; N = NIN; break;
        case 1: src = p.w_br_sb; dst = p.wt_brs; nb = 4; K = 512; N = 1024; break;
        case 2: src = p.w_br_nsa; dst = p.wt_brn; nb = 4; K = 512; N = 1024; break;
        case 3: src = p.w_o; dst = p.wt_o; nb = 4; K = 1024; N = 1024; break;
        case 4: src = p.w_ple_gate; dst = p.wt_pg; nb = 4; K = 1024; N = 1024; break;
        case 5: src = p.w_ple_proj; dst = p.wt_pp; nb = 4; K = 256; N = 1024; break;
        case 6: src = p.w_gu; dst = p.wt_gu; nb = 128; K = 1024; N = 2048; break;
        case 7: src = p.w_down; dst = p.wt_dn; nb = 128; K = 1024; N = 1024; break;
        case 8: src = p.w_cmp1; dst = p.wt_c1; nb = 8; K = 2048; N = 128; break;
        default: src = p.w_cmp2; dst = p.wt_c2; nb = 8; K = 128; N = 64; break;
    }
}
__device__ __forceinline__ int xjob_tiles(int nb, int K, int N) { return nb * (K / 64) * ((N + 63) / 64); }

__device__ __forceinline__ void phase_prologue(const Params& p, unsigned* ctr) {
    const int tid = threadIdx.x;
    int ntr = 0;
    for (int j = 0; j < 10; ++j) {
        const float* s; u16* d; int nb, K, N;
        xjob(p, j, s, d, nb, K, N);
        ntr += xjob_tiles(nb, K, N);
    }
    const int n_x = TT * DD / 8192, n_p = 4 * TT * 256 / 8192, n_r = 16, n_b = 4;
    const int total = ntr + n_x + n_p + n_r + n_b;
    float* st = (float*)g_smem;
    WorkQ q; q.init(ctr);
    for (;;) {
        int it = q.next();
        if (it >= total) break;
        if (it < ntr) {
            const float* src = nullptr; u16* dst = nullptr; int nb = 0, K = 0, N = 0;
            int rem = it;
            for (int j = 0; j < 10; ++j) {
                xjob(p, j, src, dst, nb, K, N);
                int nt = xjob_tiles(nb, K, N);
                if (rem < nt) break;
                rem -= nt;
            }
            const int ktn = K / 64, ntn = (N + 63) / 64;
            const int tpm = ktn * ntn;
            const int b = rem / tpm; rem -= b * tpm;
            const int kt = rem % ktn, nt = rem / ktn;
            src += (long)b * K * N; dst += (long)b * K * N;
            const int k0 = kt * 64, n0 = nt * 64;
#pragma unroll
            for (int i = 0; i < 4; ++i) {
                int k = (tid >> 4) + 16 * i, n = (tid & 15) * 4;
                float4 v = make_float4(0.f, 0.f, 0.f, 0.f);
                if (n0 + n < N) v = *(const float4*)(src + (long)(k0 + k) * N + n0 + n);
                st[k * 65 + n + 0] = v.x; st[k * 65 + n + 1] = v.y; st[k * 65 + n + 2] = v.z; st[k * 65 + n + 3] = v.w;
            }
            __syncthreads();
#pragma unroll
            for (int i = 0; i < 2; ++i) {
                int n = (tid >> 3) + 32 * i, k8 = (tid & 7) * 8;
                if (n0 + n < N) {
                    uint4 u;
                    u.x = (unsigned)f2bf(st[(k8 + 0) * 65 + n]) | ((unsigned)f2bf(st[(k8 + 1) * 65 + n]) << 16);
                    u.y = (unsigned)f2bf(st[(k8 + 2) * 65 + n]) | ((unsigned)f2bf(st[(k8 + 3) * 65 + n]) << 16);
                    u.z = (unsigned)f2bf(st[(k8 + 4) * 65 + n]) | ((unsigned)f2bf(st[(k8 + 5) * 65 + n]) << 16);
                    u.w = (unsigned)f2bf(st[(k8 + 6) * 65 + n]) | ((unsigned)f2bf(st[(k8 + 7) * 65 + n]) << 16);
                    *(uint4*)(dst + (long)(n0 + n) * K + k0 + k8) = u;
                }
            }
        } else if (it < ntr + n_x + n_p) {
            int e = it - ntr;
            const float* src; u16* db; float* df = nullptr;
            if (e < n_x) { src = p.x + (long)e * 8192; db = p.hb + (long)e * 8192; df = p.hf + (long)e * 8192; }
            else { e -= n_x; src = p.p + (long)e * 8192; db = p.pb + (long)e * 8192; }
#pragma unroll
            for (int i = 0; i < 8; ++i) {
                int o = i * 1024 + tid * 4;
                float4 v = *(const float4*)(src + o);
                if (df) *(float4*)(df + o) = v;
                st_bf4(db + o, v.x, v.y, v.z, v.w);
            }
        } else if (it < ntr + n_x + n_p + n_r) {
            int e0 = (it - ntr - n_x - n_p) * 8192;
            for (int i = 0; i < 32; ++i) {
                int idx = e0 + i * 256 + tid;
                int k = idx & 1023, le = idx >> 10, e = le & 31, l = le >> 5;
                float w = p.w_router[((long)l * 1024 + k) * 32 + e];
                u16 hi = f2bf(w); u16 lo = f2bf(w - bf2f(hi));
                u16* d = p.wt_r + (long)le * 3072;
                d[k] = hi; d[1024 + k] = lo; d[2048 + k] = hi;
            }
        } else {
            int o = (it - ntr - n_x - n_p - n_r) * 256 + tid;
            int lk = o >> 7, h = o & 127;
            const float* pe = p.pe_cmp + (long)lk * 2048;
            const float* w1 = p.w_cmp1 + (long)lk * 2048 * 128 + h;
            float s = 0.f;
            for (int j = 0; j < 2048; ++j) s += pe[j] * w1[(long)j * 128];
            p.cbias[o] = s;
        }
    }
}

__device__ __forceinline__ void phase_gemm_in(const Params& p, int l, unsigned* ctr) {
    const int NTN = (NIN + 127) / 128;
    const int total = (TT / 128) * NTN;
    const int tid = threadIdx.x;
    const u16* W = p.wt_in + (long)l * NIN * 1024;
    WorkQ q; q.init(ctr);
    for (;;) {
        int it = q.next();
        if (it >= total) break;
        const int mt = it / NTN, nt = it % NTN;
        const int m0 = mt * 128, n0 = nt * 128;
        const u16* ap[4]; const u16* bp[4];
#pragma unroll
        for (int i = 0; i < 4; ++i) {
            int r = (tid >> 3) + 32 * i;
            ap[i] = p.hb + (long)(m0 + r) * 1024;
            int n = n0 + r; if (n > NIN - 1) n = NIN - 1;
            bp[i] = W + (long)n * 1024;
        }
        f32x4 acc[4][4]; acc_zero(acc);
        gemm_main(acc, ap, bp, 1024, KId());
        EPI_COORDS
#pragma unroll
        for (int i = 0; i < 4; ++i)
#pragma unroll
            for (int j = 0; j < 4; ++j) {
                int m = m0 + EPI_M(j), n = n0 + EPI_N(i);
                if (n < NIN) st_bf4(p.yb + (long)m * NIN + n, acc[i][j][0], acc[i][j][1], acc[i][j][2], acc[i][j][3]);
            }
    }
}

struct KCmp {
    __device__ __forceinline__ long operator()(int k) const { return (long)(k >> 6) * NIN + (k & 63); }
};
__device__ __forceinline__ void tile_cmp1(const Params& p, int l, int it) {
    const int tid = threadIdx.x;
    const int kv = it >> 4, mt = it & 15;
    const u16* W = p.wt_c1 + (long)(l * 2 + kv) * 128 * 2048;
    const u16* ap[4]; const u16* bp[4];
#pragma unroll
    for (int i = 0; i < 4; ++i) {
        int r = (tid >> 3) + 32 * i;
        int mrow = mt * 128 + r;
        int c = mrow & 127, bg = mrow >> 7, g = bg & 1, b = bg >> 1;
        ap[i] = p.yb + (long)(b * SS + c * 32) * NIN + (kv ? C_VC : C_KC) + g * 64;
        bp[i] = W + (long)r * 2048;
    }
    f32x4 acc[4][4]; acc_zero(acc);
    gemm_main(acc, ap, bp, 2048, KCmp());
    EPI_COORDS
    const float* cb = p.cbias + (l * 2 + kv) * 128;
#pragma unroll
    for (int i = 0; i < 4; ++i)
#pragma unroll
        for (int j = 0; j < 4; ++j) {
            int m = mt * 128 + EPI_M(j), n = EPI_N(i);
            float v[4];
#pragma unroll
            for (int r = 0; r < 4; ++r) { float a = acc[i][j][r] + cb[n + r]; v[r] = a * sigmoidf_(a); }
            st_bf4(p.hid + ((long)kv * 2048 + m) * 128 + n, v[0], v[1], v[2], v[3]);
        }
}
__device__ __forceinline__ void phase_cmp2(const Params& p, int l, unsigned* ctr) {
    const int tid = threadIdx.x;
    WorkQ q; q.init(ctr);
    for (;;) {
        int it = q.next();
        if (it >= 32) break;
        const int kv = it >> 4, mt = it & 15;
        const u16* W = p.wt_c2 + (long)(l * 2 + kv) * 64 * 128;
        const u16* ap[4]; const u16* bp[4];
#pragma unroll
        for (int i = 0; i < 4; ++i) {
            int r = (tid >> 3) + 32 * i;
            ap[i] = p.hid + ((long)kv * 2048 + mt * 128 + r) * 128;
            bp[i] = W + (long)(r & 63) * 128;
        }
        f32x4 acc[4][4]; acc_zero(acc);
        gemm_main(acc, ap, bp, 128, KId());
        EPI_COORDS
#pragma unroll
        for (int i = 0; i < 4; ++i)
#pragma unroll
            for (int j = 0; j < 4; ++j) {
                int m = mt * 128 + EPI_M(j), n = EPI_N(i);
                if (n < 64) st_bf4(p.kvc + ((long)kv * 2048 + m) * 64 + n, acc[i][j][0], acc[i][j][1], acc[i][j][2], acc[i][j][3]);
            }
    }
}

struct AttnLds {
    u16* K;
    u16* Vt;
    float* S;
    u16* P;
};
__device__ __forceinline__ AttnLds attn_lds() {
    AttnLds a;
    a.K = (u16*)g_smem;
    a.Vt = (u16*)(g_smem + 18432);
    a.S = (float*)(g_smem + 18432 + 17408) + (threadIdx.x >> 6) * 16 * SSTR;
    a.P = (u16*)(g_smem + 18432 + 17408 + 17408) + (threadIdx.x >> 6) * 16 * KSTR;
    return a;
}
__device__ __forceinline__ void load_k_tile(u16* sK, int koff, const u16* base, long stride) {
    const int tid = threadIdx.x, key = tid >> 2, ch = (tid & 3) * 16;
    const u16* g = base + (long)key * stride + ch;
    uint4 a = *(const uint4*)g, b = *(const uint4*)(g + 8);
    *(uint4*)(sK + (koff + key) * KSTR + ch) = a;
    *(uint4*)(sK + (koff + key) * KSTR + ch + 8) = b;
}
__device__ __forceinline__ void load_v_tile(u16* sVt, int koff, const u16* base, long stride) {
    const int tid = threadIdx.x, key = tid & 63, d0 = (tid >> 6) * 16;
    const u16* g = base + (long)key * stride + d0;
    uint4 a = *(const uint4*)g, b = *(const uint4*)(g + 8);
    unsigned w[8] = {a.x, a.y, a.z, a.w, b.x, b.y, b.z, b.w};
#pragma unroll
    for (int i = 0; i < 8; ++i) {
        sVt[(d0 + 2 * i) * VSTR + koff + key] = (u16)(w[i] & 0xffffu);
        sVt[(d0 + 2 * i + 1) * VSTR + koff + key] = (u16)(w[i] >> 16);
    }
}
__device__ __forceinline__ void wave_qk(const AttnLds& L, int koff, const bf16x8 (&qf)[2]) {
    const int lane = threadIdx.x & 63, quad = lane >> 4, c = lane & 15;
#pragma unroll
    for (int nt = 0; nt < 4; ++nt) {
        f32x4 a = {0.f, 0.f, 0.f, 0.f};
#pragma unroll
        for (int ks = 0; ks < 2; ++ks) {
            bf16x8 kf = *(const bf16x8*)(L.K + (koff + nt * 16 + c) * KSTR + ks * 32 + quad * 8);
            a = MFMA(qf[ks], kf, a);
        }
#pragma unroll
        for (int r = 0; r < 4; ++r) L.S[(quad * 4 + r) * SSTR + nt * 16 + c] = a[r];
    }
}
__device__ __forceinline__ void wave_pv(const AttnLds& L, int koff, f32x4 (&o)[4]) {
    const int lane = threadIdx.x & 63, quad = lane >> 4, c = lane & 15;
#pragma unroll
    for (int ks = 0; ks < 2; ++ks) {
        bf16x8 pf = *(const bf16x8*)(L.P + c * KSTR + ks * 32 + quad * 8);
#pragma unroll
        for (int dt = 0; dt < 4; ++dt) {
            bf16x8 vf = *(const bf16x8*)(L.Vt + (dt * 16 + c) * VSTR + koff + ks * 32 + quad * 8);
            o[dt] = MFMA(pf, vf, o[dt]);
        }
    }
}
__device__ __forceinline__ void read_s16(const AttnLds& L, int row, int part, float (&z)[16]) {
#pragma unroll
    for (int i = 0; i < 4; ++i) {
        float4 v = *(const float4*)(L.S + row * SSTR + part * 16 + i * 4);
        z[i * 4 + 0] = v.x; z[i * 4 + 1] = v.y; z[i * 4 + 2] = v.z; z[i * 4 + 3] = v.w;
    }
}
__device__ __forceinline__ void write_p16(const AttnLds& L, int row, int part, const float (&pv)[16]) {
    uint4 a, b;
    a.x = (unsigned)f2bf(pv[0]) | ((unsigned)f2bf(pv[1]) << 16);
    a.y = (unsigned)f2bf(pv[2]) | ((unsigned)f2bf(pv[3]) << 16);
    a.z = (unsigned)f2bf(pv[4]) | ((unsigned)f2bf(pv[5]) << 16);
    a.w = (unsigned)f2bf(pv[6]) | ((unsigned)f2bf(pv[7]) << 16);
    b.x = (unsigned)f2bf(pv[8]) | ((unsigned)f2bf(pv[9]) << 16);
    b.y = (unsigned)f2bf(pv[10]) | ((unsigned)f2bf(pv[11]) << 16);
    b.z = (unsigned)f2bf(pv[12]) | ((unsigned)f2bf(pv[13]) << 16);
    b.w = (unsigned)f2bf(pv[14]) | ((unsigned)f2bf(pv[15]) << 16);
    *(uint4*)(L.P + row * KSTR + part * 16) = a;
    *(uint4*)(L.P + row * KSTR + part * 16 + 8) = b;
}
__device__ __forceinline__ float row4_max(float v) {
    v = fmaxf(v, __shfl_xor(v, 1));
    v = fmaxf(v, __shfl_xor(v, 2));
    return v;
}
__device__ __forceinline__ float row4_sum(float v) {
    v += __shfl_xor(v, 1);
    v += __shfl_xor(v, 2);
    return v;
}

__device__ __forceinline__ void item_sb(const Params& p, int it) {
    const int tid = threadIdx.x, lane = tid & 63, wave = tid >> 6, quad = lane >> 4, c = lane & 15;
    const int qb = it & 63, h = (it >> 6) & 7, b = it >> 9;
    const int t0 = qb * 64;
    AttnLds L = attn_lds();
    bf16x8 qf[2];
    {
        const u16* g = p.yb + (long)(b * SS + t0 + wave * 16 + c) * NIN + C_SBQ + h * 64 + quad * 8;
        qf[0] = *(const bf16x8*)g;
        qf[1] = *(const bf16x8*)(g + 32);
    }
    const int row = lane >> 2, part = lane & 3;
    const int t = t0 + wave * 16 + row;
    float R = 0.f;
    f32x4 o[4];
#pragma unroll
    for (int dt = 0; dt < 4; ++dt) o[dt] = f32x4{0.f, 0.f, 0.f, 0.f};
    for (int kb = qb; kb >= 0; --kb) {
        __syncthreads();
        const u16* kbase = p.yb + (long)(b * SS + kb * 64) * NIN + h * 64;
        load_k_tile(L.K, 0, kbase + C_SBK, NIN);
        load_v_tile(L.Vt, 0, kbase + C_SBV, NIN);
        __syncthreads();
        wave_qk(L, 0, qf);
        __syncthreads();
        float z[16], lat[16];
        read_s16(L, row, part, z);
        float run = 0.f;
#pragma unroll
        for (int i = 15; i >= 0; --i) {
            const int key = kb * 64 + part * 16 + i;
            const bool valid = key < t;
            const float zz = z[i] * 0.125f;
            const float sp = fmaxf(zz, 0.f) + __logf(1.f + __expf(-fabsf(zz)));
            lat[i] = run;
            z[i] = valid ? (zz - sp) : -1e30f;
            run += valid ? -sp : 0.f;
        }
        const int lb = lane & ~3;
        const float t0_ = __shfl(run, lb), t1_ = __shfl(run, lb + 1), t2_ = __shfl(run, lb + 2), t3_ = __shfl(run, lb + 3);
        float off = R;
        if (part < 3) off += t3_;
        if (part < 2) off += t2_;
        if (part < 1) off += t1_;
        float pv[16];
#pragma unroll
        for (int i = 0; i < 16; ++i) pv[i] = (z[i] > -1e29f) ? __expf(z[i] + lat[i] + off) : 0.f;
        write_p16(L, row, part, pv);
        R += (t0_ + t1_) + (t2_ + t3_);
        const int done = __syncthreads_and(R < -110.f);
        wave_pv(L, 0, o);
        if (done) break;
    }
#pragma unroll
    for (int dt = 0; dt < 4; ++dt)
#pragma unroll
        for (int r = 0; r < 4; ++r)
            p.ysb[(long)(b * SS + t0 + wave * 16 + quad * 4 + r) * 512 + h * 64 + dt * 16 + c] = f2bf(o[dt][r]);
}

__device__ __forceinline__ void phase_cmp1_sb(const Params& p, int l, unsigned* ctr) {
    const int total = 32 + 8 * 8 * 64;
    WorkQ q; q.init(ctr);
    for (;;) {
        int it = q.next();
        if (it >= total) break;
        if (it < 32) tile_cmp1(p, l, it);
        else item_sb(p, it - 32);
    }
}

template <int MODE>
__device__ __forceinline__ void nsa_step(const AttnLds& L, const bf16x8 (&qf)[2], f32x4 (&o)[4], float& m, float& l,
                                         float slope, int t, int kpos0, bool rowsel) {
    const int lane = threadIdx.x & 63, quad = lane >> 4;
    const int row = lane >> 2, part = lane & 3;
    wave_qk(L, 0, qf);
    __syncthreads();
    float z[16];
    read_s16(L, row, part, z);
    float pm = -1e30f;
#pragma unroll
    for (int i = 0; i < 16; ++i) {
        const int dist = t - (kpos0 + part * 16 + i);
        bool valid = dist >= 0;
        if (MODE == 1) valid = valid && rowsel;
        if (MODE == 2) valid = valid && (dist < 512);
        z[i] = valid ? (z[i] * 0.125f - slope * (float)dist) : -1e30f;
        pm = fmaxf(pm, z[i]);
    }
    pm = row4_max(pm);
    const float mn = fmaxf(m, pm);
    const float alpha = __expf(m - mn);
    float ps = 0.f;
#pragma unroll
    for (int i = 0; i < 16; ++i) {
        z[i] = (z[i] > -1e29f) ? __expf(z[i] - mn) : 0.f;
        ps += z[i];
    }
    ps = row4_sum(ps);
    l = l * alpha + ps;
    m = mn;
    write_p16(L, row, part, z);
    float al[4];
#pragma unroll
    for (int r = 0; r < 4; ++r) al[r] = __shfl(alpha, (quad * 4 + r) * 4);
    __syncthreads();
#pragma unroll
    for (int dt = 0; dt < 4; ++dt)
#pragma unroll
        for (int r = 0; r < 4; ++r) o[dt][r] *= al[r];
    wave_pv(L, 0, o);
    __syncthreads();
}

__device__ __forceinline__ void item_nsa(const Params& p, int it) {
    const int tid = threadIdx.x, lane = tid & 63, wave = tid >> 6, quad = lane >> 4, c = lane & 15;
    const int qb = 63 - (it >> 4), bg = it & 15, g = bg & 1, b = bg >> 1;
    const int t0 = qb * 64;
    AttnLds L = attn_lds();
    const int row = lane >> 2, part = lane & 3;
    const int t = t0 + wave * 16 + row;
    const long tokbase = (long)b * SS + t0 + wave * 16;
    float* ynf = p.ynf;
    const int nct = (2 * qb + 2 > 64) ? 2 : 1;
    const int nv = (t + 1) >> 5;
    __syncthreads();
    for (int ct = 0; ct < nct; ++ct) {
        load_k_tile(L.K, ct * 64, p.kvc + ((long)(b * 2 + g) * 128 + ct * 64) * 64, 64);
        load_v_tile(L.Vt, ct * 64, p.kvc + ((long)2048 + (b * 2 + g) * 128 + ct * 64) * 64, 64);
    }
    __syncthreads();
    float imp[2][8];
#pragma unroll
    for (int a = 0; a < 2; ++a)
#pragma unroll
        for (int j = 0; j < 8; ++j) imp[a][j] = 0.f;
#pragma unroll 1
    for (int r = 0; r < 4; ++r) {
        const float slope = exp2f(-(float)(g * 4 + r + 1));
        float m = -1e30f, l = 0.f;
        bf16x8 qfa[2];
        {
            const u16* gq = p.yb + (tokbase + c) * NIN + C_NQ + (g * 4 + r) * 64 + quad * 8;
            qfa[0] = *(const bf16x8*)gq;
            qfa[1] = *(const bf16x8*)(gq + 32);
        }
        for (int ct = 0; ct < nct; ++ct) {
            wave_qk(L, ct * 64, qfa);
            __syncthreads();
            float z[16];
            read_s16(L, row, part, z);
            float pm = -1e30f;
#pragma unroll
            for (int i = 0; i < 16; ++i) {
                const int cc = ct * 64 + part * 16 + i;
                const bool valid = cc < nv;
                z[i] = valid ? (z[i] * 0.125f - slope * (float)(t - (cc * 32 + 31))) : -1e30f;
                pm = fmaxf(pm, z[i]);
            }
            pm = row4_max(pm);
            const float mn = fmaxf(m, pm);
            float ps = 0.f;
#pragma unroll
            for (int i = 0; i < 16; ++i) ps += (z[i] > -1e29f) ? __expf(z[i] - mn) : 0.f;
            ps = row4_sum(ps);
            l = l * __expf(m - mn) + ps;
            m = mn;
            __syncthreads();
        }
        const float inv = (l > 0.f) ? 1.f / l : 0.f;
        f32x4 o[4];
#pragma unroll
        for (int dt = 0; dt < 4; ++dt) o[dt] = f32x4{0.f, 0.f, 0.f, 0.f};
#pragma unroll
        for (int ct = 0; ct < 2; ++ct) {
            if (ct < nct) {
                wave_qk(L, ct * 64, qfa);
                __syncthreads();
                float z[16];
                read_s16(L, row, part, z);
#pragma unroll
                for (int i = 0; i < 16; ++i) {
                    const int cc = ct * 64 + part * 16 + i;
                    const bool valid = cc < nv;
                    const float s = z[i] * 0.125f - slope * (float)(t - (cc * 32 + 31));
                    z[i] = valid ? __expf(s - m) * inv : 0.f;
                }
#pragma unroll
                for (int i = 0; i < 16; ++i) imp[ct][i >> 1] += z[i];
                write_p16(L, row, part, z);
                __syncthreads();
                wave_pv(L, ct * 64, o);
                __syncthreads();
            }
        }
#pragma unroll
        for (int rr = 0; rr < 4; ++rr) {
            const long tok = tokbase + quad * 4 + rr;
            const float gt = sigmoidf_(bf2f(p.yb[tok * NIN + C_NG + (g * 4 + r) * 3 + 0]));
#pragma unroll
            for (int dt = 0; dt < 4; ++dt) ynf[tok * 512 + (g * 4 + r) * 64 + dt * 16 + c] = gt * o[dt][rr];
        }
    }
#pragma unroll
    for (int a = 0; a < 2; ++a)
#pragma unroll
        for (int j = 0; j < 8; ++j) L.S[row * SSTR + a * 32 + part * 8 + j] = imp[a][j];
    __syncthreads();
    unsigned long long un = 0ull;
    for (int rr = 0; rr < 16; ++rr) {
        float v = L.S[rr * SSTR + lane];
        const bool forced = (lane == 0) || (lane == qb) || (lane == qb - 1);
        const bool validb = lane <= qb;
        v = forced ? 1e6f : (validb ? v : -1e30f);
        int rank = 0;
        for (int i = 0; i < 64; ++i) {
            const float vi = __shfl(v, i);
            rank += ((vi > v) || (vi == v && i < lane)) ? 1 : 0;
        }
        const unsigned long long mk = __ballot((rank < 16) && validb);
        if (lane == 0) s_mask[wave][rr] = mk;
        un |= mk;
    }
    if (lane == 0) s_union[wave] = un;
    __syncthreads();
    const unsigned long long rowmask = s_mask[wave][row];
    const unsigned long long umask = s_union[0] | s_union[1] | s_union[2] | s_union[3];
#pragma unroll 1
    for (int hp = 0; hp < 2; ++hp) {
        bf16x8 qf[2][2];
#pragma unroll
        for (int r = 0; r < 2; ++r) {
            const u16* gq = p.yb + (tokbase + c) * NIN + C_NQ + (g * 4 + hp * 2 + r) * 64 + quad * 8;
            qf[r][0] = *(const bf16x8*)gq;
            qf[r][1] = *(const bf16x8*)(gq + 32);
        }
#pragma unroll 1
        for (int mode = 1; mode <= 2; ++mode) {
            f32x4 o[2][4];
            float m[2], l[2];
#pragma unroll
            for (int r = 0; r < 2; ++r) {
                m[r] = -1e30f; l[r] = 0.f;
#pragma unroll
                for (int dt = 0; dt < 4; ++dt) o[r][dt] = f32x4{0.f, 0.f, 0.f, 0.f};
            }
            const int kb_lo = (mode == 1) ? 0 : ((qb - 8 > 0) ? qb - 8 : 0);
            const int colk = (mode == 1) ? C_KS : C_KW, colv = (mode == 1) ? C_VS : C_VW;
            for (int kb = kb_lo; kb <= qb; ++kb) {
                if (mode == 1 && !((umask >> kb) & 1ull)) continue;
                const u16* kbase = p.yb + (long)(b * SS + kb * 64) * NIN + g * 64;
                load_k_tile(L.K, 0, kbase + colk, NIN);
                load_v_tile(L.Vt, 0, kbase + colv, NIN);
                __syncthreads();
                const bool rowsel = (rowmask >> kb) & 1ull;
#pragma unroll
                for (int r = 0; r < 2; ++r) {
                    const float slope = exp2f(-(float)(g * 4 + hp * 2 + r + 1));
                    if (mode == 1) nsa_step<1>(L, qf[r], o[r], m[r], l[r], slope, t, kb * 64, rowsel);
                    else nsa_step<2>(L, qf[r], o[r], m[r], l[r], slope, t, kb * 64, rowsel);
                }
            }
#pragma unroll
            for (int r = 0; r < 2; ++r) {
                const int hh = g * 4 + hp * 2 + r;
#pragma unroll
                for (int rr = 0; rr < 4; ++rr) {
                    const long tok = tokbase + quad * 4 + rr;
                    const float lr = __shfl(l[r], (quad * 4 + rr) * 4);
                    const float gt = sigmoidf_(bf2f(p.yb[tok * NIN + C_NG + hh * 3 + mode])) / lr;
#pragma unroll
                    for (int dt = 0; dt < 4; ++dt) {
                        const long oi = tok * 512 + hh * 64 + dt * 16 + c;
                        const float v = ynf[oi] + gt * o[r][dt][rr];
                        if (mode == 1) ynf[oi] = v;
                        else p.ynsa[oi] = f2bf(v);
                    }
                }
            }
        }
    }
}
__device__ __forceinline__ void phase_nsa(const Params& p, unsigned* ctr) {
    WorkQ q; q.init(ctr);
    for (;;) {
        int it = q.next();
        if (it >= 1024) break;
        item_nsa(p, it);
    }
}

__device__ __forceinline__ void phase_br(const Params& p, int l, unsigned* ctr) {
    const int tid = threadIdx.x;
    const int total = (TT / 128) * 8;
    WorkQ q; q.init(ctr);
    for (;;) {
        int it = q.next();
        if (it >= total) break;
        const int mt = it >> 3, nt = it & 7, m0 = mt * 128, n0 = nt * 128;
        const u16* ap[4]; const u16* bp[4];
        f32x4 acc1[4][4], acc2[4][4];
        acc_zero(acc1); acc_zero(acc2);
#pragma unroll
        for (int i = 0; i < 4; ++i) {
            int r = (tid >> 3) + 32 * i;
            ap[i] = p.ysb + (long)(m0 + r) * 512;
            bp[i] = p.wt_brs + ((long)l * 1024 + n0 + r) * 512;
        }
        gemm_main(acc1, ap, bp, 512, KId());
#pragma unroll
        for (int i = 0; i < 4; ++i) {
            int r = (tid >> 3) + 32 * i;
            ap[i] = p.ynsa + (long)(m0 + r) * 512;
            bp[i] = p.wt_brn + ((long)l * 1024 + n0 + r) * 512;
        }
        gemm_main(acc2, ap, bp, 512, KId());
        EPI_COORDS
#pragma unroll
        for (int i = 0; i < 4; ++i)
#pragma unroll
            for (int j = 0; j < 4; ++j) {
                const int m = m0 + EPI_M(j), n = n0 + EPI_N(i);
                const uint2 ga = *(const uint2*)(p.yb + (long)m * NIN + C_GSB + n);
                const uint2 gb = *(const uint2*)(p.yb + (long)m * NIN + C_GNSA + n);
                float g1[4] = {bf2f((u16)(ga.x & 0xffff)), bf2f((u16)(ga.x >> 16)), bf2f((u16)(ga.y & 0xffff)), bf2f((u16)(ga.y >> 16))};
                float g2[4] = {bf2f((u16)(gb.x & 0xffff)), bf2f((u16)(gb.x >> 16)), bf2f((u16)(gb.y & 0xffff)), bf2f((u16)(gb.y >> 16))};
                float v[4];
#pragma unroll
                for (int r = 0; r < 4; ++r) v[r] = sigmoidf_(g1[r]) * acc1[i][j][r] + sigmoidf_(g2[r]) * acc2[i][j][r];
                st_bf4(p.merged + (long)m * 1024 + n, v[0], v[1], v[2], v[3]);
            }
    }
}
__device__ __forceinline__ void phase_wo(const Params& p, int l, unsigned* ctr) {
    const int tid = threadIdx.x;
    const int total = (TT / 128) * 8;
    WorkQ q; q.init(ctr);
    for (;;) {
        int it = q.next();
        if (it >= total) break;
        const int mt = it >> 3, nt = it & 7, m0 = mt * 128, n0 = nt * 128;
        const u16* ap[4]; const u16* bp[4];
        f32x4 acc[4][4]; acc_zero(acc);
#pragma unroll
        for (int i = 0; i < 4; ++i) {
            int r = (tid >> 3) + 32 * i;
            ap[i] = p.merged + (long)(m0 + r) * 1024;
            bp[i] = p.wt_o + ((long)l * 1024 + n0 + r) * 1024;
        }
        gemm_main(acc, ap, bp, 1024, KId());
        EPI_COORDS
#pragma unroll
        for (int i = 0; i < 4; ++i)
#pragma unroll
            for (int j = 0; j < 4; ++j) {
                const int m = m0 + EPI_M(j), n = n0 + EPI_N(i);
                const float4 hv = *(const float4*)(p.hf + (long)m * 1024 + n);
                float4 o;
                o.x = DN_ALPHA * hv.x + acc[i][j][0]; o.y = DN_ALPHA * hv.y + acc[i][j][1];
                o.z = DN_ALPHA * hv.z + acc[i][j][2]; o.w = DN_ALPHA * hv.w + acc[i][j][3];
                *(float4*)(p.pre1 + (long)m * 1024 + n) = o;
            }
    }
}
__device__ __forceinline__ float wave_sum(float v) {
#pragma unroll
    for (int s = 32; s >= 1; s >>= 1) v += __shfl_xor(v, s);
    return v;
}
__device__ __forceinline__ void phase_ln(const Params& p, int l, int mode, unsigned* ctr) {
    const int lane = threadIdx.x & 63, wave = threadIdx.x >> 6;
    const float* gam = (mode == 1 ? p.ln1_g : p.ln2_g) + l * 1024;
    const float* bet = (mode == 1 ? p.ln1_b : p.ln2_b) + l * 1024;
    WorkQ q; q.init(ctr);
    for (;;) {
        int it = q.next();
        if (it >= TT / 64) break;
        for (int rr = 0; rr < 16; ++rr) {
            const long row = (long)it * 64 + wave * 16 + rr;
            float v[16];
#pragma unroll
            for (int i = 0; i < 4; ++i) {
                const int col = i * 256 + lane * 4;
                float4 a;
                if (mode == 1) a = *(const float4*)(p.pre1 + row * 1024 + col);
                else {
                    a = *(const float4*)(p.h1f + row * 1024 + col);
                    a.x *= DN_ALPHA; a.y *= DN_ALPHA; a.z *= DN_ALPHA; a.w *= DN_ALPHA;
                    const uint2 pl = *(const uint2*)(p.ple + row * 1024 + col);
                    a.x += bf2f((u16)(pl.x & 0xffff)); a.y += bf2f((u16)(pl.x >> 16));
                    a.z += bf2f((u16)(pl.y & 0xffff)); a.w += bf2f((u16)(pl.y >> 16));
#pragma unroll
                    for (int s = 0; s < 4; ++s) {
                        const uint2 y = *(const uint2*)(p.y4 + (row * 4 + s) * 1024 + col);
                        a.x += bf2f((u16)(y.x & 0xffff)); a.y += bf2f((u16)(y.x >> 16));
                        a.z += bf2f((u16)(y.y & 0xffff)); a.w += bf2f((u16)(y.y >> 16));
                    }
                }
                v[i * 4 + 0] = a.x; v[i * 4 + 1] = a.y; v[i * 4 + 2] = a.z; v[i * 4 + 3] = a.w;
            }
            float s = 0.f;
#pragma unroll
            for (int i = 0; i < 16; ++i) s += v[i];
            const float mean = wave_sum(s) * (1.f / 1024.f);
            float s2 = 0.f;
#pragma unroll
            for (int i = 0; i < 16; ++i) { v[i] -= mean; s2 += v[i] * v[i]; }
            const float rstd = rsqrtf(wave_sum(s2) * (1.f / 1024.f) + 1e-5f);
#pragma unroll
            for (int i = 0; i < 4; ++i) {
                const int col = i * 256 + lane * 4;
                const float4 gg = *(const float4*)(gam + col), bb = *(const float4*)(bet + col);
                float4 y;
                y.x = v[i * 4 + 0] * rstd * gg.x + bb.x; y.y = v[i * 4 + 1] * rstd * gg.y + bb.y;
                y.z = v[i * 4 + 2] * rstd * gg.z + bb.z; y.w = v[i * 4 + 3] * rstd * gg.w + bb.w;
                if (mode == 1) {
                    *(float4*)(p.h1f + row * 1024 + col) = y;
                    const u16 h0 = f2bf(y.x), h1 = f2bf(y.y), h2 = f2bf(y.z), h3 = f2bf(y.w);
                    uint2 u; u.x = (unsigned)h0 | ((unsigned)h1 << 16); u.y = (unsigned)h2 | ((unsigned)h3 << 16);
                    *(uint2*)(p.h1b + row * 1024 + col) = u;
                    st_bf4(p.h1lo + row * 1024 + col, y.x - bf2f(h0), y.y - bf2f(h1), y.z - bf2f(h2), y.w - bf2f(h3));
                } else {
                    if (l == 3) *(float4*)(p.out + row * 1024 + col) = y;
                    else {
                        *(float4*)(p.hf + row * 1024 + col) = y;
                        st_bf4(p.hb + row * 1024 + col, y.x, y.y, y.z, y.w);
                    }
                }
            }
        }
    }
}
struct KRouter {
    long dlo;
    __device__ __forceinline__ long operator()(int k) const { return (k < 2048) ? (long)(k & 1023) : (dlo + (k - 2048)); }
};
__device__ __forceinline__ void phase_router_ple(const Params& p, int l, unsigned* ctr) {
    const int tid = threadIdx.x;
    const int n_r = TT / 128, total = n_r + (TT / 128) * 8;
    WorkQ q; q.init(ctr);
    for (;;) {
        int it = q.next();
        if (it >= total) break;
        const u16* ap[4]; const u16* bp[4];
        if (it < n_r) {
            const int m0 = it * 128;
            f32x4 acc[4][4]; acc_zero(acc);
#pragma unroll
            for (int i = 0; i < 4; ++i) {
                int r = (tid >> 3) + 32 * i;
                ap[i] = p.h1b + (long)(m0 + r) * 1024;
                bp[i] = p.wt_r + ((long)l * 32 + (r & 31)) * 3072;
            }
            KRouter kr; kr.dlo = (long)(p.h1lo - p.h1b);
            gemm_main(acc, ap, bp, 3072, kr);
            EPI_COORDS
#pragma unroll
            for (int i = 0; i < 4; ++i)
#pragma unroll
                for (int j = 0; j < 4; ++j) {
                    const int m = m0 + EPI_M(j), n = EPI_N(i);
                    if (n < 32) {
                        const float4 bb = *(const float4*)(p.b_router + l * 32 + n);
                        float4 o; o.x = acc[i][j][0] + bb.x; o.y = acc[i][j][1] + bb.y; o.z = acc[i][j][2] + bb.z; o.w = acc[i][j][3] + bb.w;
                        *(float4*)(p.logits + (long)m * 32 + n) = o;
                    }
                }
        } else {
            const int e = it - n_r;
            const int mt = e >> 3, nt = e & 7, m0 = mt * 128, n0 = nt * 128;
            f32x4 acc1[4][4], acc2[4][4];
            acc_zero(acc1); acc_zero(acc2);
#pragma unroll
            for (int i = 0; i < 4; ++i) {
                int r = (tid >> 3) + 32 * i;
                ap[i] = p.h1b + (long)(m0 + r) * 1024;
                bp[i] = p.wt_pg + ((long)l * 1024 + n0 + r) * 1024;
            }
            gemm_main(acc1, ap, bp, 1024, KId());
#pragma unroll
            for (int i = 0; i < 4; ++i) {
                int r = (tid >> 3) + 32 * i;
                ap[i] = p.pb + ((long)l * TT + m0 + r) * 256;
                bp[i] = p.wt_pp + ((long)l * 1024 + n0 + r) * 256;
            }
            gemm_main(acc2, ap, bp, 256, KId());
            EPI_COORDS
#pragma unroll
            for (int i = 0; i < 4; ++i)
#pragma unroll
                for (int j = 0; j < 4; ++j) {
                    const int m = m0 + EPI_M(j), n = n0 + EPI_N(i);
                    st_bf4(p.ple + (long)m * 1024 + n, sigmoidf_(acc1[i][j][0]) * acc2[i][j][0], sigmoidf_(acc1[i][j][1]) * acc2[i][j][1],
                           sigmoidf_(acc1[i][j][2]) * acc2[i][j][2], sigmoidf_(acc1[i][j][3]) * acc2[i][j][3]);
                }
        }
    }
}
__device__ __forceinline__ void phase_route(const Params& p, int l, unsigned* ctr) {
    const int tid = threadIdx.x;
    int* s_cnt = s_misc;
    int* s_base = s_misc + 32;
    WorkQ q; q.init(ctr);
    for (;;) {
        int it = q.next();
        if (it >= TT / 256) break;
        if (tid < 32) s_cnt[tid] = 0;
        __syncthreads();
        const int t = it * 256 + tid;
        float lg[32];
#pragma unroll
        for (int i = 0; i < 8; ++i) {
            const float4 v = *(const float4*)(p.logits + (long)t * 32 + i * 4);
            lg[i * 4 + 0] = v.x; lg[i * 4 + 1] = v.y; lg[i * 4 + 2] = v.z; lg[i * 4 + 3] = v.w;
        }
        unsigned taken = 0u;
        int ek[4]; float vk[4];
#pragma unroll
        for (int k = 0; k < 4; ++k) {
            float best = -3.0e38f; int bi = 0;
#pragma unroll
            for (int e = 0; e < 32; ++e) {
                const bool ok = !((taken >> e) & 1u) && (lg[e] > best);
                best = ok ? lg[e] : best;
                bi = ok ? e : bi;
            }
            taken |= 1u << bi;
            ek[k] = bi; vk[k] = best;
        }
        float wsum = 0.f;
        float v0 = -3.0e38f, v1 = 0.f, v2 = 0.f, v3 = 0.f;
#pragma unroll
        for (int e = 0; e < 32; ++e) {
            v0 = (e == ek[0]) ? lg[e] : v0;
            v1 = (e == ek[1]) ? lg[e] : v1;
            v2 = (e == ek[2]) ? lg[e] : v2;
            v3 = (e == ek[3]) ? lg[e] : v3;
        }
        vk[0] = 1.f; vk[1] = __expf(v1 - v0); vk[2] = __expf(v2 - v0); vk[3] = __expf(v3 - v0);
        wsum = vk[0] + vk[1] + vk[2] + vk[3];
        const float winv = 1.f / wsum;
        int lp[4];
#pragma unroll
        for (int k = 0; k < 4; ++k) lp[k] = atomicAdd(&s_cnt[ek[k]], 1);
        __syncthreads();
        if (tid < 32) s_base[tid] = (int)atomicAdd(&p.ecnt[l * 32 + tid], (unsigned)s_cnt[tid]);
        __syncthreads();
#pragma unroll
        for (int k = 0; k < 4; ++k) {
            const long idx = (long)ek[k] * TT + s_base[ek[k]] + lp[k];
            p.ent_id[idx] = t * 4 + k;
            p.ent_w[idx] = vk[k] * winv;
        }
    }
}
__device__ __forceinline__ void moe_prefix(const Params& p, int l) {
    __syncthreads();
    if (threadIdx.x == 0) {
        int acc = 0;
        for (int e = 0; e < 32; ++e) {
            const int n = (int)__hip_atomic_load(&p.ecnt[l * 32 + e], __ATOMIC_RELAXED, __HIP_MEMORY_SCOPE_AGENT);
            s_misc[e] = acc;
            s_misc[40 + e] = n;
            acc += (n + 127) >> 7;
        }
        s_misc[32] = acc;
    }
    __syncthreads();
}
__device__ __forceinline__ void phase_moe_gu(const Params& p, int l, unsigned* ctr) {
    const int tid = threadIdx.x;
    moe_prefix(p, l);
    const int total = s_misc[32] * 16;
    WorkQ q; q.init(ctr);
    for (;;) {
        int it = q.next();
        if (it >= total) break;
        const int mtg = it >> 4, nt = it & 15;
        int e = 0;
        for (int i = 1; i < 32; ++i) e = (s_misc[i] <= mtg) ? i : e;
        const int mt = mtg - s_misc[e], ne = s_misc[40 + e];
        const u16* ap[4]; const u16* bp[4];
#pragma unroll
        for (int i = 0; i < 4; ++i) {
            const int r = (tid >> 3) + 32 * i;
            int idx = mt * 128 + r; if (idx > ne - 1) idx = ne - 1;
            const int tok = p.ent_id[(long)e * TT + idx] >> 2;
            ap[i] = p.h1b + (long)tok * 1024;
            const int isup = (r >> 5) & 1, col = (r >> 6) * 32 + (r & 31);
            bp[i] = p.wt_gu + (((long)l * 32 + e) * 2048 + isup * 1024 + nt * 64 + col) * 1024;
        }
        f32x4 acc[4][4]; acc_zero(acc);
        gemm_main(acc, ap, bp, 1024, KId());
        EPI_COORDS
        const float* bg = p.b_gu + ((long)l * 32 + e) * 2048;
#pragma unroll
        for (int i = 0; i < 2; ++i)
#pragma unroll
            for (int j = 0; j < 4; ++j) {
                const long rowa = (long)mtg * 128 + EPI_M(j);
                const int col = nt * 64 + wn_ * 32 + i * 16 + (lane_ >> 4) * 4;
                float v[4];
#pragma unroll
                for (int r = 0; r < 4; ++r) {
                    float gate = acc[i][j][r] + bg[col + r];
                    float up = acc[i + 2][j][r] + bg[1024 + col + r];
                    gate = fminf(gate, 7.f);
                    up = fminf(fmaxf(up, -7.f), 7.f);
                    v[r] = (up + 1.f) * gate * sigmoidf_(1.702f * gate);
                }
                st_bf4(p.act + rowa * 1024 + col, v[0], v[1], v[2], v[3]);
            }
    }
}
__device__ __forceinline__ void phase_moe_down(const Params& p, int l, unsigned* ctr) {
    const int tid = threadIdx.x;
    moe_prefix(p, l);
    const int total = s_misc[32] * 8;
    WorkQ q; q.init(ctr);
    for (;;) {
        int it = q.next();
        if (it >= total) break;
        const int mtg = it >> 3, nt = it & 7;
        int e = 0;
        for (int i = 1; i < 32; ++i) e = (s_misc[i] <= mtg) ? i : e;
        const int mt = mtg - s_misc[e], ne = s_misc[40 + e];
        const u16* ap[4]; const u16* bp[4];
#pragma unroll
        for (int i = 0; i < 4; ++i) {
            const int r = (tid >> 3) + 32 * i;
            ap[i] = p.act + ((long)mtg * 128 + r) * 1024;
            bp[i] = p.wt_dn + (((long)l * 32 + e) * 1024 + nt * 128 + r) * 1024;
        }
        f32x4 acc[4][4]; acc_zero(acc);
        gemm_main(acc, ap, bp, 1024, KId());
        EPI_COORDS
        const float* bd = p.b_down + ((long)l * 32 + e) * 1024;
#pragma unroll
        for (int j = 0; j < 4; ++j) {
            const int idx = mt * 128 + EPI_M(j);
            if (idx < ne) {
                const int id = p.ent_id[(long)e * TT + idx];
                const float cw = p.ent_w[(long)e * TT + idx];
#pragma unroll
                for (int i = 0; i < 4; ++i) {
                    const int n = nt * 128 + EPI_N(i);
                    const float4 bb = *(const float4*)(bd + n);
                    st_bf4(p.y4 + (long)id * 1024 + n, cw * (acc[i][j][0] + bb.x), cw * (acc[i][j][1] + bb.y),
                           cw * (acc[i][j][2] + bb.z), cw * (acc[i][j][3] + bb.w));
                }
            }
        }
    }
}

#ifndef PH0_EN
#define PH0_EN 1
#endif
__device__ __forceinline__ void run_phase(const Params& p, int ph) {
    unsigned* ctr = p.ctr + ph;
    if (ph == 0) { if (PH0_EN) phase_prologue(p, ctr); return; }
    const int l = (ph - 1) / NPH_LAYER, s = (ph - 1) % NPH_LAYER;
#ifndef ONLY_S
#define ONLY_S -1
#endif
#define PH_EN(x) (ONLY_S < 0 || ONLY_S == (x))
    if (PH_EN(0) && s == 0) phase_gemm_in(p, l, ctr);
    if (PH_EN(1) && s == 1) phase_cmp1_sb(p, l, ctr);
    if (PH_EN(2) && s == 2) phase_cmp2(p, l, ctr);
    if (PH_EN(3) && s == 3) phase_nsa(p, ctr);
    if (PH_EN(4) && s == 4) phase_br(p, l, ctr);
    if (PH_EN(5) && s == 5) phase_wo(p, l, ctr);
    if (PH_EN(6) && s == 6) phase_ln(p, l, 1, ctr);
    if (PH_EN(7) && s == 7) phase_router_ple(p, l, ctr);
    if (PH_EN(8) && s == 8) phase_route(p, l, ctr);
    if (PH_EN(9) && s == 9) phase_moe_gu(p, l, ctr);
    if (PH_EN(10) && s == 10) phase_moe_down(p, l, ctr);
    if (PH_EN(11) && s == 11) phase_ln(p, l, 2, ctr);
}

__global__ void __launch_bounds__(256, 1) mega_kernel(Params p, int ph0, int ph1) {
    __shared__ uint4 xb_words;
    if (threadIdx.x == 0) xb_words = make_uint4(0u, 0u, 0u, 0u);
    __syncthreads();
    __shared__ Params s_p;
    if (threadIdx.x == 0) {
        const void* const* src_ = (const void* const*)&p;
        const void** dst_ = (const void**)&s_p;
#pragma unroll
        for (int i = 0; i < (int)(sizeof(Params) / sizeof(void*)); ++i) dst_[i] = src_[i];
    }
    __syncthreads();
    XcdBarrier bar = xcd_barrier_post(p.bar, (volatile LAS unsigned*)&xb_words);
    for (int ph = ph0; ph < ph1; ++ph) {
        if (ph > ph0) xcd_barrier(bar);
        asm volatile("" ::: "memory");
        run_phase(s_p, ph);
    }
}

#ifndef MK_SPLIT
#define MK_SPLIT 0
#endif

extern "C" void kernel_launch(void* const* d_in, const int* in_sizes, int n_in, void* d_out, int out_size, void* d_ws,
                              size_t ws_size, hipStream_t stream) {
    static int grid = 0;
    if (!grid) {
        int dev = 0, cus = 0, per_cu = 0;
        hipGetDevice(&dev);
        hipDeviceGetAttribute(&cus, hipDeviceAttributeMultiprocessorCount, dev);
        hipOccupancyMaxActiveBlocksPerMultiprocessor(&per_cu, mega_kernel, 256, 0);
        if (per_cu < 1) per_cu = 1;
        grid = cus * (per_cu < 2 ? per_cu : 2);
    }
    Params p;
    memset(&p, 0, sizeof(p));
    const float** pin = (const float**)&p;
    for (int i = 0; i < 21; ++i) pin[i] = (const float*)d_in[i];
    p.out = (float*)d_out;
    char* w = (char*)d_ws;
    size_t off = 0;
    auto take = [&](size_t bytes) { char* r = w + off; off += (bytes + 255) & ~(size_t)255; return r; };
    const size_t sync_bytes = (XCD_BAR_WORDS + 64 + 128) * sizeof(unsigned);
    p.bar = (unsigned*)take(sync_bytes);
    p.ctr = p.bar + XCD_BAR_WORDS;
    p.ecnt = p.ctr + 64;
    p.wt_in = (u16*)take((size_t)4 * NIN * 1024 * 2);
    p.wt_brs = (u16*)take((size_t)4 * 512 * 1024 * 2);
    p.wt_brn = (u16*)take((size_t)4 * 512 * 1024 * 2);
    p.wt_o = (u16*)take((size_t)4 * 1024 * 1024 * 2);
    p.wt_pg = (u16*)take((size_t)4 * 1024 * 1024 * 2);
    p.wt_pp = (u16*)take((size_t)4 * 256 * 1024 * 2);
    p.wt_gu = (u16*)take((size_t)128 * 2048 * 1024 * 2);
    p.wt_dn = (u16*)take((size_t)128 * 1024 * 1024 * 2);
    p.wt_c1 = (u16*)take((size_t)8 * 128 * 2048 * 2);
    p.wt_c2 = (u16*)take((size_t)8 * 64 * 128 * 2);
    p.wt_r = (u16*)take((size_t)4 * 32 * 3072 * 2);
    p.cbias = (float*)take(1024 * 4);
    p.hf = (float*)take((size_t)TT * 1024 * 4);
    p.pre1 = (float*)take((size_t)TT * 1024 * 4);
    p.h1f = (float*)take((size_t)TT * 1024 * 4);
    p.logits = (float*)take((size_t)TT * 32 * 4);
    p.ynf = (float*)take((size_t)TT * 512 * 4);
    p.ent_w = (float*)take((size_t)32 * TT * 4);
    p.hb = (u16*)take((size_t)TT * 1024 * 2);
    p.pb = (u16*)take((size_t)4 * TT * 256 * 2);
    p.yb = (u16*)take((size_t)TT * NIN * 2);
    p.ysb = (u16*)take((size_t)TT * 512 * 2);
    p.ynsa = (u16*)take((size_t)TT * 512 * 2);
    p.merged = (u16*)take((size_t)TT * 1024 * 2);
    p.h1b = (u16*)take((size_t)TT * 1024 * 2);
    p.h1lo = (u16*)take((size_t)TT * 1024 * 2);
    p.ple = (u16*)take((size_t)TT * 1024 * 2);
    p.hid = (u16*)take((size_t)2 * 2048 * 128 * 2);
    p.kvc = (u16*)take((size_t)2 * 2048 * 64 * 2);
    p.act = (u16*)take((size_t)(TT * 4 + 32 * 128) * 1024 * 2);
    p.y4 = (u16*)take((size_t)TT * 4 * 1024 * 2);
    p.ent_id = (int*)take((size_t)32 * TT * 4);
    if (off > ws_size) { fprintf(stderr, "workspace too small: need %zu have %zu\n", off, ws_size); return; }
    hipMemsetAsync(p.bar, 0, sync_bytes, stream);
#if MK_SPLIT
    for (int ph = 0; ph < NPHASE; ++ph) mega_kernel<<<dim3(grid), dim3(256), 0, stream>>>(p, ph, ph + 1);
#else
    mega_kernel<<<dim3(grid), dim3(256), 0, stream>>>(p, 0, NPHASE);
#endif
}
```

```cpp
#include <hip/hip_runtime.h>
#include <stdint.h>
#include <cstdio>
#include <cstring>
#include <cstdlib>
#include <vector>

#define XB_TMO      128
#define XB_XCNT(j)  (256  + 64 * (j))
#define XB_XSUB(j)  (1280 + 64 * (j))
#define XB_XGEN(j)  (2304 + 64 * (j))
#define XB_TOP      3328
#define XB_TOPGEN   3392
#define XCD_BAR_WORDS 3456
#define XB_SPIN_CAP (1u << 18)
#define LAS __attribute__((address_space(3)))

__device__ __forceinline__ unsigned xb_ld(unsigned* p)              { return __hip_atomic_load(p, __ATOMIC_RELAXED, __HIP_MEMORY_SCOPE_AGENT); }
__device__ __forceinline__ unsigned xb_add(unsigned* p, unsigned v) { return __hip_atomic_fetch_add(p, v, __ATOMIC_RELAXED, __HIP_MEMORY_SCOPE_AGENT); }
__device__ __forceinline__ unsigned xb_xcc_id() { return (unsigned)__builtin_amdgcn_s_getreg((3 << 11) | 20) & 0xFu; }
#define XB_SPIN(cond, bar) do { unsigned _sp = 0; while (cond) { __builtin_amdgcn_s_sleep(1); \
    if ((++_sp & 255u) == 0u) { if (xb_ld(&(bar)[XB_TMO])) break; if (_sp > XB_SPIN_CAP) { atomicAdd(&(bar)[XB_TMO], 1u); break; } } } } while (0)

struct XcdBarrier {
    unsigned* bar; unsigned x;
    volatile LAS unsigned* st;
};

__device__ __forceinline__ XcdBarrier xcd_barrier_post(unsigned* bar, volatile LAS unsigned* st) {
    XcdBarrier b; b.bar = bar; b.x = xb_xcc_id(); b.st = st;
    if (threadIdx.x == 0) (void)xb_add(&bar[XB_XCNT(b.x)], 1u);
    return b;
}
__device__ __forceinline__ void xcd_barrier_complete(unsigned* bar, unsigned x, unsigned& nloc, unsigned& nx) {
    const unsigned G = gridDim.x * gridDim.y * gridDim.z;
    unsigned sum, cnt, mine, sp = 0u;
    for (;;) {
        sum = 0u; cnt = 0u; mine = 0u;
#pragma unroll
        for (unsigned j = 0; j < 16; ++j) { const unsigned c = xb_ld(&bar[XB_XCNT(j)]); sum += c; cnt += (c > 0u) ? 1u : 0u; mine = (j == x) ? c : mine; }
        if (sum == G) break;
        __builtin_amdgcn_s_sleep(1);
        if ((++sp & 255u) == 0u) { if (xb_ld(&bar[XB_TMO])) break; if (sp > XB_SPIN_CAP) { atomicAdd(&bar[XB_TMO], 1u); break; } }
    }
    nloc = mine > 0u ? mine : 1u; nx = cnt > 0u ? cnt : 1u;
}

__device__ __forceinline__ void xcd_barrier(const XcdBarrier& b) {
    asm volatile("s_waitcnt vmcnt(0)" ::: "memory");
    __syncthreads();
    if (threadIdx.x == 0) {
        unsigned* bar = b.bar;
        __builtin_amdgcn_s_waitcnt(0);
        unsigned nloc = b.st[0], nx = b.st[1];
        if (nloc == 0u) { xcd_barrier_complete(bar, b.x, nloc, nx); b.st[0] = nloc; b.st[1] = nx; }
        const unsigned old = xb_add(&bar[XB_XSUB(b.x)], 1u);
        const unsigned gen = old / nloc;
        if (old + 1u == (gen + 1u) * nloc) {
            __builtin_amdgcn_fence(__ATOMIC_RELEASE, "agent");
            asm volatile("s_waitcnt vmcnt(0)" ::: "memory");
            const unsigned og = xb_add(&bar[XB_TOP], 1u);
            const unsigned tg = og / nx;
            if (og + 1u == (tg + 1u) * nx) xb_add(&bar[XB_TOPGEN], 1u);
            else XB_SPIN(xb_ld(&bar[XB_TOPGEN]) == tg, bar);
            __builtin_amdgcn_fence(__ATOMIC_ACQUIRE, "agent");
            xb_add(&bar[XB_XGEN(b.x)], 1u);
            asm volatile("s_waitcnt vmcnt(0)" ::: "memory");
        } else {
            XB_SPIN(xb_ld(&bar[XB_XGEN(b.x)]) == gen, bar);
            __builtin_amdgcn_fence(__ATOMIC_ACQUIRE, "agent");
            asm volatile("s_waitcnt vmcnt(0)" ::: "memory");
        }
    }
    __syncthreads();
}


typedef unsigned short u16;
typedef __attribute__((ext_vector_type(8))) short bf16x8;
typedef __attribute__((ext_vector_type(4))) float f32x4;
typedef __attribute__((ext_vector_type(4))) unsigned u32x4;
#define MFMA(a, b, c) __builtin_amdgcn_mfma_f32_16x16x32_bf16(a, b, c, 0, 0, 0)

#define TT 32768
#define SS 4096
#define DD 1024
#define NIN 4888
#define C_SBQ 0
#define C_SBK 512
#define C_SBV 1024
#define C_NQ 1536
#define C_KC 2048
#define C_VC 2176
#define C_KS 2304
#define C_VS 2432
#define C_KW 2560
#define C_VW 2688
#define C_NG 2816
#define C_GSB 2840
#define C_GNSA 3864
#define DN_ALPHA 1.681792830507429f
#define NPH_LAYER 12
#define NPHASE (1 + 4 * NPH_LAYER)
#define KSTR 72
#define VSTR 136
#define SSTR 68

struct Params {
    const float *x, *p, *w_in, *w_cmp1, *w_cmp2, *pe_cmp, *w_br_sb, *w_br_nsa, *w_o, *ln1_g, *ln1_b, *ln2_g, *ln2_b,
        *w_router, *b_router, *w_gu, *b_gu, *w_down, *b_down, *w_ple_gate, *w_ple_proj;
    float* out;
    unsigned *bar, *ctr, *ecnt;
    u16 *wt_in, *wt_brs, *wt_brn, *wt_o, *wt_pg, *wt_pp, *wt_gu, *wt_dn, *wt_c1, *wt_c2, *wt_r;
    float *cbias, *hf, *pre1, *h1f, *logits, *ynf, *ent_w;
    u16 *hb, *pb, *yb, *ysb, *ynsa, *merged, *h1b, *h1lo, *ple, *hid, *kvc, *act, *y4;
    int* ent_id;
};

__device__ __forceinline__ u16 f2bf(float f) {
    unsigned u = __float_as_uint(f);
    u += 0x7fffu + ((u >> 16) & 1u);
    return (u16)(u >> 16);
}
__device__ __forceinline__ float bf2f(u16 h) { return __uint_as_float(((unsigned)h) << 16); }
__device__ __forceinline__ void st_bf4(u16* p, float a, float b, float c, float d) {
    uint2 u;
    u.x = (unsigned)f2bf(a) | ((unsigned)f2bf(b) << 16);
    u.y = (unsigned)f2bf(c) | ((unsigned)f2bf(d) << 16);
    *(uint2*)p = u;
}
__device__ __forceinline__ float sigmoidf_(float x) { return 1.f / (1.f + __expf(-x)); }

__shared__ __attribute__((aligned(16))) unsigned char g_smem[62464];
__shared__ int s_item;
__shared__ int s_misc[80];
__shared__ unsigned long long s_mask[4][16];
__shared__ unsigned long long s_union[4];

struct WorkQ {
    unsigned* ctr;
    int nxt;
    __device__ __forceinline__ void init(unsigned* c) {
        ctr = c;
        nxt = 0;
        if (threadIdx.x == 0) nxt = (int)atomicAdd(ctr, 1u);
    }
    __device__ __forceinline__ int next() {
        __syncthreads();
        if (threadIdx.x == 0) s_item = nxt;
        __syncthreads();
        int it = s_item;
        if (threadIdx.x == 0) nxt = (int)atomicAdd(ctr, 1u);
        return it;
    }
};

struct Ctx {
    int tid__;
struct KId {
    __device__ __forceinline__ long operator()(int k) const { return k; }
};
template <class KOA>
__device__ __forceinline__ void gemm_main(f32x4 (&acc)[4][4], const u16* (&ap)[4], const u16* (&bp)[4], int K, KOA koa) {
    u16* sA = (u16*)g_smem;
    u16* sB = sA + 128 * KSTR;
    const int tid = tid__, lane = tid & 63, wave = tid >> 6;
    const int wn = wave & 1, wm = wave >> 1;
    const int kc = (tid & 7) * 8;
    const int lrow = tid >> 3;
    u32x4 ra[4], rb[4];
    {
        const long oa = koa(kc);
#pragma unroll
        for (int i = 0; i < 4; ++i) {
            ra[i] = *(const u32x4*)(ap[i] + oa);
            rb[i] = *(const u32x4*)(bp[i] + kc);
        }
    }
    for (int k0 = 0; k0 < K; k0 += 64) {
        __syncthreads();
#pragma unroll
        for (int i = 0; i < 4; ++i) {
            *(u32x4*)(sA + (lrow + 32 * i) * KSTR + kc) = ra[i];
            *(u32x4*)(sB + (lrow + 32 * i) * KSTR + kc) = rb[i];
        }
        __syncthreads();
        if (k0 + 64 < K) {
            const long oa = koa(k0 + 64 + kc);
#pragma unroll
            for (int i = 0; i < 4; ++i) {
                ra[i] = *(const u32x4*)(ap[i] + oa);
                rb[i] = *(const u32x4*)(bp[i] + (k0 + 64 + kc));
            }
        }
#pragma unroll
        for (int ks = 0; ks < 2; ++ks) {
            bf16x8 af[4], bfr[4];
#pragma unroll
            for (int j = 0; j < 4; ++j)
                af[j] = *(const bf16x8*)(sA + (wm * 64 + j * 16 + (lane & 15)) * KSTR + ks * 32 + (lane >> 4) * 8);
#pragma unroll
            for (int i = 0; i < 4; ++i)
                bfr[i] = *(const bf16x8*)(sB + (wn * 64 + i * 16 + (lane & 15)) * KSTR + ks * 32 + (lane >> 4) * 8);
#pragma unroll
            for (int i = 0; i < 4; ++i)
#pragma unroll
                for (int j = 0; j < 4; ++j) acc[i][j] = MFMA(bfr[i], af[j], acc[i][j]);
        }
    }
}
__device__ __forceinline__ void acc_zero(f32x4 (&acc)[4][4]) {
#pragma unroll
    for (int i = 0; i < 4; ++i)
#pragma unroll
        for (int j = 0; j < 4; ++j) acc[i][j] = f32x4{0.f, 0.f, 0.f, 0.f};
}
#define EPI_COORDS                                         \
    const int lane_ = tid__ & 63, wave_ = tid__ >> 6; \
    const int wn_ = wave_ & 1, wm_ = wave_ >> 1;
#define EPI_M(j) (wm_ * 64 + (j) * 16 + (lane_ & 15))
#define EPI_N(i) (wn_ * 64 + (i) * 16 + (lane_ >> 4) * 4)

__device__ __forceinline__ void xjob(const Params& p, int j, const float*& src, u16*& dst, int& nb, int& K, int& N) {
    switch (j) {
        case 0: src = p.w_in; dst = p.wt_in; nb = 4; K = 1024; N = NIN; break;
        case 1: src = p.w_br_sb; dst = p.wt_brs; nb = 4; K = 512; N = 1024; break;
        case 2: src = p.w_br_nsa; dst = p.wt_brn; nb = 4; K = 512; N = 1024; break;
        case 3: src = p.w_o; dst = p.wt_o; nb = 4; K = 1024; N = 1024; break;
        case 4: src = p.w_ple_gate; dst = p.wt_pg; nb = 4; K = 1024; N = 1024; break;
        case 5: src = p.w_ple_proj; dst = p.wt_pp; nb = 4; K = 256; N = 1024; break;
        case 6: src = p.w_gu; dst = p.wt_gu; nb = 128; K = 1024; N = 2048; break;
        case 7: src = p.w_down; dst = p.wt_dn; nb = 128; K = 1024; N = 1024; break;
        case 8: src = p.w_cmp1; dst = p.wt_c1; nb = 8; K = 2048; N = 128; break;
        default: src = p.w_cmp2; dst = p.wt_c2; nb = 8; K = 128; N = 64; break;
    }
}
__device__ __forceinline__ int xjob_tiles(int nb, int K, int N) { return nb * (K / 64) * ((N + 63) / 64); }

__device__ __forceinline__ void phase_prologue(const Params& p, unsigned* ctr) {
    const int tid = tid__;
    int ntr = 0;
    for (int j = 0; j < 10; ++j) {
        const float* s; u16* d; int nb, K, N;
        xjob(p, j, s, d, nb, K, N);
        ntr += xjob_tiles(nb, K, N);
    }
    const int n_x = TT * DD / 8192, n_p = 4 * TT * 256 / 8192, n_r = 16, n_b = 4;
    const int total = ntr + n_x + n_p + n_r + n_b;
    float* st = (float*)g_smem;
    WorkQ q; q.init(ctr);
    for (;;) {
        int it = q.next();
        if (it >= total) break;
        if (it < ntr) {
            const float* src = nullptr; u16* dst = nullptr; int nb = 0, K = 0, N = 0;
            int rem = it;
            for (int j = 0; j < 10; ++j) {
                xjob(p, j, src, dst, nb, K, N);
                int nt = xjob_tiles(nb, K, N);
                if (rem < nt) break;
                rem -= nt;
            }
            const int ktn = K / 64, ntn = (N + 63) / 64;
            const int tpm = ktn * ntn;
            const int b = rem / tpm; rem -= b * tpm;
            const int kt = rem % ktn, nt = rem / ktn;
            src += (long)b * K * N; dst += (long)b * K * N;
            const int k0 = kt * 64, n0 = nt * 64;
#pragma unroll
            for (int i = 0; i < 4; ++i) {
                int k = (tid >> 4) + 16 * i, n = (tid & 15) * 4;
                float4 v = make_float4(0.f, 0.f, 0.f, 0.f);
                if (n0 + n < N) v = *(const float4*)(src + (long)(k0 + k) * N + n0 + n);
                st[k * 65 + n + 0] = v.x; st[k * 65 + n + 1] = v.y; st[k * 65 + n + 2] = v.z; st[k * 65 + n + 3] = v.w;
            }
            __syncthreads();
#pragma unroll
            for (int i = 0; i < 2; ++i) {
                int n = (tid >> 3) + 32 * i, k8 = (tid & 7) * 8;
                if (n0 + n < N) {
                    uint4 u;
                    u.x = (unsigned)f2bf(st[(k8 + 0) * 65 + n]) | ((unsigned)f2bf(st[(k8 + 1) * 65 + n]) << 16);
                    u.y = (unsigned)f2bf(st[(k8 + 2) * 65 + n]) | ((unsigned)f2bf(st[(k8 + 3) * 65 + n]) << 16);
                    u.z = (unsigned)f2bf(st[(k8 + 4) * 65 + n]) | ((unsigned)f2bf(st[(k8 + 5) * 65 + n]) << 16);
                    u.w = (unsigned)f2bf(st[(k8 + 6) * 65 + n]) | ((unsigned)f2bf(st[(k8 + 7) * 65 + n]) << 16);
                    *(uint4*)(dst + (long)(n0 + n) * K + k0 + k8) = u;
                }
            }
        } else if (it < ntr + n_x + n_p) {
            int e = it - ntr;
            const float* src; u16* db; float* df = nullptr;
            if (e < n_x) { src = p.x + (long)e * 8192; db = p.hb + (long)e * 8192; df = p.hf + (long)e * 8192; }
            else { e -= n_x; src = p.p + (long)e * 8192; db = p.pb + (long)e * 8192; }
#pragma unroll
            for (int i = 0; i < 8; ++i) {
                int o = i * 1024 + tid * 4;
                float4 v = *(const float4*)(src + o);
                if (df) *(float4*)(df + o) = v;
                st_bf4(db + o, v.x, v.y, v.z, v.w);
            }
        } else if (it < ntr + n_x + n_p + n_r) {
            int e0 = (it - ntr - n_x - n_p) * 8192;
            for (int i = 0; i < 32; ++i) {
                int idx = e0 + i * 256 + tid;
                int k = idx & 1023, le = idx >> 10, e = le & 31, l = le >> 5;
                float w = p.w_router[((long)l * 1024 + k) * 32 + e];
                u16 hi = f2bf(w); u16 lo = f2bf(w - bf2f(hi));
                u16* d = p.wt_r + (long)le * 3072;
                d[k] = hi; d[1024 + k] = lo; d[2048 + k] = hi;
            }
        } else {
            int o = (it - ntr - n_x - n_p - n_r) * 256 + tid;
            int lk = o >> 7, h = o & 127;
            const float* pe = p.pe_cmp + (long)lk * 2048;
            const float* w1 = p.w_cmp1 + (long)lk * 2048 * 128 + h;
            float s = 0.f;
            for (int j = 0; j < 2048; ++j) s += pe[j] * w1[(long)j * 128];
            p.cbias[o] = s;
        }
    }
}

__device__ __forceinline__ void phase_gemm_in(const Params& p, int l, unsigned* ctr) {
    const int NTN = (NIN + 127) / 128;
    const int total = (TT / 128) * NTN;
    const int tid = tid__;
    const u16* W = p.wt_in + (long)l * NIN * 1024;
    WorkQ q; q.init(ctr);
    for (;;) {
        int it = q.next();
        if (it >= total) break;
        const int mt = it / NTN, nt = it % NTN;
        const int m0 = mt * 128, n0 = nt * 128;
        const u16* ap[4]; const u16* bp[4];
#pragma unroll
        for (int i = 0; i < 4; ++i) {
            int r = (tid >> 3) + 32 * i;
            ap[i] = p.hb + (long)(m0 + r) * 1024;
            int n = n0 + r; if (n > NIN - 1) n = NIN - 1;
            bp[i] = W + (long)n * 1024;
        }
        f32x4 acc[4][4]; acc_zero(acc);
        gemm_main(acc, ap, bp, 1024, KId());
        EPI_COORDS
#pragma unroll
        for (int i = 0; i < 4; ++i)
#pragma unroll
            for (int j = 0; j < 4; ++j) {
                int m = m0 + EPI_M(j), n = n0 + EPI_N(i);
                if (n < NIN) st_bf4(p.yb + (long)m * NIN + n, acc[i][j][0], acc[i][j][1], acc[i][j][2], acc[i][j][3]);
            }
    }
}

struct KCmp {
    __device__ __forceinline__ long operator()(int k) const { return (long)(k >> 6) * NIN + (k & 63); }
};
__device__ __forceinline__ void tile_cmp1(const Params& p, int l, int it) {
    const int tid = tid__;
    const int kv = it >> 4, mt = it & 15;
    const u16* W = p.wt_c1 + (long)(l * 2 + kv) * 128 * 2048;
    const u16* ap[4]; const u16* bp[4];
#pragma unroll
    for (int i = 0; i < 4; ++i) {
        int r = (tid >> 3) + 32 * i;
        int mrow = mt * 128 + r;
        int c = mrow & 127, bg = mrow >> 7, g = bg & 1, b = bg >> 1;
        ap[i] = p.yb + (long)(b * SS + c * 32) * NIN + (kv ? C_VC : C_KC) + g * 64;
        bp[i] = W + (long)r * 2048;
    }
    f32x4 acc[4][4]; acc_zero(acc);
    gemm_main(acc, ap, bp, 2048, KCmp());
    EPI_COORDS
    const float* cb = p.cbias + (l * 2 + kv) * 128;
#pragma unroll
    for (int i = 0; i < 4; ++i)
#pragma unroll
        for (int j = 0; j < 4; ++j) {
            int m = mt * 128 + EPI_M(j), n = EPI_N(i);
            float v[4];
#pragma unroll
            for (int r = 0; r < 4; ++r) { float a = acc[i][j][r] + cb[n + r]; v[r] = a * sigmoidf_(a); }
            st_bf4(p.hid + ((long)kv * 2048 + m) * 128 + n, v[0], v[1], v[2], v[3]);
        }
}
__device__ __forceinline__ void phase_cmp2(const Params& p, int l, unsigned* ctr) {
    const int tid = tid__;
    WorkQ q; q.init(ctr);
    for (;;) {
        int it = q.next();
        if (it >= 32) break;
        const int kv = it >> 4, mt = it & 15;
        const u16* W = p.wt_c2 + (long)(l * 2 + kv) * 64 * 128;
        const u16* ap[4]; const u16* bp[4];
#pragma unroll
        for (int i = 0; i < 4; ++i) {
            int r = (tid >> 3) + 32 * i;
            ap[i] = p.hid + ((long)kv * 2048 + mt * 128 + r) * 128;
            bp[i] = W + (long)(r & 63) * 128;
        }
        f32x4 acc[4][4]; acc_zero(acc);
        gemm_main(acc, ap, bp, 128, KId());
        EPI_COORDS
#pragma unroll
        for (int i = 0; i < 4; ++i)
#pragma unroll
            for (int j = 0; j < 4; ++j) {
                int m = mt * 128 + EPI_M(j), n = EPI_N(i);
                if (n < 64) st_bf4(p.kvc + ((long)kv * 2048 + m) * 64 + n, acc[i][j][0], acc[i][j][1], acc[i][j][2], acc[i][j][3]);
            }
    }
}

struct AttnLds {
    u16* K;
    u16* Vt;
    float* S;
    u16* P;
};
__device__ __forceinline__ AttnLds attn_lds() {
    AttnLds a;
    a.K = (u16*)g_smem;
    a.Vt = (u16*)(g_smem + 18432);
    a.S = (float*)(g_smem + 18432 + 17408) + (tid__ >> 6) * 16 * SSTR;
    a.P = (u16*)(g_smem + 18432 + 17408 + 17408) + (tid__ >> 6) * 16 * KSTR;
    return a;
}
__device__ __forceinline__ void load_k_tile(u16* sK, int koff, const u16* base, long stride) {
    const int tid = tid__, key = tid >> 2, ch = (tid & 3) * 16;
    const u16* g = base + (long)key * stride + ch;
    uint4 a = *(const uint4*)g, b = *(const uint4*)(g + 8);
    *(uint4*)(sK + (koff + key) * KSTR + ch) = a;
    *(uint4*)(sK + (koff + key) * KSTR + ch + 8) = b;
}
__device__ __forceinline__ void load_v_tile(u16* sVt, int koff, const u16* base, long stride) {
    const int tid = tid__, key = tid & 63, d0 = (tid >> 6) * 16;
    const u16* g = base + (long)key * stride + d0;
    uint4 a = *(const uint4*)g, b = *(const uint4*)(g + 8);
    unsigned w[8] = {a.x, a.y, a.z, a.w, b.x, b.y, b.z, b.w};
#pragma unroll
    for (int i = 0; i < 8; ++i) {
        sVt[(d0 + 2 * i) * VSTR + koff + key] = (u16)(w[i] & 0xffffu);
        sVt[(d0 + 2 * i + 1) * VSTR + koff + key] = (u16)(w[i] >> 16);
    }
}
__device__ __forceinline__ void wave_qk(const AttnLds& L, int koff, const bf16x8 (&qf)[2]) {
    const int lane = tid__ & 63, quad = lane >> 4, c = lane & 15;
#pragma unroll
    for (int nt = 0; nt < 4; ++nt) {
        f32x4 a = {0.f, 0.f, 0.f, 0.f};
#pragma unroll
        for (int ks = 0; ks < 2; ++ks) {
            bf16x8 kf = *(const bf16x8*)(L.K + (koff + nt * 16 + c) * KSTR + ks * 32 + quad * 8);
            a = MFMA(qf[ks], kf, a);
        }
#pragma unroll
        for (int r = 0; r < 4; ++r) L.S[(quad * 4 + r) * SSTR + nt * 16 + c] = a[r];
    }
}
__device__ __forceinline__ void wave_pv(const AttnLds& L, int koff, f32x4 (&o)[4]) {
    const int lane = tid__ & 63, quad = lane >> 4, c = lane & 15;
#pragma unroll
    for (int ks = 0; ks < 2; ++ks) {
        bf16x8 pf = *(const bf16x8*)(L.P + c * KSTR + ks * 32 + quad * 8);
#pragma unroll
        for (int dt = 0; dt < 4; ++dt) {
            bf16x8 vf = *(const bf16x8*)(L.Vt + (dt * 16 + c) * VSTR + koff + ks * 32 + quad * 8);
            o[dt] = MFMA(pf, vf, o[dt]);
        }
    }
}
__device__ __forceinline__ void read_s16(const AttnLds& L, int row, int part, float (&z)[16]) {
#pragma unroll
    for (int i = 0; i < 4; ++i) {
        float4 v = *(const float4*)(L.S + row * SSTR + part * 16 + i * 4);
        z[i * 4 + 0] = v.x; z[i * 4 + 1] = v.y; z[i * 4 + 2] = v.z; z[i * 4 + 3] = v.w;
    }
}
__device__ __forceinline__ void write_p16(const AttnLds& L, int row, int part, const float (&pv)[16]) {
    uint4 a, b;
    a.x = (unsigned)f2bf(pv[0]) | ((unsigned)f2bf(pv[1]) << 16);
    a.y = (unsigned)f2bf(pv[2]) | ((unsigned)f2bf(pv[3]) << 16);
    a.z = (unsigned)f2bf(pv[4]) | ((unsigned)f2bf(pv[5]) << 16);
    a.w = (unsigned)f2bf(pv[6]) | ((unsigned)f2bf(pv[7]) << 16);
    b.x = (unsigned)f2bf(pv[8]) | ((unsigned)f2bf(pv[9]) << 16);
    b.y = (unsigned)f2bf(pv[10]) | ((unsigned)f2bf(pv[11]) << 16);
    b.z = (unsigned)f2bf(pv[12]) | ((unsigned)f2bf(pv[13]) << 16);
    b.w = (unsigned)f2bf(pv[14]) | ((unsigned)f2bf(pv[15]) << 16);
    *(uint4*)(L.P + row * KSTR + part * 16) = a;
    *(uint4*)(L.P + row * KSTR + part * 16 + 8) = b;
}
__device__ __forceinline__ float row4_max(float v) {
    v = fmaxf(v, __shfl_xor(v, 1));
    v = fmaxf(v, __shfl_xor(v, 2));
    return v;
}
__device__ __forceinline__ float row4_sum(float v) {
    v += __shfl_xor(v, 1);
    v += __shfl_xor(v, 2);
    return v;
}

__device__ __forceinline__ void item_sb(const Params& p, int it) {
    const int tid = tid__, lane = tid & 63, wave = tid >> 6, quad = lane >> 4, c = lane & 15;
    const int qb = it & 63, h = (it >> 6) & 7, b = it >> 9;
    const int t0 = qb * 64;
    AttnLds L = attn_lds();
    bf16x8 qf[2];
    {
        const u16* g = p.yb + (long)(b * SS + t0 + wave * 16 + c) * NIN + C_SBQ + h * 64 + quad * 8;
        qf[0] = *(const bf16x8*)g;
        qf[1] = *(const bf16x8*)(g + 32);
    }
    const int row = lane >> 2, part = lane & 3;
    const int t = t0 + wave * 16 + row;
    float R = 0.f;
    f32x4 o[4];
#pragma unroll
    for (int dt = 0; dt < 4; ++dt) o[dt] = f32x4{0.f, 0.f, 0.f, 0.f};
    for (int kb = qb; kb >= 0; --kb) {
        __syncthreads();
        const u16* kbase = p.yb + (long)(b * SS + kb * 64) * NIN + h * 64;
        load_k_tile(L.K, 0, kbase + C_SBK, NIN);
        load_v_tile(L.Vt, 0, kbase + C_SBV, NIN);
        __syncthreads();
        wave_qk(L, 0, qf);
        __syncthreads();
        float z[16], lat[16];
        read_s16(L, row, part, z);
        float run = 0.f;
#pragma unroll
        for (int i = 15; i >= 0; --i) {
            const int key = kb * 64 + part * 16 + i;
            const bool valid = key < t;
            const float zz = z[i] * 0.125f;
            const float sp = fmaxf(zz, 0.f) + __logf(1.f + __expf(-fabsf(zz)));
            lat[i] = run;
            z[i] = valid ? (zz - sp) : -1e30f;
            run += valid ? -sp : 0.f;
        }
        const int lb = lane & ~3;
        const float t0_ = __shfl(run, lb), t1_ = __shfl(run, lb + 1), t2_ = __shfl(run, lb + 2), t3_ = __shfl(run, lb + 3);
        float off = R;
        if (part < 3) off += t3_;
        if (part < 2) off += t2_;
        if (part < 1) off += t1_;
        float pv[16];
#pragma unroll
        for (int i = 0; i < 16; ++i) pv[i] = (z[i] > -1e29f) ? __expf(z[i] + lat[i] + off) : 0.f;
        write_p16(L, row, part, pv);
        R += (t0_ + t1_) + (t2_ + t3_);
        const int done = __syncthreads_and(R < -110.f);
        wave_pv(L, 0, o);
        if (done) break;
    }
#pragma unroll
    for (int dt = 0; dt < 4; ++dt)
#pragma unroll
        for (int r = 0; r < 4; ++r)
            p.ysb[(long)(b * SS + t0 + wave * 16 + quad * 4 + r) * 512 + h * 64 + dt * 16 + c] = f2bf(o[dt][r]);
}

__device__ __forceinline__ void phase_cmp1_sb(const Params& p, int l, unsigned* ctr) {
    const int total = 32 + 8 * 8 * 64;
    WorkQ q; q.init(ctr);
    for (;;) {
        int it = q.next();
        if (it >= total) break;
        if (it < 32) tile_cmp1(p, l, it);
        else item_sb(p, it - 32);
    }
}

template <int MODE>
__device__ __forceinline__ void nsa_step(const AttnLds& L, const bf16x8 (&qf)[2], f32x4 (&o)[4], float& m, float& l,
                                         float slope, int t, int kpos0, bool rowsel) {
    const int lane = tid__ & 63, quad = lane >> 4;
    const int row = lane >> 2, part = lane & 3;
    wave_qk(L, 0, qf);
    __syncthreads();
    float z[16];
    read_s16(L, row, part, z);
    float pm = -1e30f;
#pragma unroll
    for (int i = 0; i < 16; ++i) {
        const int dist = t - (kpos0 + part * 16 + i);
        bool valid = dist >= 0;
        if (MODE == 1) valid = valid && rowsel;
        if (MODE == 2) valid = valid && (dist < 512);
        z[i] = valid ? (z[i] * 0.125f - slope * (float)dist) : -1e30f;
        pm = fmaxf(pm, z[i]);
    }
    pm = row4_max(pm);
    const float mn = fmaxf(m, pm);
    const float alpha = __expf(m - mn);
    float ps = 0.f;
#pragma unroll
    for (int i = 0; i < 16; ++i) {
        z[i] = (z[i] > -1e29f) ? __expf(z[i] - mn) : 0.f;
        ps += z[i];
    }
    ps = row4_sum(ps);
    l = l * alpha + ps;
    m = mn;
    write_p16(L, row, part, z);
    float al[4];
#pragma unroll
    for (int r = 0; r < 4; ++r) al[r] = __shfl(alpha, (quad * 4 + r) * 4);
    __syncthreads();
#pragma unroll
    for (int dt = 0; dt < 4; ++dt)
#pragma unroll
        for (int r = 0; r < 4; ++r) o[dt][r] *= al[r];
    wave_pv(L, 0, o);
    __syncthreads();
}

__device__ __forceinline__ void item_nsa(const Params& p, int it) {
    const int tid = tid__, lane = tid & 63, wave = tid >> 6, quad = lane >> 4, c = lane & 15;
    const int qb = 63 - (it >> 4), bg = it & 15, g = bg & 1, b = bg >> 1;
    const int t0 = qb * 64;
    AttnLds L = attn_lds();
    const int row = lane >> 2, part = lane & 3;
    const int t = t0 + wave * 16 + row;
    const long tokbase = (long)b * SS + t0 + wave * 16;
    float* ynf = p.ynf;
    const int nct = (2 * qb + 2 > 64) ? 2 : 1;
    const int nv = (t + 1) >> 5;
    __syncthreads();
    for (int ct = 0; ct < nct; ++ct) {
        load_k_tile(L.K, ct * 64, p.kvc + ((long)(b * 2 + g) * 128 + ct * 64) * 64, 64);
        load_v_tile(L.Vt, ct * 64, p.kvc + ((long)2048 + (b * 2 + g) * 128 + ct * 64) * 64, 64);
    }
    __syncthreads();
    float imp[2][8];
#pragma unroll
    for (int a = 0; a < 2; ++a)
#pragma unroll
        for (int j = 0; j < 8; ++j) imp[a][j] = 0.f;
#pragma unroll 1
    for (int r = 0; r < 4; ++r) {
        const float slope = exp2f(-(float)(g * 4 + r + 1));
        float m = -1e30f, l = 0.f;
        bf16x8 qfa[2];
        {
            const u16* gq = p.yb + (tokbase + c) * NIN + C_NQ + (g * 4 + r) * 64 + quad * 8;
            qfa[0] = *(const bf16x8*)gq;
            qfa[1] = *(const bf16x8*)(gq + 32);
        }
        for (int ct = 0; ct < nct; ++ct) {
            wave_qk(L, ct * 64, qfa);
            __syncthreads();
            float z[16];
            read_s16(L, row, part, z);
            float pm = -1e30f;
#pragma unroll
            for (int i = 0; i < 16; ++i) {
                const int cc = ct * 64 + part * 16 + i;
                const bool valid = cc < nv;
                z[i] = valid ? (z[i] * 0.125f - slope * (float)(t - (cc * 32 + 31))) : -1e30f;
                pm = fmaxf(pm, z[i]);
            }
            pm = row4_max(pm);
            const float mn = fmaxf(m, pm);
            float ps = 0.f;
#pragma unroll
            for (int i = 0; i < 16; ++i) ps += (z[i] > -1e29f) ? __expf(z[i] - mn) : 0.f;
            ps = row4_sum(ps);
            l = l * __expf(m - mn) + ps;
            m = mn;
            __syncthreads();
        }
        const float inv = (l > 0.f) ? 1.f / l : 0.f;
        f32x4 o[4];
#pragma unroll
        for (int dt = 0; dt < 4; ++dt) o[dt] = f32x4{0.f, 0.f, 0.f, 0.f};
#pragma unroll 1
        for (int ct = 0; ct < nct; ++ct) {
            wave_qk(L, ct * 64, qfa);
            __syncthreads();
            float z[16];
            read_s16(L, row, part, z);
#pragma unroll
            for (int i = 0; i < 16; ++i) {
                const int cc = ct * 64 + part * 16 + i;
                const bool valid = cc < nv;
                const float s = z[i] * 0.125f - slope * (float)(t - (cc * 32 + 31));
                z[i] = valid ? __expf(s - m) * inv : 0.f;
            }
            const float f0 = (ct == 0) ? 1.f : 0.f, f1 = 1.f - f0;
#pragma unroll
            for (int j = 0; j < 8; ++j) {
                const float pr = z[2 * j] + z[2 * j + 1];
                imp[0][j] += f0 * pr;
                imp[1][j] += f1 * pr;
            }
            write_p16(L, row, part, z);
            __syncthreads();
            wave_pv(L, ct * 64, o);
            __syncthreads();
        }
#pragma unroll
        for (int rr = 0; rr < 4; ++rr) {
            const long tok = tokbase + quad * 4 + rr;
            const float gt = sigmoidf_(bf2f(p.yb[tok * NIN + C_NG + (g * 4 + r) * 3 + 0]));
#pragma unroll
            for (int dt = 0; dt < 4; ++dt) ynf[tok * 512 + (g * 4 + r) * 64 + dt * 16 + c] = gt * o[dt][rr];
        }
    }
#pragma unroll
    for (int a = 0; a < 2; ++a)
#pragma unroll
        for (int j = 0; j < 8; ++j) L.S[row * SSTR + a * 32 + part * 8 + j] = imp[a][j];
    __syncthreads();
    unsigned long long un = 0ull;
#ifndef NSA_NOTOPK
#define NSA_NOTOPK 0
#endif
#pragma unroll 1
    for (int rr = 0; rr < (NSA_NOTOPK ? 0 : 16); ++rr) {
        float v = L.S[rr * SSTR + lane];
        const bool forced = (lane == 0) || (lane == qb) || (lane == qb - 1);
        const bool validb = lane <= qb;
        v = forced ? 1e6f : (validb ? v : -1e30f);
        int rank = 0;
#pragma unroll 8
        for (int i = 0; i < 64; ++i) {
            const float vi = __shfl(v, i);
            rank += ((vi > v) || (vi == v && i < lane)) ? 1 : 0;
        }
        const unsigned long long mk = __ballot((rank < 16) && validb);
        if (lane == 0) s_mask[wave][rr] = mk;
        un |= mk;
    }
    if (lane == 0) s_union[wave] = un;
    __syncthreads();
    const unsigned long long rowmask = s_mask[wave][row];
    unsigned long long umask;
    {
        const unsigned long long um_ = s_union[0] | s_union[1] | s_union[2] | s_union[3];
        const unsigned lo_ = __builtin_amdgcn_readfirstlane((unsigned)um_), hi_ = __builtin_amdgcn_readfirstlane((unsigned)(um_ >> 32));
        umask = ((unsigned long long)hi_ << 32) | lo_;
    }
#ifndef NSA_HPB
#define NSA_HPB 1
#endif
#ifndef NSA_NOBC
#define NSA_NOBC 0
#endif
#pragma unroll 1
    for (int hp = 0; hp < (NSA_NOBC ? 0 : 4 / NSA_HPB); ++hp) {
#pragma unroll 1
        for (int mode = 1; mode <= 2; ++mode) {
            f32x4 o[NSA_HPB][4];
            float m[NSA_HPB], l[NSA_HPB];
#pragma unroll
            for (int r = 0; r < NSA_HPB; ++r) {
                m[r] = -1e30f; l[r] = 0.f;
#pragma unroll
                for (int dt = 0; dt < 4; ++dt) o[r][dt] = f32x4{0.f, 0.f, 0.f, 0.f};
            }
            const int kb_lo = (mode == 1) ? 0 : ((qb - 8 > 0) ? qb - 8 : 0);
            const int colk = (mode == 1) ? C_KS : C_KW, colv = (mode == 1) ? C_VS : C_VW;
            for (int kb = kb_lo; kb <= qb; ++kb) {
                if (mode == 1 && !((umask >> kb) & 1ull)) continue;
                const u16* kbase = p.yb + (long)(b * SS + kb * 64) * NIN + g * 64;
                bf16x8 qf[NSA_HPB][2];
#pragma unroll
                for (int r = 0; r < NSA_HPB; ++r) {
                    const u16* gq = p.yb + (tokbase + c) * NIN + C_NQ + (g * 4 + hp * NSA_HPB + r) * 64 + quad * 8;
                    qf[r][0] = *(const bf16x8*)gq;
                    qf[r][1] = *(const bf16x8*)(gq + 32);
                }
                load_k_tile(L.K, 0, kbase + colk, NIN);
                load_v_tile(L.Vt, 0, kbase + colv, NIN);
                __syncthreads();
                const bool rowsel = (rowmask >> kb) & 1ull;
#pragma unroll
                for (int r = 0; r < NSA_HPB; ++r) {
                    const float slope = exp2f(-(float)(g * 4 + hp * NSA_HPB + r + 1));
                    if (mode == 1) nsa_step<1>(L, qf[r], o[r], m[r], l[r], slope, t, kb * 64, rowsel);
                    else nsa_step<2>(L, qf[r], o[r], m[r], l[r], slope, t, kb * 64, rowsel);
                }
            }
#pragma unroll
            for (int r = 0; r < NSA_HPB; ++r) {
                const int hh = g * 4 + hp * NSA_HPB + r;
#pragma unroll
                for (int rr = 0; rr < 4; ++rr) {
                    const long tok = tokbase + quad * 4 + rr;
                    const float lr = __shfl(l[r], (quad * 4 + rr) * 4);
                    const float gt = sigmoidf_(bf2f(p.yb[tok * NIN + C_NG + hh * 3 + mode])) / lr;
#pragma unroll
                    for (int dt = 0; dt < 4; ++dt) {
                        const long oi = tok * 512 + hh * 64 + dt * 16 + c;
                        const float v = ynf[oi] + gt * o[r][dt][rr];
                        if (mode == 1) ynf[oi] = v;
                        else p.ynsa[oi] = f2bf(v);
                    }
                }
            }
        }
    }
}
__device__ __forceinline__ void phase_nsa(const Params& p, unsigned* ctr) {
    WorkQ q; q.init(ctr);
    for (;;) {
        int it = q.next();
        if (it >= 1024) break;
        item_nsa(p, it);
    }
}

__device__ __forceinline__ void phase_br(const Params& p, int l, unsigned* ctr) {
    const int tid = tid__;
    const int total = (TT / 128) * 8;
    WorkQ q; q.init(ctr);
    for (;;) {
        int it = q.next();
        if (it >= total) break;
        const int mt = it >> 3, nt = it & 7, m0 = mt * 128, n0 = nt * 128;
        const u16* ap[4]; const u16* bp[4];
        f32x4 acc[4][4];
        acc_zero(acc);
#pragma unroll
        for (int i = 0; i < 4; ++i) {
            int r = (tid >> 3) + 32 * i;
            ap[i] = p.ysb + (long)(m0 + r) * 512;
            bp[i] = p.wt_brs + ((long)l * 1024 + n0 + r) * 512;
        }
        gemm_main(acc, ap, bp, 512, KId());
        EPI_COORDS
#pragma unroll
        for (int i = 0; i < 4; ++i)
#pragma unroll
            for (int j = 0; j < 4; ++j) {
                const int m = m0 + EPI_M(j), n = n0 + EPI_N(i);
                const uint2 ga = *(const uint2*)(p.yb + (long)m * NIN + C_GSB + n);
                float4 o;
                o.x = sigmoidf_(bf2f((u16)(ga.x & 0xffff))) * acc[i][j][0];
                o.y = sigmoidf_(bf2f((u16)(ga.x >> 16))) * acc[i][j][1];
                o.z = sigmoidf_(bf2f((u16)(ga.y & 0xffff))) * acc[i][j][2];
                o.w = sigmoidf_(bf2f((u16)(ga.y >> 16))) * acc[i][j][3];
                *(float4*)(p.pre1 + (long)m * 1024 + n) = o;
            }
        acc_zero(acc);
#pragma unroll
        for (int i = 0; i < 4; ++i) {
            int r = (tid >> 3) + 32 * i;
            ap[i] = p.ynsa + (long)(m0 + r) * 512;
            bp[i] = p.wt_brn + ((long)l * 1024 + n0 + r) * 512;
        }
        gemm_main(acc, ap, bp, 512, KId());
#pragma unroll
        for (int i = 0; i < 4; ++i)
#pragma unroll
            for (int j = 0; j < 4; ++j) {
                const int m = m0 + EPI_M(j), n = n0 + EPI_N(i);
                const uint2 gb = *(const uint2*)(p.yb + (long)m * NIN + C_GNSA + n);
                const float4 st = *(const float4*)(p.pre1 + (long)m * 1024 + n);
                st_bf4(p.merged + (long)m * 1024 + n,
                       st.x + sigmoidf_(bf2f((u16)(gb.x & 0xffff))) * acc[i][j][0],
                       st.y + sigmoidf_(bf2f((u16)(gb.x >> 16))) * acc[i][j][1],
                       st.z + sigmoidf_(bf2f((u16)(gb.y & 0xffff))) * acc[i][j][2],
                       st.w + sigmoidf_(bf2f((u16)(gb.y >> 16))) * acc[i][j][3]);
            }
    }
}
__device__ __forceinline__ void phase_wo(const Params& p, int l, unsigned* ctr) {
    const int tid = tid__;
    const int total = (TT / 128) * 8;
    WorkQ q; q.init(ctr);
    for (;;) {
        int it = q.next();
        if (it >= total) break;
        const int mt = it >> 3, nt = it & 7, m0 = mt * 128, n0 = nt * 128;
        const u16* ap[4]; const u16* bp[4];
        f32x4 acc[4][4]; acc_zero(acc);
#pragma unroll
        for (int i = 0; i < 4; ++i) {
            int r = (tid >> 3) + 32 * i;
            ap[i] = p.merged + (long)(m0 + r) * 1024;
            bp[i] = p.wt_o + ((long)l * 1024 + n0 + r) * 1024;
        }
        gemm_main(acc, ap, bp, 1024, KId());
        EPI_COORDS
#pragma unroll
        for (int i = 0; i < 4; ++i)
#pragma unroll
            for (int j = 0; j < 4; ++j) {
                const int m = m0 + EPI_M(j), n = n0 + EPI_N(i);
                const float4 hv = *(const float4*)(p.hf + (long)m * 1024 + n);
                float4 o;
                o.x = DN_ALPHA * hv.x + acc[i][j][0]; o.y = DN_ALPHA * hv.y + acc[i][j][1];
                o.z = DN_ALPHA * hv.z + acc[i][j][2]; o.w = DN_ALPHA * hv.w + acc[i][j][3];
                *(float4*)(p.pre1 + (long)m * 1024 + n) = o;
            }
    }
}
__device__ __forceinline__ float wave_sum(float v) {
#pragma unroll
    for (int s = 32; s >= 1; s >>= 1) v += __shfl_xor(v, s);
    return v;
}
__device__ __forceinline__ void phase_ln(const Params& p, int l, int mode, unsigned* ctr) {
    const int lane = tid__ & 63, wave = tid__ >> 6;
    const float* gam = (mode == 1 ? p.ln1_g : p.ln2_g) + l * 1024;
    const float* bet = (mode == 1 ? p.ln1_b : p.ln2_b) + l * 1024;
    WorkQ q; q.init(ctr);
    for (;;) {
        int it = q.next();
        if (it >= TT / 64) break;
        for (int rr = 0; rr < 16; ++rr) {
            const long row = (long)it * 64 + wave * 16 + rr;
            float v[16];
#pragma unroll
            for (int i = 0; i < 4; ++i) {
                const int col = i * 256 + lane * 4;
                float4 a;
                if (mode == 1) a = *(const float4*)(p.pre1 + row * 1024 + col);
                else {
                    a = *(const float4*)(p.h1f + row * 1024 + col);
                    a.x *= DN_ALPHA; a.y *= DN_ALPHA; a.z *= DN_ALPHA; a.w *= DN_ALPHA;
                    const uint2 pl = *(const uint2*)(p.ple + row * 1024 + col);
                    a.x += bf2f((u16)(pl.x & 0xffff)); a.y += bf2f((u16)(pl.x >> 16));
                    a.z += bf2f((u16)(pl.y & 0xffff)); a.w += bf2f((u16)(pl.y >> 16));
#pragma unroll
                    for (int s = 0; s < 4; ++s) {
                        const uint2 y = *(const uint2*)(p.y4 + (row * 4 + s) * 1024 + col);
                        a.x += bf2f((u16)(y.x & 0xffff)); a.y += bf2f((u16)(y.x >> 16));
                        a.z += bf2f((u16)(y.y & 0xffff)); a.w += bf2f((u16)(y.y >> 16));
                    }
                }
                v[i * 4 + 0] = a.x; v[i * 4 + 1] = a.y; v[i * 4 + 2] = a.z; v[i * 4 + 3] = a.w;
            }
            float s = 0.f;
#pragma unroll
            for (int i = 0; i < 16; ++i) s += v[i];
            const float mean = wave_sum(s) * (1.f / 1024.f);
            float s2 = 0.f;
#pragma unroll
            for (int i = 0; i < 16; ++i) { v[i] -= mean; s2 += v[i] * v[i]; }
            const float rstd = rsqrtf(wave_sum(s2) * (1.f / 1024.f) + 1e-5f);
#pragma unroll
            for (int i = 0; i < 4; ++i) {
                const int col = i * 256 + lane * 4;
                const float4 gg = *(const float4*)(gam + col), bb = *(const float4*)(bet + col);
                float4 y;
                y.x = v[i * 4 + 0] * rstd * gg.x + bb.x; y.y = v[i * 4 + 1] * rstd * gg.y + bb.y;
                y.z = v[i * 4 + 2] * rstd * gg.z + bb.z; y.w = v[i * 4 + 3] * rstd * gg.w + bb.w;
                if (mode == 1) {
                    *(float4*)(p.h1f + row * 1024 + col) = y;
                    const u16 h0 = f2bf(y.x), h1 = f2bf(y.y), h2 = f2bf(y.z), h3 = f2bf(y.w);
                    uint2 u; u.x = (unsigned)h0 | ((unsigned)h1 << 16); u.y = (unsigned)h2 | ((unsigned)h3 << 16);
                    *(uint2*)(p.h1b + row * 1024 + col) = u;
                    st_bf4(p.h1lo + row * 1024 + col, y.x - bf2f(h0), y.y - bf2f(h1), y.z - bf2f(h2), y.w - bf2f(h3));
                } else {
                    if (l == 3) *(float4*)(p.out + row * 1024 + col) = y;
                    else {
                        *(float4*)(p.hf + row * 1024 + col) = y;
                        st_bf4(p.hb + row * 1024 + col, y.x, y.y, y.z, y.w);
                    }
                }
            }
        }
    }
}
struct KRouter {
    long dlo;
    __device__ __forceinline__ long operator()(int k) const { return (k < 2048) ? (long)(k & 1023) : (dlo + (k - 2048)); }
};
__device__ __forceinline__ void phase_router_ple(const Params& p, int l, unsigned* ctr) {
    const int tid = tid__;
    const int n_r = TT / 128, total = n_r + (TT / 128) * 8;
    WorkQ q; q.init(ctr);
    for (;;) {
        int it = q.next();
        if (it >= total) break;
        const u16* ap[4]; const u16* bp[4];
        if (it < n_r) {
            const int m0 = it * 128;
            f32x4 acc[4][4]; acc_zero(acc);
#pragma unroll
            for (int i = 0; i < 4; ++i) {
                int r = (tid >> 3) + 32 * i;
                ap[i] = p.h1b + (long)(m0 + r) * 1024;
                bp[i] = p.wt_r + ((long)l * 32 + (r & 31)) * 3072;
            }
            KRouter kr; kr.dlo = (long)(p.h1lo - p.h1b);
            gemm_main(acc, ap, bp, 3072, kr);
            EPI_COORDS
#pragma unroll
            for (int i = 0; i < 4; ++i)
#pragma unroll
                for (int j = 0; j < 4; ++j) {
                    const int m = m0 + EPI_M(j), n = EPI_N(i);
                    if (n < 32) {
                        const float4 bb = *(const float4*)(p.b_router + l * 32 + n);
                        float4 o; o.x = acc[i][j][0] + bb.x; o.y = acc[i][j][1] + bb.y; o.z = acc[i][j][2] + bb.z; o.w = acc[i][j][3] + bb.w;
                        *(float4*)(p.logits + (long)m * 32 + n) = o;
                    }
                }
        } else {
            const int e = it - n_r;
            const int mt = e >> 3, nt = e & 7, m0 = mt * 128, n0 = nt * 128;
            f32x4 acc[4][4];
            acc_zero(acc);
#pragma unroll
            for (int i = 0; i < 4; ++i) {
                int r = (tid >> 3) + 32 * i;
                ap[i] = p.pb + ((long)l * TT + m0 + r) * 256;
                bp[i] = p.wt_pp + ((long)l * 1024 + n0 + r) * 256;
            }
            gemm_main(acc, ap, bp, 256, KId());
            EPI_COORDS
#pragma unroll
            for (int i = 0; i < 4; ++i)
#pragma unroll
                for (int j = 0; j < 4; ++j) {
                    const int m = m0 + EPI_M(j), n = n0 + EPI_N(i);
                    float4 o; o.x = acc[i][j][0]; o.y = acc[i][j][1]; o.z = acc[i][j][2]; o.w = acc[i][j][3];
                    *(float4*)(p.pre1 + (long)m * 1024 + n) = o;
                }
            acc_zero(acc);
#pragma unroll
            for (int i = 0; i < 4; ++i) {
                int r = (tid >> 3) + 32 * i;
                ap[i] = p.h1b + (long)(m0 + r) * 1024;
                bp[i] = p.wt_pg + ((long)l * 1024 + n0 + r) * 1024;
            }
            gemm_main(acc, ap, bp, 1024, KId());
#pragma unroll
            for (int i = 0; i < 4; ++i)
#pragma unroll
                for (int j = 0; j < 4; ++j) {
                    const int m = m0 + EPI_M(j), n = n0 + EPI_N(i);
                    const float4 st = *(const float4*)(p.pre1 + (long)m * 1024 + n);
                    st_bf4(p.ple + (long)m * 1024 + n, sigmoidf_(acc[i][j][0]) * st.x, sigmoidf_(acc[i][j][1]) * st.y,
                           sigmoidf_(acc[i][j][2]) * st.z, sigmoidf_(acc[i][j][3]) * st.w);
                }
        }
    }
}
__device__ __forceinline__ void phase_route(const Params& p, int l, unsigned* ctr) {
    const int tid = tid__;
    int* s_cnt = s_misc;
    int* s_base = s_misc + 32;
    WorkQ q; q.init(ctr);
    for (;;) {
        int it = q.next();
        if (it >= TT / 256) break;
        if (tid < 32) s_cnt[tid] = 0;
        __syncthreads();
        const int t = it * 256 + tid;
        float lg[32];
#pragma unroll
        for (int i = 0; i < 8; ++i) {
            const float4 v = *(const float4*)(p.logits + (long)t * 32 + i * 4);
            lg[i * 4 + 0] = v.x; lg[i * 4 + 1] = v.y; lg[i * 4 + 2] = v.z; lg[i * 4 + 3] = v.w;
        }
        unsigned taken = 0u;
        int ek[4]; float vk[4];
#pragma unroll
        for (int k = 0; k < 4; ++k) {
            float best = -3.0e38f; int bi = 0;
#pragma unroll
            for (int e = 0; e < 32; ++e) {
                const bool ok = !((taken >> e) & 1u) && (lg[e] > best);
                best = ok ? lg[e] : best;
                bi = ok ? e : bi;
            }
            taken |= 1u << bi;
            ek[k] = bi; vk[k] = best;
        }
        float wsum = 0.f;
        float v0 = -3.0e38f, v1 = 0.f, v2 = 0.f, v3 = 0.f;
#pragma unroll
        for (int e = 0; e < 32; ++e) {
            v0 = (e == ek[0]) ? lg[e] : v0;
            v1 = (e == ek[1]) ? lg[e] : v1;
            v2 = (e == ek[2]) ? lg[e] : v2;
            v3 = (e == ek[3]) ? lg[e] : v3;
        }
        vk[0] = 1.f; vk[1] = __expf(v1 - v0); vk[2] = __expf(v2 - v0); vk[3] = __expf(v3 - v0);
        wsum = vk[0] + vk[1] + vk[2] + vk[3];
        const float winv = 1.f / wsum;
        int lp[4];
#pragma unroll
        for (int k = 0; k < 4; ++k) lp[k] = atomicAdd(&s_cnt[ek[k]], 1);
        __syncthreads();
        if (tid < 32) s_base[tid] = (int)atomicAdd(&p.ecnt[l * 32 + tid], (unsigned)s_cnt[tid]);
        __syncthreads();
#pragma unroll
        for (int k = 0; k < 4; ++k) {
            const long idx = (long)ek[k] * TT + s_base[ek[k]] + lp[k];
            p.ent_id[idx] = t * 4 + k;
            p.ent_w[idx] = vk[k] * winv;
        }
    }
}
__device__ __forceinline__ void moe_prefix(const Params& p, int l) {
    __syncthreads();
    if (tid__ == 0) {
        int acc = 0;
        for (int e = 0; e < 32; ++e) {
            const int n = (int)__hip_atomic_load(&p.ecnt[l * 32 + e], __ATOMIC_RELAXED, __HIP_MEMORY_SCOPE_AGENT);
            s_misc[e] = acc;
            s_misc[40 + e] = n;
            acc += (n + 127) >> 7;
        }
        s_misc[32] = acc;
    }
    __syncthreads();
}
__device__ __forceinline__ void phase_moe_gu(const Params& p, int l, unsigned* ctr) {
    const int tid = tid__;
    moe_prefix(p, l);
    const int total = s_misc[32] * 16;
    WorkQ q; q.init(ctr);
    for (;;) {
        int it = q.next();
        if (it >= total) break;
        const int mtg = it >> 4, nt = it & 15;
        int e = 0;
        for (int i = 1; i < 32; ++i) e = (s_misc[i] <= mtg) ? i : e;
        const int mt = mtg - s_misc[e], ne = s_misc[40 + e];
        const u16* ap[4]; const u16* bp[4];
#pragma unroll
        for (int i = 0; i < 4; ++i) {
            const int r = (tid >> 3) + 32 * i;
            int idx = mt * 128 + r; if (idx > ne - 1) idx = ne - 1;
            const int tok = p.ent_id[(long)e * TT + idx] >> 2;
            ap[i] = p.h1b + (long)tok * 1024;
            const int isup = (r >> 5) & 1, col = (r >> 6) * 32 + (r & 31);
            bp[i] = p.wt_gu + (((long)l * 32 + e) * 2048 + isup * 1024 + nt * 64 + col) * 1024;
        }
        f32x4 acc[4][4]; acc_zero(acc);
        gemm_main(acc, ap, bp, 1024, KId());
        EPI_COORDS
        const float* bg = p.b_gu + ((long)l * 32 + e) * 2048;
#pragma unroll
        for (int i = 0; i < 2; ++i)
#pragma unroll
            for (int j = 0; j < 4; ++j) {
                const long rowa = (long)mtg * 128 + EPI_M(j);
                const int col = nt * 64 + wn_ * 32 + i * 16 + (lane_ >> 4) * 4;
                float v[4];
#pragma unroll
                for (int r = 0; r < 4; ++r) {
                    float gate = acc[i][j][r] + bg[col + r];
                    float up = acc[i + 2][j][r] + bg[1024 + col + r];
                    gate = fminf(gate, 7.f);
                    up = fminf(fmaxf(up, -7.f), 7.f);
                    v[r] = (up + 1.f) * gate * sigmoidf_(1.702f * gate);
                }
                st_bf4(p.act + rowa * 1024 + col, v[0], v[1], v[2], v[3]);
            }
    }
}
__device__ __forceinline__ void phase_moe_down(const Params& p, int l, unsigned* ctr) {
    const int tid = tid__;
    moe_prefix(p, l);
    const int total = s_misc[32] * 8;
    WorkQ q; q.init(ctr);
    for (;;) {
        int it = q.next();
        if (it >= total) break;
        const int mtg = it >> 3, nt = it & 7;
        int e = 0;
        for (int i = 1; i < 32; ++i) e = (s_misc[i] <= mtg) ? i : e;
        const int mt = mtg - s_misc[e], ne = s_misc[40 + e];
        const u16* ap[4]; const u16* bp[4];
#pragma unroll
        for (int i = 0; i < 4; ++i) {
            const int r = (tid >> 3) + 32 * i;
            ap[i] = p.act + ((long)mtg * 128 + r) * 1024;
            bp[i] = p.wt_dn + (((long)l * 32 + e) * 1024 + nt * 128 + r) * 1024;
        }
        f32x4 acc[4][4]; acc_zero(acc);
        gemm_main(acc, ap, bp, 1024, KId());
        EPI_COORDS
        const float* bd = p.b_down + ((long)l * 32 + e) * 1024;
#pragma unroll
        for (int j = 0; j < 4; ++j) {
            const int idx = mt * 128 + EPI_M(j);
            if (idx < ne) {
                const int id = p.ent_id[(long)e * TT + idx];
                const float cw = p.ent_w[(long)e * TT + idx];
#pragma unroll
                for (int i = 0; i < 4; ++i) {
                    const int n = nt * 128 + EPI_N(i);
                    const float4 bb = *(const float4*)(bd + n);
                    st_bf4(p.y4 + (long)id * 1024 + n, cw * (acc[i][j][0] + bb.x), cw * (acc[i][j][1] + bb.y),
                           cw * (acc[i][j][2] + bb.z), cw * (acc[i][j][3] + bb.w));
                }
            }
        }
    }
}

};
#ifndef PH0_EN
#define PH0_EN 1
#endif
__device__ __forceinline__ void run_phase(const Params& p, int ph) {
    unsigned* ctr = p.ctr + ph;
    Ctx cx;
    {
        int t_ = threadIdx.x;
        asm volatile("" : "+v"(t_));
        cx.tid__ = t_;
    }
    if (ph == 0) { if (PH0_EN) cx.phase_prologue(p, ctr); return; }
    const int l = (ph - 1) / NPH_LAYER, s = (ph - 1) % NPH_LAYER;
#ifndef ONLY_S
#define ONLY_S -1
#endif
#ifndef SKIP_S
#define SKIP_S -1
#endif
#define PH_EN(x) ((ONLY_S < 0 || ONLY_S == (x)) && SKIP_S != (x))
    if (PH_EN(0) && s == 0) cx.phase_gemm_in(p, l, ctr);
    if (PH_EN(1) && s == 1) cx.phase_cmp1_sb(p, l, ctr);
    if (PH_EN(2) && s == 2) cx.phase_cmp2(p, l, ctr);
    if (PH_EN(3) && s == 3) cx.phase_nsa(p, ctr);
    if (PH_EN(4) && s == 4) cx.phase_br(p, l, ctr);
    if (PH_EN(5) && s == 5) cx.phase_wo(p, l, ctr);
    if (PH_EN(6) && s == 6) cx.phase_ln(p, l, 1, ctr);
    if (PH_EN(7) && s == 7) cx.phase_router_ple(p, l, ctr);
    if (PH_EN(8) && s == 8) cx.phase_route(p, l, ctr);
    if (PH_EN(9) && s == 9) cx.phase_moe_gu(p, l, ctr);
    if (PH_EN(10) && s == 10) cx.phase_moe_down(p, l, ctr);
    if (PH_EN(11) && s == 11) cx.phase_ln(p, l, 2, ctr);
}

__global__ void __launch_bounds__(256, 2) mega_kernel(Params p, int ph0, int ph1) {
    __shared__ uint4 xb_words;
    if (threadIdx.x == 0) xb_words = make_uint4(0u, 0u, 0u, 0u);
    __syncthreads();
    __shared__ Params s_p;
    if (threadIdx.x == 0) {
        const void* const* src_ = (const void* const*)&p;
        const void** dst_ = (const void**)&s_p;
#pragma unroll
        for (int i = 0; i < (int)(sizeof(Params) / sizeof(void*)); ++i) dst_[i] = src_[i];
    }
    __syncthreads();
    XcdBarrier bar = xcd_barrier_post(p.bar, (volatile LAS unsigned*)&xb_words);
    for (int ph = ph0; ph < ph1; ++ph) {
        if (ph > ph0) xcd_barrier(bar);
        asm volatile("" ::: "memory");
        run_phase(s_p, ph);
    }
}

#ifndef MK_SPLIT
#define MK_SPLIT 0
#endif

extern "C" void kernel_launch(void* const* d_in, const int* in_sizes, int n_in, void* d_out, int out_size, void* d_ws,
                              size_t ws_size, hipStream_t stream) {
    static int grid = 0;
    if (!grid) {
        int dev = 0, cus = 0, per_cu = 0;
        hipGetDevice(&dev);
        hipDeviceGetAttribute(&cus, hipDeviceAttributeMultiprocessorCount, dev);
        hipOccupancyMaxActiveBlocksPerMultiprocessor(&per_cu, mega_kernel, 256, 0);
        if (per_cu < 1) per_cu = 1;
        grid = cus * (per_cu < 2 ? per_cu : 2);
    }
    Params p;
    memset(&p, 0, sizeof(p));
    const float** pin = (const float**)&p;
    for (int i = 0; i < 21; ++i) pin[i] = (const float*)d_in[i];
    p.out = (float*)d_out;
    char* w = (char*)d_ws;
    size_t off = 0;
    auto take = [&](size_t bytes) { char* r = w + off; off += (bytes + 255) & ~(size_t)255; return r; };
    const size_t sync_bytes = (XCD_BAR_WORDS + 64 + 128) * sizeof(unsigned);
    p.bar = (unsigned*)take(sync_bytes);
    p.ctr = p.bar + XCD_BAR_WORDS;
    p.ecnt = p.ctr + 64;
    p.wt_in = (u16*)take((size_t)4 * NIN * 1024 * 2);
    p.wt_brs = (u16*)take((size_t)4 * 512 * 1024 * 2);
    p.wt_brn = (u16*)take((size_t)4 * 512 * 1024 * 2);
    p.wt_o = (u16*)take((size_t)4 * 1024 * 1024 * 2);
    p.wt_pg = (u16*)take((size_t)4 * 1024 * 1024 * 2);
    p.wt_pp = (u16*)take((size_t)4 * 256 * 1024 * 2);
    p.wt_gu = (u16*)take((size_t)128 * 2048 * 1024 * 2);
    p.wt_dn = (u16*)take((size_t)128 * 1024 * 1024 * 2);
    p.wt_c1 = (u16*)take((size_t)8 * 128 * 2048 * 2);
    p.wt_c2 = (u16*)take((size_t)8 * 64 * 128 * 2);
    p.wt_r = (u16*)take((size_t)4 * 32 * 3072 * 2);
    p.cbias = (float*)take(1024 * 4);
    p.hf = (float*)take((size_t)TT * 1024 * 4);
    p.pre1 = (float*)take((size_t)TT * 1024 * 4);
    p.h1f = (float*)take((size_t)TT * 1024 * 4);
    p.logits = (float*)take((size_t)TT * 32 * 4);
    p.ynf = (float*)take((size_t)TT * 512 * 4);
    p.ent_w = (float*)take((size_t)32 * TT * 4);
    p.hb = (u16*)take((size_t)TT * 1024 * 2);
    p.pb = (u16*)take((size_t)4 * TT * 256 * 2);
    p.yb = (u16*)take((size_t)TT * NIN * 2);
    p.ysb = (u16*)take((size_t)TT * 512 * 2);
    p.ynsa = (u16*)take((size_t)TT * 512 * 2);
    p.merged = (u16*)take((size_t)TT * 1024 * 2);
    p.h1b = (u16*)take((size_t)TT * 1024 * 2);
    p.h1lo = (u16*)take((size_t)TT * 1024 * 2);
    p.ple = (u16*)take((size_t)TT * 1024 * 2);
    p.hid = (u16*)take((size_t)2 * 2048 * 128 * 2);
    p.kvc = (u16*)take((size_t)2 * 2048 * 64 * 2);
    p.act = (u16*)take((size_t)(TT * 4 + 32 * 128) * 1024 * 2);
    p.y4 = (u16*)take((size_t)TT * 4 * 1024 * 2);
    p.ent_id = (int*)take((size_t)32 * TT * 4);
    if (off > ws_size) { fprintf(stderr, "workspace too small: need %zu have %zu\n", off, ws_size); return; }
    hipMemsetAsync(p.bar, 0, sync_bytes, stream);
#if MK_SPLIT
    for (int ph = 0; ph < NPHASE; ++ph) mega_kernel<<<dim3(grid), dim3(256), 0, stream>>>(p, ph, ph + 1);
#else
    mega_kernel<<<dim3(grid), dim3(256), 0, stream>>>(p, 0, NPHASE);
#endif
}
```

```cpp
#include <hip/hip_runtime.h>
#include <stdint.h>
#include <cstdio>
#include <cstring>
#include <cstdlib>
#include <vector>

#define XB_TMO      128
#define XB_XCNT(j)  (256  + 64 * (j))
#define XB_XSUB(j)  (1280 + 64 * (j))
#define XB_XGEN(j)  (2304 + 64 * (j))
#define XB_TOP      3328
#define XB_TOPGEN   3392
#define XCD_BAR_WORDS 3456
#define XB_SPIN_CAP (1u << 18)
#define LAS __attribute__((address_space(3)))

__device__ __forceinline__ unsigned xb_ld(unsigned* p)              { return __hip_atomic_load(p, __ATOMIC_RELAXED, __HIP_MEMORY_SCOPE_AGENT); }
__device__ __forceinline__ unsigned xb_add(unsigned* p, unsigned v) { return __hip_atomic_fetch_add(p, v, __ATOMIC_RELAXED, __HIP_MEMORY_SCOPE_AGENT); }
__device__ __forceinline__ unsigned xb_xcc_id() { return (unsigned)__builtin_amdgcn_s_getreg((3 << 11) | 20) & 0xFu; }
#define XB_SPIN(cond, bar) do { unsigned _sp = 0; while (cond) { __builtin_amdgcn_s_sleep(1); \
    if ((++_sp & 255u) == 0u) { if (xb_ld(&(bar)[XB_TMO])) break; if (_sp > XB_SPIN_CAP) { atomicAdd(&(bar)[XB_TMO], 1u); break; } } } } while (0)

struct XcdBarrier {
    unsigned* bar; unsigned x;
    volatile LAS unsigned* st;
};

__device__ __forceinline__ XcdBarrier xcd_barrier_post(unsigned* bar, volatile LAS unsigned* st) {
    XcdBarrier b; b.bar = bar; b.x = xb_xcc_id(); b.st = st;
    if (threadIdx.x == 0) (void)xb_add(&bar[XB_XCNT(b.x)], 1u);
    return b;
}
__device__ __forceinline__ void xcd_barrier_complete(unsigned* bar, unsigned x, unsigned& nloc, unsigned& nx) {
    const unsigned G = gridDim.x * gridDim.y * gridDim.z;
    unsigned sum, cnt, mine, sp = 0u;
    for (;;) {
        sum = 0u; cnt = 0u; mine = 0u;
#pragma unroll
        for (unsigned j = 0; j < 16; ++j) { const unsigned c = xb_ld(&bar[XB_XCNT(j)]); sum += c; cnt += (c > 0u) ? 1u : 0u; mine = (j == x) ? c : mine; }
        if (sum == G) break;
        __builtin_amdgcn_s_sleep(1);
        if ((++sp & 255u) == 0u) { if (xb_ld(&bar[XB_TMO])) break; if (sp > XB_SPIN_CAP) { atomicAdd(&bar[XB_TMO], 1u); break; } }
    }
    nloc = mine > 0u ? mine : 1u; nx = cnt > 0u ? cnt : 1u;
}

__device__ __forceinline__ void xcd_barrier(const XcdBarrier& b) {
    asm volatile("s_waitcnt vmcnt(0)" ::: "memory");
    __syncthreads();
    if (threadIdx.x == 0) {
        unsigned* bar = b.bar;
        __builtin_amdgcn_s_waitcnt(0);
        unsigned nloc = b.st[0], nx = b.st[1];
        if (nloc == 0u) { xcd_barrier_complete(bar, b.x, nloc, nx); b.st[0] = nloc; b.st[1] = nx; }
        const unsigned old = xb_add(&bar[XB_XSUB(b.x)], 1u);
        const unsigned gen = old / nloc;
        if (old + 1u == (gen + 1u) * nloc) {
            __builtin_amdgcn_fence(__ATOMIC_RELEASE, "agent");
            asm volatile("s_waitcnt vmcnt(0)" ::: "memory");
            const unsigned og = xb_add(&bar[XB_TOP], 1u);
            const unsigned tg = og / nx;
            if (og + 1u == (tg + 1u) * nx) xb_add(&bar[XB_TOPGEN], 1u);
            else XB_SPIN(xb_ld(&bar[XB_TOPGEN]) == tg, bar);
            __builtin_amdgcn_fence(__ATOMIC_ACQUIRE, "agent");
            xb_add(&bar[XB_XGEN(b.x)], 1u);
            asm volatile("s_waitcnt vmcnt(0)" ::: "memory");
        } else {
            XB_SPIN(xb_ld(&bar[XB_XGEN(b.x)]) == gen, bar);
            __builtin_amdgcn_fence(__ATOMIC_ACQUIRE, "agent");
            asm volatile("s_waitcnt vmcnt(0)" ::: "memory");
        }
    }
    __syncthreads();
}


#ifndef REP_MASK
#define REP_MASK 0
#endif
typedef unsigned short u16;
typedef __attribute__((ext_vector_type(8))) short bf16x8;
typedef __attribute__((ext_vector_type(4))) float f32x4;
typedef __attribute__((ext_vector_type(4))) unsigned u32x4;
#define MFMA(a, b, c) __builtin_amdgcn_mfma_f32_16x16x32_bf16(a, b, c, 0, 0, 0)

#define TT 32768
#define SS 4096
#define DD 1024
#define NIN 4888
#define C_SBQ 0
#define C_SBK 512
#define C_SBV 1024
#define C_NQ 1536
#define C_KC 2048
#define C_VC 2176
#define C_KS 2304
#define C_VS 2432
#define C_KW 2560
#define C_VW 2688
#define C_NG 2816
#define C_GSB 2840
#define C_GNSA 3864
#define DN_ALPHA 1.681792830507429f
#define NPH_LAYER 12
#define NPHASE (1 + 4 * NPH_LAYER)
#define KSTR 72
#define VSTR 136
#define SSTR 68

struct Params {
    const float *x, *p, *w_in, *w_cmp1, *w_cmp2, *pe_cmp, *w_br_sb, *w_br_nsa, *w_o, *ln1_g, *ln1_b, *ln2_g, *ln2_b,
        *w_router, *b_router, *w_gu, *b_gu, *w_down, *b_down, *w_ple_gate, *w_ple_proj;
    float* out;
    unsigned *bar, *ctr, *ecnt;
    u16 *wt_in, *wt_brs, *wt_brn, *wt_o, *wt_pg, *wt_pp, *wt_gu, *wt_dn, *wt_c1, *wt_c2, *wt_r;
    float *cbias, *hf, *pre1, *h1f, *logits, *ynf, *ent_w;
    u16 *hb, *pb, *yb, *ysb, *ynsa, *merged, *h1b, *h1lo, *ple, *hid, *kvc, *act, *y4;
    int* ent_id;
};

__device__ __forceinline__ u16 f2bf(float f) {
    unsigned u = __float_as_uint(f);
    u += 0x7fffu + ((u >> 16) & 1u);
    return (u16)(u >> 16);
}
__device__ __forceinline__ float bf2f(u16 h) { return __uint_as_float(((unsigned)h) << 16); }
__device__ __forceinline__ void st_bf4(u16* p, float a, float b, float c, float d) {
    uint2 u;
    u.x = (unsigned)f2bf(a) | ((unsigned)f2bf(b) << 16);
    u.y = (unsigned)f2bf(c) | ((unsigned)f2bf(d) << 16);
    *(uint2*)p = u;
}
__device__ __forceinline__ float sigmoidf_(float x) { return 1.f / (1.f + __expf(-x)); }

__shared__ __attribute__((aligned(16))) unsigned char g_smem[62464];
__shared__ int s_item;
__shared__ int s_misc[80];
__shared__ unsigned long long s_mask[4][16];
__shared__ unsigned long long s_union[4];

struct WorkQ {
    unsigned* ctr;
    int nxt;
    __device__ __forceinline__ void init(unsigned* c) {
        ctr = c;
        nxt = 0;
        if (threadIdx.x == 0) nxt = (int)atomicAdd(ctr, 1u);
    }
    __device__ __forceinline__ int next() {
        __syncthreads();
        if (threadIdx.x == 0) s_item = nxt;
        __syncthreads();
        int it = s_item;
        if (threadIdx.x == 0) nxt = (int)atomicAdd(ctr, 1u);
        return it;
    }
};


struct XQ {
    unsigned* ctr;
    int per, x0, k, nxt;
    __device__ __forceinline__ void init(unsigned* c, int per_) {
        ctr = c; per = per_; k = 0; nxt = 0;
        x0 = (int)(xb_xcc_id() & 7u);
        if (threadIdx.x == 0) nxt = (int)atomicAdd(&ctr[x0], 1u);
    }
    __device__ __forceinline__ int next() {
        __syncthreads();
        if (threadIdx.x == 0) {
            int v = nxt;
            while (v >= per && k < 8) {
                ++k;
                if (k < 8) v = (int)atomicAdd(&ctr[(x0 + k) & 7], 1u);
            }
            if (k < 8) {
                s_item = ((x0 + k) & 7) * per + v;
                nxt = (int)atomicAdd(&ctr[(x0 + k) & 7], 1u);
            } else s_item = -1;
        }
        __syncthreads();
        return s_item;
    }
};
__device__ __forceinline__ void xq_decode(int item, int mpx, int NT, int& mt, int& nt) {
    const int per = mpx * NT;
    const int q = item / per, idx = item - q * per;
    const int sm = idx / (8 * NT), rem = idx - sm * (8 * NT);
    nt = rem >> 3;
    mt = q * mpx + sm * 8 + (rem & 7);
}
struct Ctx {
    int tid__;
struct KId {
    __device__ __forceinline__ long operator()(int k) const { return k; }
};
template <class KOA>
__device__ __forceinline__ void gemm_main(f32x4 (&acc)[4][4], const u16* (&ap)[4], const u16* (&bp)[4], int K, KOA koa) {
    u16* sA = (u16*)g_smem;
    u16* sB = sA + 128 * KSTR;
    const int tid = tid__, lane = tid & 63, wave = tid >> 6;
    const int wn = wave & 1, wm = wave >> 1;
    const int kc = (tid & 7) * 8;
    const int lrow = tid >> 3;
    u32x4 ra[4], rb[4];
    {
        const long oa = koa(kc);
#pragma unroll
        for (int i = 0; i < 4; ++i) {
            ra[i] = *(const u32x4*)(ap[i] + oa);
            rb[i] = *(const u32x4*)(bp[i] + kc);
        }
    }
    for (int k0 = 0; k0 < K; k0 += 64) {
        __syncthreads();
#pragma unroll
        for (int i = 0; i < 4; ++i) {
            *(u32x4*)(sA + (lrow + 32 * i) * KSTR + kc) = ra[i];
            *(u32x4*)(sB + (lrow + 32 * i) * KSTR + kc) = rb[i];
        }
        __syncthreads();
        if (k0 + 64 < K) {
            const long oa = koa(k0 + 64 + kc);
#pragma unroll
            for (int i = 0; i < 4; ++i) {
                ra[i] = *(const u32x4*)(ap[i] + oa);
                rb[i] = *(const u32x4*)(bp[i] + (k0 + 64 + kc));
            }
        }
#pragma unroll
        for (int ks = 0; ks < 2; ++ks) {
            bf16x8 af[4], bfr[4];
#pragma unroll
            for (int j = 0; j < 4; ++j)
                af[j] = *(const bf16x8*)(sA + (wm * 64 + j * 16 + (lane & 15)) * KSTR + ks * 32 + (lane >> 4) * 8);
#pragma unroll
            for (int i = 0; i < 4; ++i)
                bfr[i] = *(const bf16x8*)(sB + (wn * 64 + i * 16 + (lane & 15)) * KSTR + ks * 32 + (lane >> 4) * 8);
#pragma unroll
            for (int i = 0; i < 4; ++i)
#pragma unroll
                for (int j = 0; j < 4; ++j) acc[i][j] = MFMA(bfr[i], af[j], acc[i][j]);
        }
    }
}
__device__ __forceinline__ void acc_zero(f32x4 (&acc)[4][4]) {
#pragma unroll
    for (int i = 0; i < 4; ++i)
#pragma unroll
        for (int j = 0; j < 4; ++j) acc[i][j] = f32x4{0.f, 0.f, 0.f, 0.f};
}
#define EPI_COORDS                                         \
    const int lane_ = tid__ & 63, wave_ = tid__ >> 6; \
    const int wn_ = wave_ & 1, wm_ = wave_ >> 1;
#define EPI_M(j) (wm_ * 64 + (j) * 16 + (lane_ & 15))
#define EPI_N(i) (wn_ * 64 + (i) * 16 + (lane_ >> 4) * 4)

__device__ __forceinline__ void xjob(const Params& p, int j, const float*& src, u16*& dst, int& nb, int& K, int& N) {
    switch (j) {
        case 0: src = p.w_in; dst = p.wt_in; nb = 4; K = 1024; N = NIN; break;
        case 1: src = p.w_br_sb; dst = p.wt_brs; nb = 4; K = 512; N = 1024; break;
        case 2: src = p.w_br_nsa; dst = p.wt_brn; nb = 4; K = 512; N = 1024; break;
        case 3: src = p.w_o; dst = p.wt_o; nb = 4; K = 1024; N = 1024; break;
        case 4: src = p.w_ple_gate; dst = p.wt_pg; nb = 4; K = 1024; N = 1024; break;
        case 5: src = p.w_ple_proj; dst = p.wt_pp; nb = 4; K = 256; N = 1024; break;
        case 6: src = p.w_gu; dst = p.wt_gu; nb = 128; K = 1024; N = 2048; break;
        case 7: src = p.w_down; dst = p.wt_dn; nb = 128; K = 1024; N = 1024; break;
        case 8: src = p.w_cmp1; dst = p.wt_c1; nb = 8; K = 2048; N = 128; break;
        default: src = p.w_cmp2; dst = p.wt_c2; nb = 8; K = 128; N = 64; break;
    }
}
__device__ __forceinline__ int xjob_tiles(int nb, int K, int N) { return nb * (K / 64) * ((N + 63) / 64); }

__device__ __forceinline__ void phase_prologue(const Params& p, unsigned* ctr) {
    const int tid = tid__;
    int ntr = 0;
    for (int j = 0; j < 10; ++j) {
        const float* s; u16* d; int nb, K, N;
        xjob(p, j, s, d, nb, K, N);
        ntr += xjob_tiles(nb, K, N);
    }
    const int n_x = TT * DD / 8192, n_p = 4 * TT * 256 / 8192, n_r = 16, n_b = 16;
    const int total = ntr + n_x + n_p + n_r + n_b;
    float* st = (float*)g_smem;
    WorkQ q; q.init(ctr);
    for (;;) {
        int it = q.next();
        if (it >= total) break;
        it = (it < n_b + n_r) ? (ntr + n_x + n_p + (it < n_b ? n_r + it : it - n_b)) : it - (n_b + n_r);
        if (it < ntr) {
            const float* src = nullptr; u16* dst = nullptr; int nb = 0, K = 0, N = 0;
            int rem = it;
            for (int j = 0; j < 10; ++j) {
                xjob(p, j, src, dst, nb, K, N);
                int nt = xjob_tiles(nb, K, N);
                if (rem < nt) break;
                rem -= nt;
            }
            const int ktn = K / 64, ntn = (N + 63) / 64;
            const int tpm = ktn * ntn;
            const int b = rem / tpm; rem -= b * tpm;
            const int kt = rem % ktn, nt = rem / ktn;
            src += (long)b * K * N; dst += (long)b * K * N;
            const int k0 = kt * 64, n0 = nt * 64;
#pragma unroll
            for (int i = 0; i < 4; ++i) {
                int k = (tid >> 4) + 16 * i, n = (tid & 15) * 4;
                float4 v = make_float4(0.f, 0.f, 0.f, 0.f);
                if (n0 + n < N) v = *(const float4*)(src + (long)(k0 + k) * N + n0 + n);
                st[k * 65 + n + 0] = v.x; st[k * 65 + n + 1] = v.y; st[k * 65 + n + 2] = v.z; st[k * 65 + n + 3] = v.w;
            }
            __syncthreads();
#pragma unroll
            for (int i = 0; i < 2; ++i) {
                int n = (tid >> 3) + 32 * i, k8 = (tid & 7) * 8;
                if (n0 + n < N) {
                    uint4 u;
                    u.x = (unsigned)f2bf(st[(k8 + 0) * 65 + n]) | ((unsigned)f2bf(st[(k8 + 1) * 65 + n]) << 16);
                    u.y = (unsigned)f2bf(st[(k8 + 2) * 65 + n]) | ((unsigned)f2bf(st[(k8 + 3) * 65 + n]) << 16);
                    u.z = (unsigned)f2bf(st[(k8 + 4) * 65 + n]) | ((unsigned)f2bf(st[(k8 + 5) * 65 + n]) << 16);
                    u.w = (unsigned)f2bf(st[(k8 + 6) * 65 + n]) | ((unsigned)f2bf(st[(k8 + 7) * 65 + n]) << 16);
                    *(uint4*)(dst + (long)(n0 + n) * K + k0 + k8) = u;
                }
            }
        } else if (it < ntr + n_x + n_p) {
            int e = it - ntr;
            const float* src; u16* db; float* df = nullptr;
            if (e < n_x) { src = p.x + (long)e * 8192; db = p.hb + (long)e * 8192; df = p.hf + (long)e * 8192; }
            else { e -= n_x; src = p.p + (long)e * 8192; db = p.pb + (long)e * 8192; }
#pragma unroll
            for (int i = 0; i < 8; ++i) {
                int o = i * 1024 + tid * 4;
                float4 v = *(const float4*)(src + o);
                if (df) *(float4*)(df + o) = v;
                st_bf4(db + o, v.x, v.y, v.z, v.w);
            }
        } else if (it < ntr + n_x + n_p + n_r) {
            int e0 = (it - ntr - n_x - n_p) * 8192;
            for (int i = 0; i < 32; ++i) {
                int idx = e0 + i * 256 + tid;
                int k = idx & 1023, le = idx >> 10, e = le & 31, l = le >> 5;
                float w = p.w_router[((long)l * 1024 + k) * 32 + e];
                u16 hi = f2bf(w); u16 lo = f2bf(w - bf2f(hi));
                u16* d = p.wt_r + (long)le * 3072;
                d[k] = hi; d[1024 + k] = lo; d[2048 + k] = hi;
            }
        } else {
            const int bi = it - ntr - n_x - n_p - n_r;
            const int lk = bi >> 1, h = (bi & 1) * 64 + (tid & 63), jp = tid >> 6;
            const float* pe = p.pe_cmp + (long)lk * 2048 + jp * 512;
            const float* w1 = p.w_cmp1 + ((long)lk * 2048 + jp * 512) * 128 + h;
            float sacc = 0.f;
#pragma unroll 8
            for (int j = 0; j < 512; ++j) sacc += pe[j] * w1[(long)j * 128];
            st[tid] = sacc;
            __syncthreads();
            if (tid < 64) p.cbias[lk * 128 + h] = (st[tid] + st[tid + 64]) + (st[tid + 128] + st[tid + 192]);
        }
    }
}

__device__ __forceinline__ void phase_gemm_in(const Params& p, int l, unsigned* ctr) {
    const int NTN = (NIN + 127) / 128;
    const int tid = tid__;
    const u16* W = p.wt_in + (long)l * NIN * 1024;
    XQ q; q.init(ctr, 32 * NTN);
    for (;;) {
        int it = q.next();
        if (it < 0) break;
        int mt, nt; xq_decode(it, 32, NTN, mt, nt);
        const int m0 = mt * 128, n0 = nt * 128;
        const u16* ap[4]; const u16* bp[4];
#pragma unroll
        for (int i = 0; i < 4; ++i) {
            int r = (tid >> 3) + 32 * i;
            ap[i] = p.hb + (long)(m0 + r) * 1024;
            int n = n0 + r; if (n > NIN - 1) n = NIN - 1;
            bp[i] = W + (long)n * 1024;
        }
        f32x4 acc[4][4]; acc_zero(acc);
        gemm_main(acc, ap, bp, 1024, KId());
        EPI_COORDS
#pragma unroll
        for (int i = 0; i < 4; ++i)
#pragma unroll
            for (int j = 0; j < 4; ++j) {
                int m = m0 + EPI_M(j), n = n0 + EPI_N(i);
                if (n < NIN) st_bf4(p.yb + (long)m * NIN + n, acc[i][j][0], acc[i][j][1], acc[i][j][2], acc[i][j][3]);
            }
    }
}

struct KCmp {
    __device__ __forceinline__ long operator()(int k) const { return (long)(k >> 6) * NIN + (k & 63); }
};
__device__ __forceinline__ void tile_cmp1(const Params& p, int l, int it) {
    const int tid = tid__;
    const int kv = it >> 4, mt = it & 15;
    const u16* W = p.wt_c1 + (long)(l * 2 + kv) * 128 * 2048;
    const u16* ap[4]; const u16* bp[4];
#pragma unroll
    for (int i = 0; i < 4; ++i) {
        int r = (tid >> 3) + 32 * i;
        int mrow = mt * 128 + r;
        int c = mrow & 127, bg = mrow >> 7, g = bg & 1, b = bg >> 1;
        ap[i] = p.yb + (long)(b * SS + c * 32) * NIN + (kv ? C_VC : C_KC) + g * 64;
        bp[i] = W + (long)r * 2048;
    }
    f32x4 acc[4][4]; acc_zero(acc);
    gemm_main(acc, ap, bp, 2048, KCmp());
    EPI_COORDS
    const float* cb = p.cbias + (l * 2 + kv) * 128;
#pragma unroll
    for (int i = 0; i < 4; ++i)
#pragma unroll
        for (int j = 0; j < 4; ++j) {
            int m = mt * 128 + EPI_M(j), n = EPI_N(i);
            float v[4];
#pragma unroll
            for (int r = 0; r < 4; ++r) { float a = acc[i][j][r] + cb[n + r]; v[r] = a * sigmoidf_(a); }
            st_bf4(p.hid + ((long)kv * 2048 + m) * 128 + n, v[0], v[1], v[2], v[3]);
        }
}
__device__ __forceinline__ void phase_cmp2(const Params& p, int l, unsigned* ctr) {
    const int tid = tid__;
    WorkQ q; q.init(ctr);
    for (;;) {
        int it = q.next();
        if (it >= 32) break;
        const int kv = it >> 4, mt = it & 15;
        const u16* W = p.wt_c2 + (long)(l * 2 + kv) * 64 * 128;
        const u16* ap[4]; const u16* bp[4];
#pragma unroll
        for (int i = 0; i < 4; ++i) {
            int r = (tid >> 3) + 32 * i;
            ap[i] = p.hid + ((long)kv * 2048 + mt * 128 + r) * 128;
            bp[i] = W + (long)(r & 63) * 128;
        }
        f32x4 acc[4][4]; acc_zero(acc);
        gemm_main(acc, ap, bp, 128, KId());
        EPI_COORDS
#pragma unroll
        for (int i = 0; i < 4; ++i)
#pragma unroll
            for (int j = 0; j < 4; ++j) {
                int m = mt * 128 + EPI_M(j), n = EPI_N(i);
                if (n < 64) st_bf4(p.kvc + ((long)kv * 2048 + m) * 64 + n, acc[i][j][0], acc[i][j][1], acc[i][j][2], acc[i][j][3]);
            }
    }
}

struct AttnLds {
    u16* K;
    u16* Vt;
    float* S;
    u16* P;
};
__device__ __forceinline__ AttnLds attn_lds() {
    AttnLds a;
    a.K = (u16*)g_smem;
    a.Vt = (u16*)(g_smem + 18432);
    a.S = (float*)(g_smem + 18432 + 17408) + (tid__ >> 6) * 16 * SSTR;
    a.P = (u16*)(g_smem + 18432 + 17408 + 17408) + (tid__ >> 6) * 16 * KSTR;
    return a;
}
__device__ __forceinline__ void load_k_tile(u16* sK, int koff, const u16* base, long stride) {
    const int tid = tid__, key = tid >> 2, ch = (tid & 3) * 16;
    const u16* g = base + (long)key * stride + ch;
    uint4 a = *(const uint4*)g, b = *(const uint4*)(g + 8);
    *(uint4*)(sK + (koff + key) * KSTR + ch) = a;
    *(uint4*)(sK + (koff + key) * KSTR + ch + 8) = b;
}
__device__ __forceinline__ void load_v_tile(u16* sVt, int koff, const u16* base, long stride) {
    const int tid = tid__, key = tid & 63, d0 = (tid >> 6) * 16;
    const u16* g = base + (long)key * stride + d0;
    uint4 a = *(const uint4*)g, b = *(const uint4*)(g + 8);
    unsigned w[8] = {a.x, a.y, a.z, a.w, b.x, b.y, b.z, b.w};
#pragma unroll
    for (int i = 0; i < 8; ++i) {
        sVt[(d0 + 2 * i) * VSTR + koff + key] = (u16)(w[i] & 0xffffu);
        sVt[(d0 + 2 * i + 1) * VSTR + koff + key] = (u16)(w[i] >> 16);
    }
}
__device__ __forceinline__ void wave_qk(const AttnLds& L, int koff, const bf16x8 (&qf)[2]) {
    const int lane = tid__ & 63, quad = lane >> 4, c = lane & 15;
#pragma unroll
    for (int nt = 0; nt < 4; ++nt) {
        f32x4 a = {0.f, 0.f, 0.f, 0.f};
#pragma unroll
        for (int ks = 0; ks < 2; ++ks) {
            bf16x8 kf = *(const bf16x8*)(L.K + (koff + nt * 16 + c) * KSTR + ks * 32 + quad * 8);
            a = MFMA(qf[ks], kf, a);
        }
#pragma unroll
        for (int r = 0; r < 4; ++r) L.S[(quad * 4 + r) * SSTR + nt * 16 + c] = a[r];
    }
}
__device__ __forceinline__ void wave_pv(const AttnLds& L, int koff, f32x4 (&o)[4]) {
    const int lane = tid__ & 63, quad = lane >> 4, c = lane & 15;
#pragma unroll
    for (int ks = 0; ks < 2; ++ks) {
        bf16x8 pf = *(const bf16x8*)(L.P + c * KSTR + ks * 32 + quad * 8);
#pragma unroll
        for (int dt = 0; dt < 4; ++dt) {
            bf16x8 vf = *(const bf16x8*)(L.Vt + (dt * 16 + c) * VSTR + koff + ks * 32 + quad * 8);
            o[dt] = MFMA(pf, vf, o[dt]);
        }
    }
}
__device__ __forceinline__ void read_s16(const AttnLds& L, int row, int part, float (&z)[16]) {
#pragma unroll
    for (int i = 0; i < 4; ++i) {
        float4 v = *(const float4*)(L.S + row * SSTR + part * 16 + i * 4);
        z[i * 4 + 0] = v.x; z[i * 4 + 1] = v.y; z[i * 4 + 2] = v.z; z[i * 4 + 3] = v.w;
    }
}
__device__ __forceinline__ void write_p16(const AttnLds& L, int row, int part, const float (&pv)[16]) {
    uint4 a, b;
    a.x = (unsigned)f2bf(pv[0]) | ((unsigned)f2bf(pv[1]) << 16);
    a.y = (unsigned)f2bf(pv[2]) | ((unsigned)f2bf(pv[3]) << 16);
    a.z = (unsigned)f2bf(pv[4]) | ((unsigned)f2bf(pv[5]) << 16);
    a.w = (unsigned)f2bf(pv[6]) | ((unsigned)f2bf(pv[7]) << 16);
    b.x = (unsigned)f2bf(pv[8]) | ((unsigned)f2bf(pv[9]) << 16);
    b.y = (unsigned)f2bf(pv[10]) | ((unsigned)f2bf(pv[11]) << 16);
    b.z = (unsigned)f2bf(pv[12]) | ((unsigned)f2bf(pv[13]) << 16);
    b.w = (unsigned)f2bf(pv[14]) | ((unsigned)f2bf(pv[15]) << 16);
    *(uint4*)(L.P + row * KSTR + part * 16) = a;
    *(uint4*)(L.P + row * KSTR + part * 16 + 8) = b;
}
__device__ __forceinline__ float row4_max(float v) {
    v = fmaxf(v, __shfl_xor(v, 1));
    v = fmaxf(v, __shfl_xor(v, 2));
    return v;
}
__device__ __forceinline__ float row4_sum(float v) {
    v += __shfl_xor(v, 1);
    v += __shfl_xor(v, 2);
    return v;
}

__device__ __forceinline__ void item_sb(const Params& p, int it) {
    const int tid = tid__, lane = tid & 63, wave = tid >> 6, quad = lane >> 4, c = lane & 15;
    const int qb = it & 63, h = (it >> 6) & 7, b = it >> 9;
    const int t0 = qb * 64;
    AttnLds L = attn_lds();
    bf16x8 qf[2];
    {
        const u16* g = p.yb + (long)(b * SS + t0 + wave * 16 + c) * NIN + C_SBQ + h * 64 + quad * 8;
        qf[0] = *(const bf16x8*)g;
        qf[1] = *(const bf16x8*)(g + 32);
    }
    const int row = lane >> 2, part = lane & 3;
    const int t = t0 + wave * 16 + row;
    float R = 0.f;
    f32x4 o[4];
#pragma unroll
    for (int dt = 0; dt < 4; ++dt) o[dt] = f32x4{0.f, 0.f, 0.f, 0.f};
    for (int kb = qb; kb >= 0; --kb) {
        __syncthreads();
        const u16* kbase = p.yb + (long)(b * SS + kb * 64) * NIN + h * 64;
        load_k_tile(L.K, 0, kbase + C_SBK, NIN);
        load_v_tile(L.Vt, 0, kbase + C_SBV, NIN);
        __syncthreads();
        wave_qk(L, 0, qf);
        __syncthreads();
        float z[16], lat[16];
        read_s16(L, row, part, z);
        float run = 0.f;
#pragma unroll
        for (int i = 15; i >= 0; --i) {
            const int key = kb * 64 + part * 16 + i;
            const bool valid = key < t;
            const float zz = z[i] * 0.125f;
            const float sp = fmaxf(zz, 0.f) + __logf(1.f + __expf(-fabsf(zz)));
            lat[i] = run;
            z[i] = valid ? (zz - sp) : -1e30f;
            run += valid ? -sp : 0.f;
        }
        const int lb = lane & ~3;
        const float t0_ = __shfl(run, lb), t1_ = __shfl(run, lb + 1), t2_ = __shfl(run, lb + 2), t3_ = __shfl(run, lb + 3);
        float off = R;
        if (part < 3) off += t3_;
        if (part < 2) off += t2_;
        if (part < 1) off += t1_;
        float pv[16];
#pragma unroll
        for (int i = 0; i < 16; ++i) pv[i] = (z[i] > -1e29f) ? __expf(z[i] + lat[i] + off) : 0.f;
        write_p16(L, row, part, pv);
        R += (t0_ + t1_) + (t2_ + t3_);
        const int done = __syncthreads_and(R < -110.f);
        wave_pv(L, 0, o);
        if (done) break;
    }
#pragma unroll
    for (int dt = 0; dt < 4; ++dt)
#pragma unroll
        for (int r = 0; r < 4; ++r)
            p.ysb[(long)(b * SS + t0 + wave * 16 + quad * 4 + r) * 512 + h * 64 + dt * 16 + c] = f2bf(o[dt][r]);
}

__device__ __forceinline__ void phase_cmp1_sb(const Params& p, int l, unsigned* ctr) {
    const int total = 32 + 8 * 8 * 64;
    WorkQ q; q.init(ctr);
    for (;;) {
        int it = q.next();
        if (it >= total) break;
        if (it < 32) tile_cmp1(p, l, it);
        else item_sb(p, it - 32);
    }
}

template <int MODE>
__device__ __forceinline__ void nsa_step(const AttnLds& L, const bf16x8 (&qf)[2], f32x4 (&o)[4], float& m, float& l,
                                         float slope, int t, int kpos0, bool rowsel) {
    const int lane = tid__ & 63, quad = lane >> 4;
    const int row = lane >> 2, part = lane & 3;
    wave_qk(L, 0, qf);
    __syncthreads();
    float z[16];
    read_s16(L, row, part, z);
    float pm = -1e30f;
#pragma unroll
    for (int i = 0; i < 16; ++i) {
        const int dist = t - (kpos0 + part * 16 + i);
        bool valid = dist >= 0;
        if (MODE == 1) valid = valid && rowsel;
        if (MODE == 2) valid = valid && (dist < 512);
        z[i] = valid ? (z[i] * 0.125f - slope * (float)dist) : -1e30f;
        pm = fmaxf(pm, z[i]);
    }
    pm = row4_max(pm);
    const float mn = fmaxf(m, pm);
    const float alpha = __expf(m - mn);
    float ps = 0.f;
#pragma unroll
    for (int i = 0; i < 16; ++i) {
        z[i] = (z[i] > -1e29f) ? __expf(z[i] - mn) : 0.f;
        ps += z[i];
    }
    ps = row4_sum(ps);
    l = l * alpha + ps;
    m = mn;
    write_p16(L, row, part, z);
    float al[4];
#pragma unroll
    for (int r = 0; r < 4; ++r) al[r] = __shfl(alpha, (quad * 4 + r) * 4);
    __syncthreads();
#pragma unroll
    for (int dt = 0; dt < 4; ++dt)
#pragma unroll
        for (int r = 0; r < 4; ++r) o[dt][r] *= al[r];
    wave_pv(L, 0, o);
    __syncthreads();
}

__device__ __forceinline__ void item_nsa(const Params& p, int it) {
    const int tid = tid__, lane = tid & 63, wave = tid >> 6, quad = lane >> 4, c = lane & 15;
    const int qb = 63 - (it >> 4), bg = it & 15, g = bg & 1, b = bg >> 1;
    const int t0 = qb * 64;
    AttnLds L = attn_lds();
    const int row = lane >> 2, part = lane & 3;
    const int t = t0 + wave * 16 + row;
    const long tokbase = (long)b * SS + t0 + wave * 16;
    float* ynf = p.ynf;
    const int nct = (2 * qb + 2 > 64) ? 2 : 1;
    const int nv = (t + 1) >> 5;
    __syncthreads();
    for (int ct = 0; ct < nct; ++ct) {
        load_k_tile(L.K, ct * 64, p.kvc + ((long)(b * 2 + g) * 128 + ct * 64) * 64, 64);
        load_v_tile(L.Vt, ct * 64, p.kvc + ((long)2048 + (b * 2 + g) * 128 + ct * 64) * 64, 64);
    }
    __syncthreads();
    float imp[2][8];
#pragma unroll
    for (int a = 0; a < 2; ++a)
#pragma unroll
        for (int j = 0; j < 8; ++j) imp[a][j] = 0.f;
#pragma unroll 1
    for (int r = 0; r < 4; ++r) {
        const float slope = exp2f(-(float)(g * 4 + r + 1));
        float m = -1e30f, l = 0.f;
        bf16x8 qfa[2];
        {
            const u16* gq = p.yb + (tokbase + c) * NIN + C_NQ + (g * 4 + r) * 64 + quad * 8;
            qfa[0] = *(const bf16x8*)gq;
            qfa[1] = *(const bf16x8*)(gq + 32);
        }
        for (int ct = 0; ct < nct; ++ct) {
            wave_qk(L, ct * 64, qfa);
            __syncthreads();
            float z[16];
            read_s16(L, row, part, z);
            float pm = -1e30f;
#pragma unroll
            for (int i = 0; i < 16; ++i) {
                const int cc = ct * 64 + part * 16 + i;
                const bool valid = cc < nv;
                z[i] = valid ? (z[i] * 0.125f - slope * (float)(t - (cc * 32 + 31))) : -1e30f;
                pm = fmaxf(pm, z[i]);
            }
            pm = row4_max(pm);
            const float mn = fmaxf(m, pm);
            float ps = 0.f;
#pragma unroll
            for (int i = 0; i < 16; ++i) ps += (z[i] > -1e29f) ? __expf(z[i] - mn) : 0.f;
            ps = row4_sum(ps);
            l = l * __expf(m - mn) + ps;
            m = mn;
            __syncthreads();
        }
        const float inv = (l > 0.f) ? 1.f / l : 0.f;
        f32x4 o[4];
#pragma unroll
        for (int dt = 0; dt < 4; ++dt) o[dt] = f32x4{0.f, 0.f, 0.f, 0.f};
#pragma unroll 1
        for (int ct = 0; ct < nct; ++ct) {
            wave_qk(L, ct * 64, qfa);
            __syncthreads();
            float z[16];
            read_s16(L, row, part, z);
#pragma unroll
            for (int i = 0; i < 16; ++i) {
                const int cc = ct * 64 + part * 16 + i;
                const bool valid = cc < nv;
                const float s = z[i] * 0.125f - slope * (float)(t - (cc * 32 + 31));
                z[i] = valid ? __expf(s - m) * inv : 0.f;
            }
            const float f0 = (ct == 0) ? 1.f : 0.f, f1 = 1.f - f0;
#pragma unroll
            for (int j = 0; j < 8; ++j) {
                const float pr = z[2 * j] + z[2 * j + 1];
                imp[0][j] += f0 * pr;
                imp[1][j] += f1 * pr;
            }
            write_p16(L, row, part, z);
            __syncthreads();
            wave_pv(L, ct * 64, o);
            __syncthreads();
        }
#pragma unroll
        for (int rr = 0; rr < 4; ++rr) {
            const long tok = tokbase + quad * 4 + rr;
            const float gt = sigmoidf_(bf2f(p.yb[tok * NIN + C_NG + (g * 4 + r) * 3 + 0]));
#pragma unroll
            for (int dt = 0; dt < 4; ++dt) ynf[tok * 512 + (g * 4 + r) * 64 + dt * 16 + c] = gt * o[dt][rr];
        }
    }
#pragma unroll
    for (int a = 0; a < 2; ++a)
#pragma unroll
        for (int j = 0; j < 8; ++j) L.S[row * SSTR + a * 32 + part * 8 + j] = imp[a][j];
    __syncthreads();
    unsigned long long un = 0ull;
#ifndef NSA_NOTOPK
#define NSA_NOTOPK 0
#endif
#pragma unroll 1
    for (int rr = 0; rr < (NSA_NOTOPK ? 0 : 16); ++rr) {
        float v = L.S[rr * SSTR + lane];
        const bool forced = (lane == 0) || (lane == qb) || (lane == qb - 1);
        const bool validb = lane <= qb;
        v = forced ? 1e6f : (validb ? v : -1e30f);
        int rank = 0;
#pragma unroll 8
        for (int i = 0; i < 64; ++i) {
            const float vi = __shfl(v, i);
            rank += ((vi > v) || (vi == v && i < lane)) ? 1 : 0;
        }
        const unsigned long long mk = __ballot((rank < 16) && validb);
        if (lane == 0) s_mask[wave][rr] = mk;
        un |= mk;
    }
    if (lane == 0) s_union[wave] = un;
    __syncthreads();
    const unsigned long long rowmask = s_mask[wave][row];
    unsigned long long umask;
    {
        const unsigned long long um_ = s_union[0] | s_union[1] | s_union[2] | s_union[3];
        const unsigned lo_ = __builtin_amdgcn_readfirstlane((unsigned)um_), hi_ = __builtin_amdgcn_readfirstlane((unsigned)(um_ >> 32));
        umask = ((unsigned long long)hi_ << 32) | lo_;
    }
#ifndef NSA_HPB
#define NSA_HPB 1
#endif
#ifndef NSA_NOBC
#define NSA_NOBC 0
#endif
#pragma unroll 1
    for (int hp = 0; hp < (NSA_NOBC ? 0 : 4 / NSA_HPB); ++hp) {
#pragma unroll 1
        for (int mode = 1; mode <= 2; ++mode) {
            f32x4 o[NSA_HPB][4];
            float m[NSA_HPB], l[NSA_HPB];
#pragma unroll
            for (int r = 0; r < NSA_HPB; ++r) {
                m[r] = -1e30f; l[r] = 0.f;
#pragma unroll
                for (int dt = 0; dt < 4; ++dt) o[r][dt] = f32x4{0.f, 0.f, 0.f, 0.f};
            }
            const int kb_lo = (mode == 1) ? 0 : ((qb - 8 > 0) ? qb - 8 : 0);
            const int colk = (mode == 1) ? C_KS : C_KW, colv = (mode == 1) ? C_VS : C_VW;
            for (int kb = kb_lo; kb <= qb; ++kb) {
                if (mode == 1 && !((umask >> kb) & 1ull)) continue;
                const u16* kbase = p.yb + (long)(b * SS + kb * 64) * NIN + g * 64;
                bf16x8 qf[NSA_HPB][2];
#pragma unroll
                for (int r = 0; r < NSA_HPB; ++r) {
                    const u16* gq = p.yb + (tokbase + c) * NIN + C_NQ + (g * 4 + hp * NSA_HPB + r) * 64 + quad * 8;
                    qf[r][0] = *(const bf16x8*)gq;
                    qf[r][1] = *(const bf16x8*)(gq + 32);
                }
                load_k_tile(L.K, 0, kbase + colk, NIN);
                load_v_tile(L.Vt, 0, kbase + colv, NIN);
                __syncthreads();
                const bool rowsel = (rowmask >> kb) & 1ull;
#pragma unroll
                for (int r = 0; r < NSA_HPB; ++r) {
                    const float slope = exp2f(-(float)(g * 4 + hp * NSA_HPB + r + 1));
                    if (mode == 1) nsa_step<1>(L, qf[r], o[r], m[r], l[r], slope, t, kb * 64, rowsel);
                    else nsa_step<2>(L, qf[r], o[r], m[r], l[r], slope, t, kb * 64, rowsel);
                }
            }
#pragma unroll
            for (int r = 0; r < NSA_HPB; ++r) {
                const int hh = g * 4 + hp * NSA_HPB + r;
#pragma unroll
                for (int rr = 0; rr < 4; ++rr) {
                    const long tok = tokbase + quad * 4 + rr;
                    const float lr = __shfl(l[r], (quad * 4 + rr) * 4);
                    const float gt = sigmoidf_(bf2f(p.yb[tok * NIN + C_NG + hh * 3 + mode])) / lr;
#pragma unroll
                    for (int dt = 0; dt < 4; ++dt) {
                        const long oi = tok * 512 + hh * 64 + dt * 16 + c;
                        const float v = ynf[oi] + gt * o[r][dt][rr];
                        if (mode == 1) ynf[oi] = v;
                        else p.ynsa[oi] = f2bf(v);
                    }
                }
            }
        }
    }
}
__device__ __forceinline__ void phase_nsa(const Params& p, unsigned* ctr) {
    WorkQ q; q.init(ctr);
    for (;;) {
        int it = q.next();
        if (it >= 1024) break;
        item_nsa(p, it);
    }
}

__device__ __forceinline__ void phase_br(const Params& p, int l, unsigned* ctr) {
    const int tid = tid__;
    XQ q; q.init(ctr, 32 * 8);
    for (;;) {
        int it = q.next();
        if (it < 0) break;
        int mt, nt; xq_decode(it, 32, 8, mt, nt);
        const int m0 = mt * 128, n0 = nt * 128;
        const u16* ap[4]; const u16* bp[4];
        f32x4 acc[4][4];
        acc_zero(acc);
#pragma unroll
        for (int i = 0; i < 4; ++i) {
            int r = (tid >> 3) + 32 * i;
            ap[i] = p.ysb + (long)(m0 + r) * 512;
            bp[i] = p.wt_brs + ((long)l * 1024 + n0 + r) * 512;
        }
        gemm_main(acc, ap, bp, 512, KId());
        EPI_COORDS
#pragma unroll
        for (int i = 0; i < 4; ++i)
#pragma unroll
            for (int j = 0; j < 4; ++j) {
                const int m = m0 + EPI_M(j), n = n0 + EPI_N(i);
                const uint2 ga = *(const uint2*)(p.yb + (long)m * NIN + C_GSB + n);
                float4 o;
                o.x = sigmoidf_(bf2f((u16)(ga.x & 0xffff))) * acc[i][j][0];
                o.y = sigmoidf_(bf2f((u16)(ga.x >> 16))) * acc[i][j][1];
                o.z = sigmoidf_(bf2f((u16)(ga.y & 0xffff))) * acc[i][j][2];
                o.w = sigmoidf_(bf2f((u16)(ga.y >> 16))) * acc[i][j][3];
                *(float4*)(p.pre1 + (long)m * 1024 + n) = o;
            }
        acc_zero(acc);
#pragma unroll
        for (int i = 0; i < 4; ++i) {
            int r = (tid >> 3) + 32 * i;
            ap[i] = p.ynsa + (long)(m0 + r) * 512;
            bp[i] = p.wt_brn + ((long)l * 1024 + n0 + r) * 512;
        }
        gemm_main(acc, ap, bp, 512, KId());
#pragma unroll
        for (int i = 0; i < 4; ++i)
#pragma unroll
            for (int j = 0; j < 4; ++j) {
                const int m = m0 + EPI_M(j), n = n0 + EPI_N(i);
                const uint2 gb = *(const uint2*)(p.yb + (long)m * NIN + C_GNSA + n);
                const float4 st = *(const float4*)(p.pre1 + (long)m * 1024 + n);
                st_bf4(p.merged + (long)m * 1024 + n,
                       st.x + sigmoidf_(bf2f((u16)(gb.x & 0xffff))) * acc[i][j][0],
                       st.y + sigmoidf_(bf2f((u16)(gb.x >> 16))) * acc[i][j][1],
                       st.z + sigmoidf_(bf2f((u16)(gb.y & 0xffff))) * acc[i][j][2],
                       st.w + sigmoidf_(bf2f((u16)(gb.y >> 16))) * acc[i][j][3]);
            }
    }
}
__device__ __forceinline__ void phase_wo(const Params& p, int l, unsigned* ctr) {
    const int tid = tid__;
    XQ q; q.init(ctr, 32 * 8);
    for (;;) {
        int it = q.next();
        if (it < 0) break;
        int mt, nt; xq_decode(it, 32, 8, mt, nt);
        const int m0 = mt * 128, n0 = nt * 128;
        const u16* ap[4]; const u16* bp[4];
        f32x4 acc[4][4]; acc_zero(acc);
#pragma unroll
        for (int i = 0; i < 4; ++i) {
            int r = (tid >> 3) + 32 * i;
            ap[i] = p.merged + (long)(m0 + r) * 1024;
            bp[i] = p.wt_o + ((long)l * 1024 + n0 + r) * 1024;
        }
        gemm_main(acc, ap, bp, 1024, KId());
        EPI_COORDS
#pragma unroll
        for (int i = 0; i < 4; ++i)
#pragma unroll
            for (int j = 0; j < 4; ++j) {
                const int m = m0 + EPI_M(j), n = n0 + EPI_N(i);
                const float4 hv = *(const float4*)(p.hf + (long)m * 1024 + n);
                float4 o;
                o.x = DN_ALPHA * hv.x + acc[i][j][0]; o.y = DN_ALPHA * hv.y + acc[i][j][1];
                o.z = DN_ALPHA * hv.z + acc[i][j][2]; o.w = DN_ALPHA * hv.w + acc[i][j][3];
                *(float4*)(p.pre1 + (long)m * 1024 + n) = o;
            }
    }
}
__device__ __forceinline__ float wave_sum(float v) {
#pragma unroll
    for (int s = 32; s >= 1; s >>= 1) v += __shfl_xor(v, s);
    return v;
}
__device__ __forceinline__ void phase_ln(const Params& p, int l, int mode, unsigned* ctr) {
    const int lane = tid__ & 63, wave = tid__ >> 6;
    const float* gam = (mode == 1 ? p.ln1_g : p.ln2_g) + l * 1024;
    const float* bet = (mode == 1 ? p.ln1_b : p.ln2_b) + l * 1024;
    WorkQ q; q.init(ctr);
    for (;;) {
        int it = q.next();
        if (it >= TT / 64) break;
        for (int rr = 0; rr < 16; ++rr) {
            const long row = (long)it * 64 + wave * 16 + rr;
            float v[16];
#pragma unroll
            for (int i = 0; i < 4; ++i) {
                const int col = i * 256 + lane * 4;
                float4 a;
                if (mode == 1) a = *(const float4*)(p.pre1 + row * 1024 + col);
                else {
                    a = *(const float4*)(p.h1f + row * 1024 + col);
                    a.x *= DN_ALPHA; a.y *= DN_ALPHA; a.z *= DN_ALPHA; a.w *= DN_ALPHA;
                    const uint2 pl = *(const uint2*)(p.ple + row * 1024 + col);
                    a.x += bf2f((u16)(pl.x & 0xffff)); a.y += bf2f((u16)(pl.x >> 16));
                    a.z += bf2f((u16)(pl.y & 0xffff)); a.w += bf2f((u16)(pl.y >> 16));
#pragma unroll
                    for (int s = 0; s < 4; ++s) {
                        const uint2 y = *(const uint2*)(p.y4 + (row * 4 + s) * 1024 + col);
                        a.x += bf2f((u16)(y.x & 0xffff)); a.y += bf2f((u16)(y.x >> 16));
                        a.z += bf2f((u16)(y.y & 0xffff)); a.w += bf2f((u16)(y.y >> 16));
                    }
                }
                v[i * 4 + 0] = a.x; v[i * 4 + 1] = a.y; v[i * 4 + 2] = a.z; v[i * 4 + 3] = a.w;
            }
            float s = 0.f;
#pragma unroll
            for (int i = 0; i < 16; ++i) s += v[i];
            const float mean = wave_sum(s) * (1.f / 1024.f);
            float s2 = 0.f;
#pragma unroll
            for (int i = 0; i < 16; ++i) { v[i] -= mean; s2 += v[i] * v[i]; }
            const float rstd = rsqrtf(wave_sum(s2) * (1.f / 1024.f) + 1e-5f);
#pragma unroll
            for (int i = 0; i < 4; ++i) {
                const int col = i * 256 + lane * 4;
                const float4 gg = *(const float4*)(gam + col), bb = *(const float4*)(bet + col);
                float4 y;
                y.x = v[i * 4 + 0] * rstd * gg.x + bb.x; y.y = v[i * 4 + 1] * rstd * gg.y + bb.y;
                y.z = v[i * 4 + 2] * rstd * gg.z + bb.z; y.w = v[i * 4 + 3] * rstd * gg.w + bb.w;
                if (mode == 1) {
                    *(float4*)(p.h1f + row * 1024 + col) = y;
                    const u16 h0 = f2bf(y.x), h1 = f2bf(y.y), h2 = f2bf(y.z), h3 = f2bf(y.w);
                    uint2 u; u.x = (unsigned)h0 | ((unsigned)h1 << 16); u.y = (unsigned)h2 | ((unsigned)h3 << 16);
                    *(uint2*)(p.h1b + row * 1024 + col) = u;
                    st_bf4(p.h1lo + row * 1024 + col, y.x - bf2f(h0), y.y - bf2f(h1), y.z - bf2f(h2), y.w - bf2f(h3));
                } else {
                    if (l == 3) *(float4*)(p.out + row * 1024 + col) = y;
                    else {
                        *(float4*)(p.hf + row * 1024 + col) = y;
                        st_bf4(p.hb + row * 1024 + col, y.x, y.y, y.z, y.w);
                    }
                }
            }
        }
    }
}
struct KRouter {
    long dlo;
    __device__ __forceinline__ long operator()(int k) const { return (k < 2048) ? (long)(k & 1023) : (dlo + (k - 2048)); }
};
__device__ __forceinline__ void phase_router_ple(const Params& p, int l, unsigned* ctr) {
    const int tid = tid__;
    XQ q; q.init(ctr, 32 * 9);
    for (;;) {
        int it = q.next();
        if (it < 0) break;
        int mt, nt; xq_decode(it, 32, 9, mt, nt);
        const u16* ap[4]; const u16* bp[4];
        if (nt == 8) {
            const int m0 = mt * 128;
            f32x4 acc[4][4]; acc_zero(acc);
#pragma unroll
            for (int i = 0; i < 4; ++i) {
                int r = (tid >> 3) + 32 * i;
                ap[i] = p.h1b + (long)(m0 + r) * 1024;
                bp[i] = p.wt_r + ((long)l * 32 + (r & 31)) * 3072;
            }
            KRouter kr; kr.dlo = (long)(p.h1lo - p.h1b);
            gemm_main(acc, ap, bp, 3072, kr);
            EPI_COORDS
#pragma unroll
            for (int i = 0; i < 4; ++i)
#pragma unroll
                for (int j = 0; j < 4; ++j) {
                    const int m = m0 + EPI_M(j), n = EPI_N(i);
                    if (n < 32) {
                        const float4 bb = *(const float4*)(p.b_router + l * 32 + n);
                        float4 o; o.x = acc[i][j][0] + bb.x; o.y = acc[i][j][1] + bb.y; o.z = acc[i][j][2] + bb.z; o.w = acc[i][j][3] + bb.w;
                        *(float4*)(p.logits + (long)m * 32 + n) = o;
                    }
                }
        } else {
            const int m0 = mt * 128, n0 = nt * 128;
            f32x4 acc[4][4];
            acc_zero(acc);
#pragma unroll
            for (int i = 0; i < 4; ++i) {
                int r = (tid >> 3) + 32 * i;
                ap[i] = p.pb + ((long)l * TT + m0 + r) * 256;
                bp[i] = p.wt_pp + ((long)l * 1024 + n0 + r) * 256;
            }
            gemm_main(acc, ap, bp, 256, KId());
            EPI_COORDS
#pragma unroll
            for (int i = 0; i < 4; ++i)
#pragma unroll
                for (int j = 0; j < 4; ++j) {
                    const int m = m0 + EPI_M(j), n = n0 + EPI_N(i);
                    float4 o; o.x = acc[i][j][0]; o.y = acc[i][j][1]; o.z = acc[i][j][2]; o.w = acc[i][j][3];
                    *(float4*)(p.pre1 + (long)m * 1024 + n) = o;
                }
            acc_zero(acc);
#pragma unroll
            for (int i = 0; i < 4; ++i) {
                int r = (tid >> 3) + 32 * i;
                ap[i] = p.h1b + (long)(m0 + r) * 1024;
                bp[i] = p.wt_pg + ((long)l * 1024 + n0 + r) * 1024;
            }
            gemm_main(acc, ap, bp, 1024, KId());
#pragma unroll
            for (int i = 0; i < 4; ++i)
#pragma unroll
                for (int j = 0; j < 4; ++j) {
                    const int m = m0 + EPI_M(j), n = n0 + EPI_N(i);
                    const float4 st = *(const float4*)(p.pre1 + (long)m * 1024 + n);
                    st_bf4(p.ple + (long)m * 1024 + n, sigmoidf_(acc[i][j][0]) * st.x, sigmoidf_(acc[i][j][1]) * st.y,
                           sigmoidf_(acc[i][j][2]) * st.z, sigmoidf_(acc[i][j][3]) * st.w);
                }
        }
    }
}
__device__ __forceinline__ void phase_route(const Params& p, int l, unsigned* ctr) {
    const int tid = tid__;
    int* s_cnt = s_misc;
    int* s_base = s_misc + 32;
    WorkQ q; q.init(ctr);
    for (;;) {
        int it = q.next();
        if (it >= TT / 256) break;
        if (tid < 32) s_cnt[tid] = 0;
        __syncthreads();
        const int t = it * 256 + tid;
        float lg[32];
#pragma unroll
        for (int i = 0; i < 8; ++i) {
            const float4 v = *(const float4*)(p.logits + (long)t * 32 + i * 4);
            lg[i * 4 + 0] = v.x; lg[i * 4 + 1] = v.y; lg[i * 4 + 2] = v.z; lg[i * 4 + 3] = v.w;
        }
        unsigned taken = 0u;
        int ek[4]; float vk[4];
#pragma unroll
        for (int k = 0; k < 4; ++k) {
            float best = -3.0e38f; int bi = 0;
#pragma unroll
            for (int e = 0; e < 32; ++e) {
                const bool ok = !((taken >> e) & 1u) && (lg[e] > best);
                best = ok ? lg[e] : best;
                bi = ok ? e : bi;
            }
            taken |= 1u << bi;
            ek[k] = bi; vk[k] = best;
        }
        float wsum = 0.f;
        float v0 = -3.0e38f, v1 = 0.f, v2 = 0.f, v3 = 0.f;
#pragma unroll
        for (int e = 0; e < 32; ++e) {
            v0 = (e == ek[0]) ? lg[e] : v0;
            v1 = (e == ek[1]) ? lg[e] : v1;
            v2 = (e == ek[2]) ? lg[e] : v2;
            v3 = (e == ek[3]) ? lg[e] : v3;
        }
        vk[0] = 1.f; vk[1] = __expf(v1 - v0); vk[2] = __expf(v2 - v0); vk[3] = __expf(v3 - v0);
        wsum = vk[0] + vk[1] + vk[2] + vk[3];
        const float winv = 1.f / wsum;
        int lp[4];
#pragma unroll
        for (int k = 0; k < 4; ++k) lp[k] = atomicAdd(&s_cnt[ek[k]], 1);
        __syncthreads();
        if (tid < 32) s_base[tid] = (int)atomicAdd(&p.ecnt[l * 32 + tid], (unsigned)s_cnt[tid]);
        __syncthreads();
#pragma unroll
        for (int k = 0; k < 4; ++k) {
            const long idx = (long)ek[k] * TT + s_base[ek[k]] + lp[k];
            p.ent_id[idx] = t * 4 + k;
            p.ent_w[idx] = vk[k] * winv;
        }
    }
}
__device__ __forceinline__ void moe_prefix(const Params& p, int l) {
    __syncthreads();
    if (tid__ == 0) {
        int acc = 0;
        for (int e = 0; e < 32; ++e) {
            const int n = (int)__hip_atomic_load(&p.ecnt[l * 32 + e], __ATOMIC_RELAXED, __HIP_MEMORY_SCOPE_AGENT);
            s_misc[e] = acc;
            s_misc[40 + e] = n;
            acc += (n + 127) >> 7;
        }
        s_misc[32] = acc;
    }
    __syncthreads();
}
__device__ __forceinline__ void phase_moe_gu(const Params& p, int l, unsigned* ctr) {
    const int tid = tid__;
    moe_prefix(p, l);
    const int mtotal = s_misc[32];
    const int mpx = (((mtotal + 7) >> 3) + 7) & ~7;
    XQ q; q.init(ctr, mpx * 16);
    for (;;) {
        int it = q.next();
        if (it < 0) break;
        int mtg, nt; xq_decode(it, mpx, 16, mtg, nt);
        if (mtg >= mtotal) continue;
        int e = 0;
        for (int i = 1; i < 32; ++i) e = (s_misc[i] <= mtg) ? i : e;
        const int mt = mtg - s_misc[e], ne = s_misc[40 + e];
        const u16* ap[4]; const u16* bp[4];
#pragma unroll
        for (int i = 0; i < 4; ++i) {
            const int r = (tid >> 3) + 32 * i;
            int idx = mt * 128 + r; if (idx > ne - 1) idx = ne - 1;
            const int tok = p.ent_id[(long)e * TT + idx] >> 2;
            ap[i] = p.h1b + (long)tok * 1024;
            const int isup = (r >> 5) & 1, col = (r >> 6) * 32 + (r & 31);
            bp[i] = p.wt_gu + (((long)l * 32 + e) * 2048 + isup * 1024 + nt * 64 + col) * 1024;
        }
        f32x4 acc[4][4]; acc_zero(acc);
        gemm_main(acc, ap, bp, 1024, KId());
        EPI_COORDS
        const float* bg = p.b_gu + ((long)l * 32 + e) * 2048;
#pragma unroll
        for (int i = 0; i < 2; ++i)
#pragma unroll
            for (int j = 0; j < 4; ++j) {
                const long rowa = (long)mtg * 128 + EPI_M(j);
                const int col = nt * 64 + wn_ * 32 + i * 16 + (lane_ >> 4) * 4;
                float v[4];
#pragma unroll
                for (int r = 0; r < 4; ++r) {
                    float gate = acc[i][j][r] + bg[col + r];
                    float up = acc[i + 2][j][r] + bg[1024 + col + r];
                    gate = fminf(gate, 7.f);
                    up = fminf(fmaxf(up, -7.f), 7.f);
                    v[r] = (up + 1.f) * gate * sigmoidf_(1.702f * gate);
                }
                st_bf4(p.act + rowa * 1024 + col, v[0], v[1], v[2], v[3]);
            }
    }
}
__device__ __forceinline__ void phase_moe_down(const Params& p, int l, unsigned* ctr) {
    const int tid = tid__;
    moe_prefix(p, l);
    const int mtotal = s_misc[32];
    const int mpx = (((mtotal + 7) >> 3) + 7) & ~7;
    XQ q; q.init(ctr, mpx * 8);
    for (;;) {
        int it = q.next();
        if (it < 0) break;
        int mtg, nt; xq_decode(it, mpx, 8, mtg, nt);
        if (mtg >= mtotal) continue;
        int e = 0;
        for (int i = 1; i < 32; ++i) e = (s_misc[i] <= mtg) ? i : e;
        const int mt = mtg - s_misc[e], ne = s_misc[40 + e];
        const u16* ap[4]; const u16* bp[4];
#pragma unroll
        for (int i = 0; i < 4; ++i) {
            const int r = (tid >> 3) + 32 * i;
            ap[i] = p.act + ((long)mtg * 128 + r) * 1024;
            bp[i] = p.wt_dn + (((long)l * 32 + e) * 1024 + nt * 128 + r) * 1024;
        }
        f32x4 acc[4][4]; acc_zero(acc);
        gemm_main(acc, ap, bp, 1024, KId());
        EPI_COORDS
        const float* bd = p.b_down + ((long)l * 32 + e) * 1024;
#pragma unroll
        for (int j = 0; j < 4; ++j) {
            const int idx = mt * 128 + EPI_M(j);
            if (idx < ne) {
                const int id = p.ent_id[(long)e * TT + idx];
                const float cw = p.ent_w[(long)e * TT + idx];
#pragma unroll
                for (int i = 0; i < 4; ++i) {
                    const int n = nt * 128 + EPI_N(i);
                    const float4 bb = *(const float4*)(bd + n);
                    st_bf4(p.y4 + (long)id * 1024 + n, cw * (acc[i][j][0] + bb.x), cw * (acc[i][j][1] + bb.y),
                           cw * (acc[i][j][2] + bb.z), cw * (acc[i][j][3] + bb.w));
                }
            }
        }
    }
}

};
#ifndef PH0_EN
#define PH0_EN 1
#endif
__device__ __forceinline__ void run_phase(const Params& p, int ph, int coff) {
    unsigned* ctr = p.ctr + (ph + coff) * 8;
    Ctx cx;
    {
        int t_ = threadIdx.x;
        asm volatile("" : "+v"(t_));
        cx.tid__ = t_;
    }
    if (ph == 0) { if (PH0_EN) cx.phase_prologue(p, ctr); return; }
    const int l = (ph - 1) / NPH_LAYER, s = (ph - 1) % NPH_LAYER;
#ifndef ONLY_S
#define ONLY_S -1
#endif
#ifndef SKIP_S
#define SKIP_S -1
#endif
#define PH_EN(x) ((ONLY_S < 0 || ONLY_S == (x)) && SKIP_S != (x))
    if (PH_EN(0) && s == 0) cx.phase_gemm_in(p, l, ctr);
    if (PH_EN(1) && s == 1) cx.phase_cmp1_sb(p, l, ctr);
    if (PH_EN(2) && s == 2) cx.phase_cmp2(p, l, ctr);
    if (PH_EN(3) && s == 3) cx.phase_nsa(p, ctr);
    if (PH_EN(4) && s == 4) cx.phase_br(p, l, ctr);
    if (PH_EN(5) && s == 5) cx.phase_wo(p, l, ctr);
    if (PH_EN(6) && s == 6) cx.phase_ln(p, l, 1, ctr);
    if (PH_EN(7) && s == 7) cx.phase_router_ple(p, l, ctr);
    if (PH_EN(8) && s == 8) cx.phase_route(p, l, ctr);
    if (PH_EN(9) && s == 9) cx.phase_moe_gu(p, l, ctr);
    if (PH_EN(10) && s == 10) cx.phase_moe_down(p, l, ctr);
    if (PH_EN(11) && s == 11) cx.phase_ln(p, l, 2, ctr);
}

__global__ void __launch_bounds__(256, 2) mega_kernel(Params p, int ph0, int ph1) {
    __shared__ uint4 xb_words;
    if (threadIdx.x == 0) xb_words = make_uint4(0u, 0u, 0u, 0u);
    __syncthreads();
    __shared__ Params s_p;
    if (threadIdx.x == 0) {
        const void* const* src_ = (const void* const*)&p;
        const void** dst_ = (const void**)&s_p;
#pragma unroll
        for (int i = 0; i < (int)(sizeof(Params) / sizeof(void*)); ++i) dst_[i] = src_[i];
    }
    __syncthreads();
    XcdBarrier bar = xcd_barrier_post(p.bar, (volatile LAS unsigned*)&xb_words);
    for (int ph = ph0; ph < ph1; ++ph) {
        if (ph > ph0) xcd_barrier(bar);
        asm volatile("" ::: "memory");
        run_phase(s_p, ph, 0);
#if REP_MASK
        if (ph > 0 && ((REP_MASK >> ((ph - 1) % NPH_LAYER)) & 1)) {
            xcd_barrier(bar);
            asm volatile("" ::: "memory");
            run_phase(s_p, ph, 64);
        }
#endif
    }
}

#ifndef REP_MASK
#define REP_MASK 0
#endif
#ifndef MK_SPLIT
#define MK_SPLIT 0
#endif

extern "C" void kernel_launch(void* const* d_in, const int* in_sizes, int n_in, void* d_out, int out_size, void* d_ws,
                              size_t ws_size, hipStream_t stream) {
    static int grid = 0;
    if (!grid) {
        int dev = 0, cus = 0, per_cu = 0;
        hipGetDevice(&dev);
        hipDeviceGetAttribute(&cus, hipDeviceAttributeMultiprocessorCount, dev);
        hipOccupancyMaxActiveBlocksPerMultiprocessor(&per_cu, mega_kernel, 256, 0);
        if (per_cu < 1) per_cu = 1;
        grid = cus * (per_cu < 2 ? per_cu : 2);
    }
    Params p;
    memset(&p, 0, sizeof(p));
    const float** pin = (const float**)&p;
    for (int i = 0; i < 21; ++i) pin[i] = (const float*)d_in[i];
    p.out = (float*)d_out;
    char* w = (char*)d_ws;
    size_t off = 0;
    auto take = [&](size_t bytes) { char* r = w + off; off += (bytes + 255) & ~(size_t)255; return r; };
    const size_t sync_bytes = (XCD_BAR_WORDS + 1024 + 128) * sizeof(unsigned);
    p.bar = (unsigned*)take(sync_bytes);
    p.ctr = p.bar + XCD_BAR_WORDS;
    p.ecnt = p.ctr + 1024;
    p.wt_in = (u16*)take((size_t)4 * NIN * 1024 * 2);
    p.wt_brs = (u16*)take((size_t)4 * 512 * 1024 * 2);
    p.wt_brn = (u16*)take((size_t)4 * 512 * 1024 * 2);
    p.wt_o = (u16*)take((size_t)4 * 1024 * 1024 * 2);
    p.wt_pg = (u16*)take((size_t)4 * 1024 * 1024 * 2);
    p.wt_pp = (u16*)take((size_t)4 * 256 * 1024 * 2);
    p.wt_gu = (u16*)take((size_t)128 * 2048 * 1024 * 2);
    p.wt_dn = (u16*)take((size_t)128 * 1024 * 1024 * 2);
    p.wt_c1 = (u16*)take((size_t)8 * 128 * 2048 * 2);
    p.wt_c2 = (u16*)take((size_t)8 * 64 * 128 * 2);
    p.wt_r = (u16*)take((size_t)4 * 32 * 3072 * 2);
    p.cbias = (float*)take(1024 * 4);
    p.hf = (float*)take((size_t)TT * 1024 * 4);
    p.pre1 = (float*)take((size_t)TT * 1024 * 4);
    p.h1f = (float*)take((size_t)TT * 1024 * 4);
    p.logits = (float*)take((size_t)TT * 32 * 4);
    p.ynf = (float*)take((size_t)TT * 512 * 4);
    p.ent_w = (float*)take((size_t)32 * TT * 4);
    p.hb = (u16*)take((size_t)TT * 1024 * 2);
    p.pb = (u16*)take((size_t)4 * TT * 256 * 2);
    p.yb = (u16*)take((size_t)TT * NIN * 2);
    p.ysb = (u16*)take((size_t)TT * 512 * 2);
    p.ynsa = (u16*)take((size_t)TT * 512 * 2);
    p.merged = (u16*)take((size_t)TT * 1024 * 2);
    p.h1b = (u16*)take((size_t)TT * 1024 * 2);
    p.h1lo = (u16*)take((size_t)TT * 1024 * 2);
    p.ple = (u16*)take((size_t)TT * 1024 * 2);
    p.hid = (u16*)take((size_t)2 * 2048 * 128 * 2);
    p.kvc = (u16*)take((size_t)2 * 2048 * 64 * 2);
    p.act = (u16*)take((size_t)(TT * 4 + 32 * 128) * 1024 * 2);
    p.y4 = (u16*)take((size_t)TT * 4 * 1024 * 2);
    p.ent_id = (int*)take((size_t)32 * TT * 4);
    if (off > ws_size) { fprintf(stderr, "workspace too small: need %zu have %zu\n", off, ws_size); return; }
    hipMemsetAsync(p.bar, 0, sync_bytes, stream);
#if MK_SPLIT
    for (int ph = 0; ph < NPHASE; ++ph) mega_kernel<<<dim3(grid), dim3(256), 0, stream>>>(p, ph, ph + 1);
#else
    mega_kernel<<<dim3(grid), dim3(256), 0, stream>>>(p, 0, NPHASE);
#endif
}
```

```cpp
#include <hip/hip_runtime.h>
#include <stdint.h>
#include <cstdio>
#include <cstring>
#include <cstdlib>
#include <vector>

#define XB_TMO      128
#define XB_XCNT(j)  (256  + 64 * (j))
#define XB_XSUB(j)  (1280 + 64 * (j))
#define XB_XGEN(j)  (2304 + 64 * (j))
#define XB_TOP      3328
#define XB_TOPGEN   3392
#define XCD_BAR_WORDS 3456
#define XB_SPIN_CAP (1u << 18)
#define LAS __attribute__((address_space(3)))

__device__ __forceinline__ unsigned xb_ld(unsigned* p)              { return __hip_atomic_load(p, __ATOMIC_RELAXED, __HIP_MEMORY_SCOPE_AGENT); }
__device__ __forceinline__ unsigned xb_add(unsigned* p, unsigned v) { return __hip_atomic_fetch_add(p, v, __ATOMIC_RELAXED, __HIP_MEMORY_SCOPE_AGENT); }
__device__ __forceinline__ unsigned xb_xcc_id() { return (unsigned)__builtin_amdgcn_s_getreg((3 << 11) | 20) & 0xFu; }
#define XB_SPIN(cond, bar) do { unsigned _sp = 0; while (cond) { __builtin_amdgcn_s_sleep(1); \
    if ((++_sp & 255u) == 0u) { if (xb_ld(&(bar)[XB_TMO])) break; if (_sp > XB_SPIN_CAP) { atomicAdd(&(bar)[XB_TMO], 1u); break; } } } } while (0)

struct XcdBarrier {
    unsigned* bar; unsigned x;
    volatile LAS unsigned* st;
};

__device__ __forceinline__ XcdBarrier xcd_barrier_post(unsigned* bar, volatile LAS unsigned* st) {
    XcdBarrier b; b.bar = bar; b.x = xb_xcc_id(); b.st = st;
    if (threadIdx.x == 0) (void)xb_add(&bar[XB_XCNT(b.x)], 1u);
    return b;
}
__device__ __forceinline__ void xcd_barrier_complete(unsigned* bar, unsigned x, unsigned& nloc, unsigned& nx) {
    const unsigned G = gridDim.x * gridDim.y * gridDim.z;
    unsigned sum, cnt, mine, sp = 0u;
    for (;;) {
        sum = 0u; cnt = 0u; mine = 0u;
#pragma unroll
        for (unsigned j = 0; j < 16; ++j) { const unsigned c = xb_ld(&bar[XB_XCNT(j)]); sum += c; cnt += (c > 0u) ? 1u : 0u; mine = (j == x) ? c : mine; }
        if (sum == G) break;
        __builtin_amdgcn_s_sleep(1);
        if ((++sp & 255u) == 0u) { if (xb_ld(&bar[XB_TMO])) break; if (sp > XB_SPIN_CAP) { atomicAdd(&bar[XB_TMO], 1u); break; } }
    }
    nloc = mine > 0u ? mine : 1u; nx = cnt > 0u ? cnt : 1u;
}

__device__ __forceinline__ void xcd_barrier(const XcdBarrier& b) {
    asm volatile("s_waitcnt vmcnt(0)" ::: "memory");
    __syncthreads();
    if (threadIdx.x == 0) {
        unsigned* bar = b.bar;
        __builtin_amdgcn_s_waitcnt(0);
        unsigned nloc = b.st[0], nx = b.st[1];
        if (nloc == 0u) { xcd_barrier_complete(bar, b.x, nloc, nx); b.st[0] = nloc; b.st[1] = nx; }
        const unsigned old = xb_add(&bar[XB_XSUB(b.x)], 1u);
        const unsigned gen = old / nloc;
        if (old + 1u == (gen + 1u) * nloc) {
            __builtin_amdgcn_fence(__ATOMIC_RELEASE, "agent");
            asm volatile("s_waitcnt vmcnt(0)" ::: "memory");
            const unsigned og = xb_add(&bar[XB_TOP], 1u);
            const unsigned tg = og / nx;
            if (og + 1u == (tg + 1u) * nx) xb_add(&bar[XB_TOPGEN], 1u);
            else XB_SPIN(xb_ld(&bar[XB_TOPGEN]) == tg, bar);
            __builtin_amdgcn_fence(__ATOMIC_ACQUIRE, "agent");
            xb_add(&bar[XB_XGEN(b.x)], 1u);
            asm volatile("s_waitcnt vmcnt(0)" ::: "memory");
        } else {
            XB_SPIN(xb_ld(&bar[XB_XGEN(b.x)]) == gen, bar);
            __builtin_amdgcn_fence(__ATOMIC_ACQUIRE, "agent");
            asm volatile("s_waitcnt vmcnt(0)" ::: "memory");
        }
    }
    __syncthreads();
}


#ifndef REP_MASK
#define REP_MASK 0
#endif
typedef unsigned short u16;
typedef __attribute__((ext_vector_type(8))) short bf16x8;
typedef __attribute__((ext_vector_type(4))) float f32x4;
typedef __attribute__((ext_vector_type(4))) unsigned u32x4;
#define MFMA(a, b, c) __builtin_amdgcn_mfma_f32_16x16x32_bf16(a, b, c, 0, 0, 0)

#define TT 32768
#define SS 4096
#define DD 1024
#define NIN 4888
#define C_SBQ 0
#define C_SBK 512
#define C_SBV 1024
#define C_NQ 1536
#define C_KC 2048
#define C_VC 2176
#define C_KS 2304
#define C_VS 2432
#define C_KW 2560
#define C_VW 2688
#define C_NG 2816
#define C_GSB 2840
#define C_GNSA 3864
#define DN_ALPHA 1.681792830507429f
#define NPH_LAYER 12
#define NPHASE (1 + 4 * NPH_LAYER)
#define KSTR 72
#define VSTR 136
#define SSTR 68

struct Params {
    const float *x, *p, *w_in, *w_cmp1, *w_cmp2, *pe_cmp, *w_br_sb, *w_br_nsa, *w_o, *ln1_g, *ln1_b, *ln2_g, *ln2_b,
        *w_router, *b_router, *w_gu, *b_gu, *w_down, *b_down, *w_ple_gate, *w_ple_proj;
    float* out;
    unsigned *bar, *ctr, *ecnt;
    u16 *wt_in, *wt_brs, *wt_brn, *wt_o, *wt_pg, *wt_pp, *wt_gu, *wt_dn, *wt_c1, *wt_c2, *wt_r;
    float *cbias, *hf, *pre1, *h1f, *logits, *ynf, *ent_w;
    u16 *hb, *pb, *yb, *ysb, *ynsa, *merged, *h1b, *h1lo, *ple, *hid, *kvc, *act, *y4;
    int* ent_id;
};

__device__ __forceinline__ u16 f2bf(float f) {
    unsigned u = __float_as_uint(f);
    u += 0x7fffu + ((u >> 16) & 1u);
    return (u16)(u >> 16);
}
__device__ __forceinline__ float bf2f(u16 h) { return __uint_as_float(((unsigned)h) << 16); }
__device__ __forceinline__ void st_bf4(u16* p, float a, float b, float c, float d) {
    uint2 u;
    u.x = (unsigned)f2bf(a) | ((unsigned)f2bf(b) << 16);
    u.y = (unsigned)f2bf(c) | ((unsigned)f2bf(d) << 16);
    *(uint2*)p = u;
}
__device__ __forceinline__ float sigmoidf_(float x) { return 1.f / (1.f + __expf(-x)); }

__shared__ __attribute__((aligned(16))) unsigned char g_smem[62464];
__shared__ int s_item;
__shared__ int s_misc[80];
__shared__ unsigned long long s_mask[4][16];
__shared__ unsigned long long s_union[4];

struct WorkQ {
    unsigned* ctr;
    int nxt;
    __device__ __forceinline__ void init(unsigned* c) {
        ctr = c;
        nxt = 0;
        if (threadIdx.x == 0) nxt = (int)atomicAdd(ctr, 1u);
    }
    __device__ __forceinline__ int next() {
        __syncthreads();
        if (threadIdx.x == 0) s_item = nxt;
        __syncthreads();
        int it = s_item;
        if (threadIdx.x == 0) nxt = (int)atomicAdd(ctr, 1u);
        return it;
    }
};


struct XQ {
    unsigned* ctr;
    int per, x0, k, nxt;
    __device__ __forceinline__ void init(unsigned* c, int per_) {
        ctr = c; per = per_; k = 0; nxt = 0;
        x0 = (int)(xb_xcc_id() & 7u);
        if (threadIdx.x == 0) nxt = (int)atomicAdd(&ctr[x0], 1u);
    }
    __device__ __forceinline__ int next() {
        __syncthreads();
        if (threadIdx.x == 0) {
            int v = nxt;
            while (v >= per && k < 8) {
                ++k;
                if (k < 8) v = (int)atomicAdd(&ctr[(x0 + k) & 7], 1u);
            }
            if (k < 8) {
                s_item = ((x0 + k) & 7) * per + v;
                nxt = (int)atomicAdd(&ctr[(x0 + k) & 7], 1u);
            } else s_item = -1;
        }
        __syncthreads();
        return s_item;
    }
};
__device__ __forceinline__ void xq_decode(int item, int mpx, int NT, int& mt, int& nt) {
    const int per = mpx * NT;
    const int q = item / per, idx = item - q * per;
    const int sm = idx / (8 * NT), rem = idx - sm * (8 * NT);
    nt = rem >> 3;
    mt = q * mpx + sm * 8 + (rem & 7);
}
struct Ctx {
    int tid__;
struct KId {
    __device__ __forceinline__ long operator()(int k) const { return k; }
};
template <class KOA>
__device__ __forceinline__ void gemm_main(f32x4 (&acc)[4][4], const u16* (&ap)[4], const u16* (&bp)[4], int K, KOA koa) {
    u16* sA = (u16*)g_smem;
    u16* sB = sA + 128 * KSTR;
    const int tid = tid__, lane = tid & 63, wave = tid >> 6;
    const int wn = wave & 1, wm = wave >> 1;
    const int kc = (tid & 7) * 8;
    const int lrow = tid >> 3;
    u32x4 ra[4], rb[4];
    {
        const long oa = koa(kc);
#pragma unroll
        for (int i = 0; i < 4; ++i) {
            ra[i] = *(const u32x4*)(ap[i] + oa);
            rb[i] = *(const u32x4*)(bp[i] + kc);
        }
    }
    for (int k0 = 0; k0 < K; k0 += 64) {
        __syncthreads();
#pragma unroll
        for (int i = 0; i < 4; ++i) {
            *(u32x4*)(sA + (lrow + 32 * i) * KSTR + kc) = ra[i];
            *(u32x4*)(sB + (lrow + 32 * i) * KSTR + kc) = rb[i];
        }
        __syncthreads();
        if (k0 + 64 < K) {
            const long oa = koa(k0 + 64 + kc);
#pragma unroll
            for (int i = 0; i < 4; ++i) {
                ra[i] = *(const u32x4*)(ap[i] + oa);
                rb[i] = *(const u32x4*)(bp[i] + (k0 + 64 + kc));
            }
        }
#pragma unroll
        for (int ks = 0; ks < 2; ++ks) {
            bf16x8 af[4], bfr[4];
#pragma unroll
            for (int j = 0; j < 4; ++j)
                af[j] = *(const bf16x8*)(sA + (wm * 64 + j * 16 + (lane & 15)) * KSTR + ks * 32 + (lane >> 4) * 8);
#pragma unroll
            for (int i = 0; i < 4; ++i)
                bfr[i] = *(const bf16x8*)(sB + (wn * 64 + i * 16 + (lane & 15)) * KSTR + ks * 32 + (lane >> 4) * 8);
#pragma unroll
            for (int i = 0; i < 4; ++i)
#pragma unroll
                for (int j = 0; j < 4; ++j) acc[i][j] = MFMA(bfr[i], af[j], acc[i][j]);
        }
    }
}
__device__ __forceinline__ void acc_zero(f32x4 (&acc)[4][4]) {
#pragma unroll
    for (int i = 0; i < 4; ++i)
#pragma unroll
        for (int j = 0; j < 4; ++j) acc[i][j] = f32x4{0.f, 0.f, 0.f, 0.f};
}
#define EPI_COORDS                                         \
    const int lane_ = tid__ & 63, wave_ = tid__ >> 6; \
    const int wn_ = wave_ & 1, wm_ = wave_ >> 1;
#define EPI_M(j) (wm_ * 64 + (j) * 16 + (lane_ & 15))
#define EPI_N(i) (wn_ * 64 + (i) * 16 + (lane_ >> 4) * 4)

__device__ __forceinline__ void xjob(const Params& p, int j, const float*& src, u16*& dst, int& nb, int& K, int& N) {
    switch (j) {
        case 0: src = p.w_in; dst = p.wt_in; nb = 4; K = 1024; N = NIN; break;
        case 1: src = p.w_br_sb; dst = p.wt_brs; nb = 4; K = 512; N = 1024; break;
        case 2: src = p.w_br_nsa; dst = p.wt_brn; nb = 4; K = 512; N = 1024; break;
        case 3: src = p.w_o; dst = p.wt_o; nb = 4; K = 1024; N = 1024; break;
        case 4: src = p.w_ple_gate; dst = p.wt_pg; nb = 4; K = 1024; N = 1024; break;
        case 5: src = p.w_ple_proj; dst = p.wt_pp; nb = 4; K = 256; N = 1024; break;
        case 6: src = p.w_gu; dst = p.wt_gu; nb = 128; K = 1024; N = 2048; break;
        case 7: src = p.w_down; dst = p.wt_dn; nb = 128; K = 1024; N = 1024; break;
        case 8: src = p.w_cmp1; dst = p.wt_c1; nb = 8; K = 2048; N = 128; break;
        default: src = p.w_cmp2; dst = p.wt_c2; nb = 8; K = 128; N = 64; break;
    }
}
__device__ __forceinline__ int xjob_tiles(int nb, int K, int N) { return nb * (K / 128) * ((N + 63) / 64); }

__device__ __forceinline__ void phase_prologue(const Params& p, unsigned* ctr) {
    const int tid = tid__;
    int ntr = 0;
    for (int j = 0; j < 10; ++j) {
        const float* s; u16* d; int nb, K, N;
        xjob(p, j, s, d, nb, K, N);
        ntr += xjob_tiles(nb, K, N);
    }
    const int n_x = TT * DD / 8192, n_p = 4 * TT * 256 / 8192, n_r = 16, n_b = 16;
    const int total = ntr + n_x + n_p + n_r + n_b;
    float* st = (float*)g_smem;
    WorkQ q; q.init(ctr);
    for (;;) {
        int it = q.next();
        if (it >= total) break;
        it = (it < n_b + n_r) ? (ntr + n_x + n_p + (it < n_b ? n_r + it : it - n_b)) : it - (n_b + n_r);
        if (it < ntr) {
            const float* src = nullptr; u16* dst = nullptr; int nb = 0, K = 0, N = 0;
            int rem = it;
            for (int j = 0; j < 10; ++j) {
                xjob(p, j, src, dst, nb, K, N);
                int nt = xjob_tiles(nb, K, N);
                if (rem < nt) break;
                rem -= nt;
            }
            const int ktn = K / 128, ntn = (N + 63) / 64;
            const int tpm = ktn * ntn;
            const int b = rem / tpm; rem -= b * tpm;
            const int kt = rem % ktn, nt = rem / ktn;
            src += (long)b * K * N; dst += (long)b * K * N;
            const int k0 = kt * 128, n0 = nt * 64;
            float4 v[8];
#pragma unroll
            for (int i = 0; i < 8; ++i) {
                int k = (tid >> 4) + 16 * i, n = (tid & 15) * 4;
                v[i] = make_float4(0.f, 0.f, 0.f, 0.f);
                if (n0 + n < N) v[i] = *(const float4*)(src + (long)(k0 + k) * N + n0 + n);
            }
#pragma unroll
            for (int i = 0; i < 8; ++i) {
                int k = (tid >> 4) + 16 * i, n = (tid & 15) * 4;
                st[k * 65 + n + 0] = v[i].x; st[k * 65 + n + 1] = v[i].y; st[k * 65 + n + 2] = v[i].z; st[k * 65 + n + 3] = v[i].w;
            }
            __syncthreads();
#pragma unroll
            for (int i = 0; i < 4; ++i) {
                int n = (tid >> 4) + 16 * i, k8 = (tid & 15) * 8;
                if (n0 + n < N) {
                    uint4 u;
                    u.x = (unsigned)f2bf(st[(k8 + 0) * 65 + n]) | ((unsigned)f2bf(st[(k8 + 1) * 65 + n]) << 16);
                    u.y = (unsigned)f2bf(st[(k8 + 2) * 65 + n]) | ((unsigned)f2bf(st[(k8 + 3) * 65 + n]) << 16);
                    u.z = (unsigned)f2bf(st[(k8 + 4) * 65 + n]) | ((unsigned)f2bf(st[(k8 + 5) * 65 + n]) << 16);
                    u.w = (unsigned)f2bf(st[(k8 + 6) * 65 + n]) | ((unsigned)f2bf(st[(k8 + 7) * 65 + n]) << 16);
                    *(uint4*)(dst + (long)(n0 + n) * K + k0 + k8) = u;
                }
            }
        } else if (it < ntr + n_x + n_p) {
            int e = it - ntr;
            const float* src; u16* db; float* df = nullptr;
            if (e < n_x) { src = p.x + (long)e * 8192; db = p.hb + (long)e * 8192; df = p.hf + (long)e * 8192; }
            else { e -= n_x; src = p.p + (long)e * 8192; db = p.pb + (long)e * 8192; }
#pragma unroll
            for (int i = 0; i < 8; ++i) {
                int o = i * 1024 + tid * 4;
                float4 v = *(const float4*)(src + o);
                if (df) *(float4*)(df + o) = v;
                st_bf4(db + o, v.x, v.y, v.z, v.w);
            }
        } else if (it < ntr + n_x + n_p + n_r) {
            int e0 = (it - ntr - n_x - n_p) * 8192;
            for (int i = 0; i < 32; ++i) {
                int idx = e0 + i * 256 + tid;
                int k = idx & 1023, le = idx >> 10, e = le & 31, l = le >> 5;
                float w = p.w_router[((long)l * 1024 + k) * 32 + e];
                u16 hi = f2bf(w); u16 lo = f2bf(w - bf2f(hi));
                u16* d = p.wt_r + (long)le * 3072;
                d[k] = hi; d[1024 + k] = lo; d[2048 + k] = hi;
            }
        } else {
            const int bi = it - ntr - n_x - n_p - n_r;
            const int lk = bi >> 1, h = (bi & 1) * 64 + (tid & 63), jp = tid >> 6;
            const float* pe = p.pe_cmp + (long)lk * 2048 + jp * 512;
            const float* w1 = p.w_cmp1 + ((long)lk * 2048 + jp * 512) * 128 + h;
            float sacc = 0.f;
#pragma unroll 8
            for (int j = 0; j < 512; ++j) sacc += pe[j] * w1[(long)j * 128];
            st[tid] = sacc;
            __syncthreads();
            if (tid < 64) p.cbias[lk * 128 + h] = (st[tid] + st[tid + 64]) + (st[tid + 128] + st[tid + 192]);
        }
    }
}

__device__ __forceinline__ void phase_gemm_in(const Params& p, int l, unsigned* ctr) {
    const int NTN = (NIN + 127) / 128;
    const int tid = tid__;
    const u16* W = p.wt_in + (long)l * NIN * 1024;
    XQ q; q.init(ctr, 32 * NTN);
    for (;;) {
        int it = q.next();
        if (it < 0) break;
        int mt, nt; xq_decode(it, 32, NTN, mt, nt);
        const int m0 = mt * 128, n0 = nt * 128;
        const u16* ap[4]; const u16* bp[4];
#pragma unroll
        for (int i = 0; i < 4; ++i) {
            int r = (tid >> 3) + 32 * i;
            ap[i] = p.hb + (long)(m0 + r) * 1024;
            int n = n0 + r; if (n > NIN - 1) n = NIN - 1;
            bp[i] = W + (long)n * 1024;
        }
        f32x4 acc[4][4]; acc_zero(acc);
        gemm_main(acc, ap, bp, 1024, KId());
        EPI_COORDS
#pragma unroll
        for (int i = 0; i < 4; ++i)
#pragma unroll
            for (int j = 0; j < 4; ++j) {
                int m = m0 + EPI_M(j), n = n0 + EPI_N(i);
                if (n < NIN) st_bf4(p.yb + (long)m * NIN + n, acc[i][j][0], acc[i][j][1], acc[i][j][2], acc[i][j][3]);
            }
    }
}

struct KCmp {
    __device__ __forceinline__ long operator()(int k) const { return (long)(k >> 6) * NIN + (k & 63); }
};
__device__ __forceinline__ void tile_cmp1(const Params& p, int l, int it) {
    const int tid = tid__;
    const int kv = it >> 4, mt = it & 15;
    const u16* W = p.wt_c1 + (long)(l * 2 + kv) * 128 * 2048;
    const u16* ap[4]; const u16* bp[4];
#pragma unroll
    for (int i = 0; i < 4; ++i) {
        int r = (tid >> 3) + 32 * i;
        int mrow = mt * 128 + r;
        int c = mrow & 127, bg = mrow >> 7, g = bg & 1, b = bg >> 1;
        ap[i] = p.yb + (long)(b * SS + c * 32) * NIN + (kv ? C_VC : C_KC) + g * 64;
        bp[i] = W + (long)r * 2048;
    }
    f32x4 acc[4][4]; acc_zero(acc);
    gemm_main(acc, ap, bp, 2048, KCmp());
    EPI_COORDS
    const float* cb = p.cbias + (l * 2 + kv) * 128;
#pragma unroll
    for (int i = 0; i < 4; ++i)
#pragma unroll
        for (int j = 0; j < 4; ++j) {
            int m = mt * 128 + EPI_M(j), n = EPI_N(i);
            float v[4];
#pragma unroll
            for (int r = 0; r < 4; ++r) { float a = acc[i][j][r] + cb[n + r]; v[r] = a * sigmoidf_(a); }
            st_bf4(p.hid + ((long)kv * 2048 + m) * 128 + n, v[0], v[1], v[2], v[3]);
        }
}
__device__ __forceinline__ void phase_cmp2(const Params& p, int l, unsigned* ctr) {
    const int tid = tid__;
    WorkQ q; q.init(ctr);
    for (;;) {
        int it = q.next();
        if (it >= 32) break;
        const int kv = it >> 4, mt = it & 15;
        const u16* W = p.wt_c2 + (long)(l * 2 + kv) * 64 * 128;
        const u16* ap[4]; const u16* bp[4];
#pragma unroll
        for (int i = 0; i < 4; ++i) {
            int r = (tid >> 3) + 32 * i;
            ap[i] = p.hid + ((long)kv * 2048 + mt * 128 + r) * 128;
            bp[i] = W + (long)(r & 63) * 128;
        }
        f32x4 acc[4][4]; acc_zero(acc);
        gemm_main(acc, ap, bp, 128, KId());
        EPI_COORDS
#pragma unroll
        for (int i = 0; i < 4; ++i)
#pragma unroll
            for (int j = 0; j < 4; ++j) {
                int m = mt * 128 + EPI_M(j), n = EPI_N(i);
                if (n < 64) st_bf4(p.kvc + ((long)kv * 2048 + m) * 64 + n, acc[i][j][0], acc[i][j][1], acc[i][j][2], acc[i][j][3]);
            }
    }
}

struct AttnLds {
    u16* K;
    u16* Vt;
    float* S;
    u16* P;
};
__device__ __forceinline__ AttnLds attn_lds() {
    AttnLds a;
    a.K = (u16*)g_smem;
    a.Vt = (u16*)(g_smem + 18432);
    a.S = (float*)(g_smem + 18432 + 17408) + (tid__ >> 6) * 16 * SSTR;
    a.P = (u16*)(g_smem + 18432 + 17408 + 17408) + (tid__ >> 6) * 16 * KSTR;
    return a;
}
__device__ __forceinline__ void load_k_tile(u16* sK, int koff, const u16* base, long stride) {
    const int tid = tid__, key = tid >> 2, ch = (tid & 3) * 16;
    const u16* g = base + (long)key * stride + ch;
    uint4 a = *(const uint4*)g, b = *(const uint4*)(g + 8);
    *(uint4*)(sK + (koff + key) * KSTR + ch) = a;
    *(uint4*)(sK + (koff + key) * KSTR + ch + 8) = b;
}
__device__ __forceinline__ void load_v_tile(u16* sVt, int koff, const u16* base, long stride) {
    const int tid = tid__, key = tid & 63, d0 = (tid >> 6) * 16;
    const u16* g = base + (long)key * stride + d0;
    uint4 a = *(const uint4*)g, b = *(const uint4*)(g + 8);
    unsigned w[8] = {a.x, a.y, a.z, a.w, b.x, b.y, b.z, b.w};
#pragma unroll
    for (int i = 0; i < 8; ++i) {
        sVt[(d0 + 2 * i) * VSTR + koff + key] = (u16)(w[i] & 0xffffu);
        sVt[(d0 + 2 * i + 1) * VSTR + koff + key] = (u16)(w[i] >> 16);
    }
}
__device__ __forceinline__ void wave_qk(const AttnLds& L, int koff, const bf16x8 (&qf)[2]) {
    const int lane = tid__ & 63, quad = lane >> 4, c = lane & 15;
#pragma unroll
    for (int nt = 0; nt < 4; ++nt) {
        f32x4 a = {0.f, 0.f, 0.f, 0.f};
#pragma unroll
        for (int ks = 0; ks < 2; ++ks) {
            bf16x8 kf = *(const bf16x8*)(L.K + (koff + nt * 16 + c) * KSTR + ks * 32 + quad * 8);
            a = MFMA(qf[ks], kf, a);
        }
#pragma unroll
        for (int r = 0; r < 4; ++r) L.S[(quad * 4 + r) * SSTR + nt * 16 + c] = a[r];
    }
}
__device__ __forceinline__ void wave_pv(const AttnLds& L, int koff, f32x4 (&o)[4]) {
    const int lane = tid__ & 63, quad = lane >> 4, c = lane & 15;
#pragma unroll
    for (int ks = 0; ks < 2; ++ks) {
        bf16x8 pf = *(const bf16x8*)(L.P + c * KSTR + ks * 32 + quad * 8);
#pragma unroll
        for (int dt = 0; dt < 4; ++dt) {
            bf16x8 vf = *(const bf16x8*)(L.Vt + (dt * 16 + c) * VSTR + koff + ks * 32 + quad * 8);
            o[dt] = MFMA(pf, vf, o[dt]);
        }
    }
}
__device__ __forceinline__ void read_s16(const AttnLds& L, int row, int part, float (&z)[16]) {
#pragma unroll
    for (int i = 0; i < 4; ++i) {
        float4 v = *(const float4*)(L.S + row * SSTR + part * 16 + i * 4);
        z[i * 4 + 0] = v.x; z[i * 4 + 1] = v.y; z[i * 4 + 2] = v.z; z[i * 4 + 3] = v.w;
    }
}
__device__ __forceinline__ void write_p16(const AttnLds& L, int row, int part, const float (&pv)[16]) {
    uint4 a, b;
    a.x = (unsigned)f2bf(pv[0]) | ((unsigned)f2bf(pv[1]) << 16);
    a.y = (unsigned)f2bf(pv[2]) | ((unsigned)f2bf(pv[3]) << 16);
    a.z = (unsigned)f2bf(pv[4]) | ((unsigned)f2bf(pv[5]) << 16);
    a.w = (unsigned)f2bf(pv[6]) | ((unsigned)f2bf(pv[7]) << 16);
    b.x = (unsigned)f2bf(pv[8]) | ((unsigned)f2bf(pv[9]) << 16);
    b.y = (unsigned)f2bf(pv[10]) | ((unsigned)f2bf(pv[11]) << 16);
    b.z = (unsigned)f2bf(pv[12]) | ((unsigned)f2bf(pv[13]) << 16);
    b.w = (unsigned)f2bf(pv[14]) | ((unsigned)f2bf(pv[15]) << 16);
    *(uint4*)(L.P + row * KSTR + part * 16) = a;
    *(uint4*)(L.P + row * KSTR + part * 16 + 8) = b;
}
__device__ __forceinline__ float row4_max(float v) {
    v = fmaxf(v, __shfl_xor(v, 1));
    v = fmaxf(v, __shfl_xor(v, 2));
    return v;
}
__device__ __forceinline__ float row4_sum(float v) {
    v += __shfl_xor(v, 1);
    v += __shfl_xor(v, 2);
    return v;
}

__device__ __forceinline__ void item_sb(const Params& p, int it) {
    const int tid = tid__, lane = tid & 63, wave = tid >> 6, quad = lane >> 4, c = lane & 15;
    const int qb = it & 63, h = (it >> 6) & 7, b = it >> 9;
    const int t0 = qb * 64;
    AttnLds L = attn_lds();
    bf16x8 qf[2];
    {
        const u16* g = p.yb + (long)(b * SS + t0 + wave * 16 + c) * NIN + C_SBQ + h * 64 + quad * 8;
        qf[0] = *(const bf16x8*)g;
        qf[1] = *(const bf16x8*)(g + 32);
    }
    const int row = lane >> 2, part = lane & 3;
    const int t = t0 + wave * 16 + row;
    float R = 0.f;
    f32x4 o[4];
#pragma unroll
    for (int dt = 0; dt < 4; ++dt) o[dt] = f32x4{0.f, 0.f, 0.f, 0.f};
    for (int kb = qb; kb >= 0; --kb) {
        __syncthreads();
        const u16* kbase = p.yb + (long)(b * SS + kb * 64) * NIN + h * 64;
        load_k_tile(L.K, 0, kbase + C_SBK, NIN);
        load_v_tile(L.Vt, 0, kbase + C_SBV, NIN);
        __syncthreads();
        wave_qk(L, 0, qf);
        __syncthreads();
        float z[16], lat[16];
        read_s16(L, row, part, z);
        float run = 0.f;
#pragma unroll
        for (int i = 15; i >= 0; --i) {
            const int key = kb * 64 + part * 16 + i;
            const bool valid = key < t;
            const float zz = z[i] * 0.125f;
            const float sp = fmaxf(zz, 0.f) + __logf(1.f + __expf(-fabsf(zz)));
            lat[i] = run;
            z[i] = valid ? (zz - sp) : -1e30f;
            run += valid ? -sp : 0.f;
        }
        const int lb = lane & ~3;
        const float t0_ = __shfl(run, lb), t1_ = __shfl(run, lb + 1), t2_ = __shfl(run, lb + 2), t3_ = __shfl(run, lb + 3);
        float off = R;
        if (part < 3) off += t3_;
        if (part < 2) off += t2_;
        if (part < 1) off += t1_;
        float pv[16];
#pragma unroll
        for (int i = 0; i < 16; ++i) pv[i] = (z[i] > -1e29f) ? __expf(z[i] + lat[i] + off) : 0.f;
        write_p16(L, row, part, pv);
        R += (t0_ + t1_) + (t2_ + t3_);
        const int done = __syncthreads_and(R < -110.f);
        wave_pv(L, 0, o);
        if (done) break;
    }
#pragma unroll
    for (int dt = 0; dt < 4; ++dt)
#pragma unroll
        for (int r = 0; r < 4; ++r)
            p.ysb[(long)(b * SS + t0 + wave * 16 + quad * 4 + r) * 512 + h * 64 + dt * 16 + c] = f2bf(o[dt][r]);
}

__device__ __forceinline__ void phase_cmp1_sb(const Params& p, int l, unsigned* ctr) {
    const int total = 32 + 8 * 8 * 64;
    WorkQ q; q.init(ctr);
    for (;;) {
        int it = q.next();
        if (it >= total) break;
        if (it < 32) tile_cmp1(p, l, it);
        else item_sb(p, it - 32);
    }
}

template <int MODE>
__device__ __forceinline__ void nsa_step(const AttnLds& L, const bf16x8 (&qf)[2], f32x4 (&o)[4], float& m, float& l,
                                         float slope, int t, int kpos0, bool rowsel) {
    const int lane = tid__ & 63, quad = lane >> 4;
    const int row = lane >> 2, part = lane & 3;
    wave_qk(L, 0, qf);
    __syncthreads();
    float z[16];
    read_s16(L, row, part, z);
    float pm = -1e30f;
#pragma unroll
    for (int i = 0; i < 16; ++i) {
        const int dist = t - (kpos0 + part * 16 + i);
        bool valid = dist >= 0;
        if (MODE == 1) valid = valid && rowsel;
        if (MODE == 2) valid = valid && (dist < 512);
        z[i] = valid ? (z[i] * 0.125f - slope * (float)dist) : -1e30f;
        pm = fmaxf(pm, z[i]);
    }
    pm = row4_max(pm);
    const float mn = fmaxf(m, pm);
    const float alpha = __expf(m - mn);
    float ps = 0.f;
#pragma unroll
    for (int i = 0; i < 16; ++i) {
        z[i] = (z[i] > -1e29f) ? __expf(z[i] - mn) : 0.f;
        ps += z[i];
    }
    ps = row4_sum(ps);
    l = l * alpha + ps;
    m = mn;
    write_p16(L, row, part, z);
    float al[4];
#pragma unroll
    for (int r = 0; r < 4; ++r) al[r] = __shfl(alpha, (quad * 4 + r) * 4);
    __syncthreads();
#pragma unroll
    for (int dt = 0; dt < 4; ++dt)
#pragma unroll
        for (int r = 0; r < 4; ++r) o[dt][r] *= al[r];
    wave_pv(L, 0, o);
    __syncthreads();
}

__device__ __forceinline__ void item_nsa(const Params& p, int it) {
    const int tid = tid__, lane = tid & 63, wave = tid >> 6, quad = lane >> 4, c = lane & 15;
    const int qb = 63 - (it >> 4), bg = it & 15, g = bg & 1, b = bg >> 1;
    const int t0 = qb * 64;
    AttnLds L = attn_lds();
    const int row = lane >> 2, part = lane & 3;
    const int t = t0 + wave * 16 + row;
    const long tokbase = (long)b * SS + t0 + wave * 16;
    float* ynf = p.ynf;
    const int nct = (2 * qb + 2 > 64) ? 2 : 1;
    const int nv = (t + 1) >> 5;
    __syncthreads();
    for (int ct = 0; ct < nct; ++ct) {
        load_k_tile(L.K, ct * 64, p.kvc + ((long)(b * 2 + g) * 128 + ct * 64) * 64, 64);
        load_v_tile(L.Vt, ct * 64, p.kvc + ((long)2048 + (b * 2 + g) * 128 + ct * 64) * 64, 64);
    }
    __syncthreads();
    float imp[2][8];
#pragma unroll
    for (int a = 0; a < 2; ++a)
#pragma unroll
        for (int j = 0; j < 8; ++j) imp[a][j] = 0.f;
#pragma unroll 1
    for (int r = 0; r < 4; ++r) {
        const float slope = exp2f(-(float)(g * 4 + r + 1));
        float m = -1e30f, l = 0.f;
        bf16x8 qfa[2];
        {
            const u16* gq = p.yb + (tokbase + c) * NIN + C_NQ + (g * 4 + r) * 64 + quad * 8;
            qfa[0] = *(const bf16x8*)gq;
            qfa[1] = *(const bf16x8*)(gq + 32);
        }
        for (int ct = 0; ct < nct; ++ct) {
            wave_qk(L, ct * 64, qfa);
            __syncthreads();
            float z[16];
            read_s16(L, row, part, z);
            float pm = -1e30f;
#pragma unroll
            for (int i = 0; i < 16; ++i) {
                const int cc = ct * 64 + part * 16 + i;
                const bool valid = cc < nv;
                z[i] = valid ? (z[i] * 0.125f - slope * (float)(t - (cc * 32 + 31))) : -1e30f;
                pm = fmaxf(pm, z[i]);
            }
            pm = row4_max(pm);
            const float mn = fmaxf(m, pm);
            float ps = 0.f;
#pragma unroll
            for (int i = 0; i < 16; ++i) ps += (z[i] > -1e29f) ? __expf(z[i] - mn) : 0.f;
            ps = row4_sum(ps);
            l = l * __expf(m - mn) + ps;
            m = mn;
            __syncthreads();
        }
        const float inv = (l > 0.f) ? 1.f / l : 0.f;
        f32x4 o[4];
#pragma unroll
        for (int dt = 0; dt < 4; ++dt) o[dt] = f32x4{0.f, 0.f, 0.f, 0.f};
#pragma unroll 1
        for (int ct = 0; ct < nct; ++ct) {
            wave_qk(L, ct * 64, qfa);
            __syncthreads();
            float z[16];
            read_s16(L, row, part, z);
#pragma unroll
            for (int i = 0; i < 16; ++i) {
                const int cc = ct * 64 + part * 16 + i;
                const bool valid = cc < nv;
                const float s = z[i] * 0.125f - slope * (float)(t - (cc * 32 + 31));
                z[i] = valid ? __expf(s - m) * inv : 0.f;
            }
            const float f0 = (ct == 0) ? 1.f : 0.f, f1 = 1.f - f0;
#pragma unroll
            for (int j = 0; j < 8; ++j) {
                const float pr = z[2 * j] + z[2 * j + 1];
                imp[0][j] += f0 * pr;
                imp[1][j] += f1 * pr;
            }
            write_p16(L, row, part, z);
            __syncthreads();
            wave_pv(L, ct * 64, o);
            __syncthreads();
        }
#pragma unroll
        for (int rr = 0; rr < 4; ++rr) {
            const long tok = tokbase + quad * 4 + rr;
            const float gt = sigmoidf_(bf2f(p.yb[tok * NIN + C_NG + (g * 4 + r) * 3 + 0]));
#pragma unroll
            for (int dt = 0; dt < 4; ++dt) ynf[tok * 512 + (g * 4 + r) * 64 + dt * 16 + c] = gt * o[dt][rr];
        }
    }
#pragma unroll
    for (int a = 0; a < 2; ++a)
#pragma unroll
        for (int j = 0; j < 8; ++j) L.S[row * SSTR + a * 32 + part * 8 + j] = imp[a][j];
    __syncthreads();
    unsigned long long un = 0ull;
#ifndef NSA_NOTOPK
#define NSA_NOTOPK 0
#endif
#pragma unroll 1
    for (int rr = 0; rr < (NSA_NOTOPK ? 0 : 16); ++rr) {
        float v = L.S[rr * SSTR + lane];
        const bool forced = (lane == 0) || (lane == qb) || (lane == qb - 1);
        const bool validb = lane <= qb;
        v = forced ? 1e6f : (validb ? v : -1e30f);
        int rank = 0;
#pragma unroll 8
        for (int i = 0; i < 64; ++i) {
            const float vi = __shfl(v, i);
            rank += ((vi > v) || (vi == v && i < lane)) ? 1 : 0;
        }
        const unsigned long long mk = __ballot((rank < 16) && validb);
        if (lane == 0) s_mask[wave][rr] = mk;
        un |= mk;
    }
    if (lane == 0) s_union[wave] = un;
    __syncthreads();
    const unsigned long long rowmask = s_mask[wave][row];
    unsigned long long umask;
    {
        const unsigned long long um_ = s_union[0] | s_union[1] | s_union[2] | s_union[3];
        const unsigned lo_ = __builtin_amdgcn_readfirstlane((unsigned)um_), hi_ = __builtin_amdgcn_readfirstlane((unsigned)(um_ >> 32));
        umask = ((unsigned long long)hi_ << 32) | lo_;
    }
#ifndef NSA_HPB
#define NSA_HPB 1
#endif
#ifndef NSA_NOBC
#define NSA_NOBC 0
#endif
#pragma unroll 1
    for (int hp = 0; hp < (NSA_NOBC ? 0 : 4 / NSA_HPB); ++hp) {
#pragma unroll 1
        for (int mode = 1; mode <= 2; ++mode) {
            f32x4 o[NSA_HPB][4];
            float m[NSA_HPB], l[NSA_HPB];
#pragma unroll
            for (int r = 0; r < NSA_HPB; ++r) {
                m[r] = -1e30f; l[r] = 0.f;
#pragma unroll
                for (int dt = 0; dt < 4; ++dt) o[r][dt] = f32x4{0.f, 0.f, 0.f, 0.f};
            }
            const int kb_lo = (mode == 1) ? 0 : ((qb - 8 > 0) ? qb - 8 : 0);
            const int colk = (mode == 1) ? C_KS : C_KW, colv = (mode == 1) ? C_VS : C_VW;
            for (int kb = kb_lo; kb <= qb; ++kb) {
                if (mode == 1 && !((umask >> kb) & 1ull)) continue;
                const u16* kbase = p.yb + (long)(b * SS + kb * 64) * NIN + g * 64;
                bf16x8 qf[NSA_HPB][2];
#pragma unroll
                for (int r = 0; r < NSA_HPB; ++r) {
                    const u16* gq = p.yb + (tokbase + c) * NIN + C_NQ + (g * 4 + hp * NSA_HPB + r) * 64 + quad * 8;
                    qf[r][0] = *(const bf16x8*)gq;
                    qf[r][1] = *(const bf16x8*)(gq + 32);
                }
                load_k_tile(L.K, 0, kbase + colk, NIN);
                load_v_tile(L.Vt, 0, kbase + colv, NIN);
                __syncthreads();
                const bool rowsel = (rowmask >> kb) & 1ull;
#pragma unroll
                for (int r = 0; r < NSA_HPB; ++r) {
                    const float slope = exp2f(-(float)(g * 4 + hp * NSA_HPB + r + 1));
                    if (mode == 1) nsa_step<1>(L, qf[r], o[r], m[r], l[r], slope, t, kb * 64, rowsel);
                    else nsa_step<2>(L, qf[r], o[r], m[r], l[r], slope, t, kb * 64, rowsel);
                }
            }
#pragma unroll
            for (int r = 0; r < NSA_HPB; ++r) {
                const int hh = g * 4 + hp * NSA_HPB + r;
#pragma unroll
                for (int rr = 0; rr < 4; ++rr) {
                    const long tok = tokbase + quad * 4 + rr;
                    const float lr = __shfl(l[r], (quad * 4 + rr) * 4);
                    const float gt = sigmoidf_(bf2f(p.yb[tok * NIN + C_NG + hh * 3 + mode])) / lr;
#pragma unroll
                    for (int dt = 0; dt < 4; ++dt) {
                        const long oi = tok * 512 + hh * 64 + dt * 16 + c;
                        const float v = ynf[oi] + gt * o[r][dt][rr];
                        if (mode == 1) ynf[oi] = v;
                        else p.ynsa[oi] = f2bf(v);
                    }
                }
            }
        }
    }
}
__device__ __forceinline__ void phase_nsa(const Params& p, unsigned* ctr) {
    WorkQ q; q.init(ctr);
    for (;;) {
        int it = q.next();
        if (it >= 1024) break;
        item_nsa(p, it);
    }
}

__device__ __forceinline__ void phase_br(const Params& p, int l, unsigned* ctr) {
    const int tid = tid__;
    XQ q; q.init(ctr, 32 * 8);
    for (;;) {
        int it = q.next();
        if (it < 0) break;
        int mt, nt; xq_decode(it, 32, 8, mt, nt);
        const int m0 = mt * 128, n0 = nt * 128;
        const u16* ap[4]; const u16* bp[4];
        f32x4 acc[4][4];
        acc_zero(acc);
#pragma unroll
        for (int i = 0; i < 4; ++i) {
            int r = (tid >> 3) + 32 * i;
            ap[i] = p.ysb + (long)(m0 + r) * 512;
            bp[i] = p.wt_brs + ((long)l * 1024 + n0 + r) * 512;
        }
        gemm_main(acc, ap, bp, 512, KId());
        EPI_COORDS
#pragma unroll
        for (int i = 0; i < 4; ++i)
#pragma unroll
            for (int j = 0; j < 4; ++j) {
                const int m = m0 + EPI_M(j), n = n0 + EPI_N(i);
                const uint2 ga = *(const uint2*)(p.yb + (long)m * NIN + C_GSB + n);
                float4 o;
                o.x = sigmoidf_(bf2f((u16)(ga.x & 0xffff))) * acc[i][j][0];
                o.y = sigmoidf_(bf2f((u16)(ga.x >> 16))) * acc[i][j][1];
                o.z = sigmoidf_(bf2f((u16)(ga.y & 0xffff))) * acc[i][j][2];
                o.w = sigmoidf_(bf2f((u16)(ga.y >> 16))) * acc[i][j][3];
                *(float4*)(p.pre1 + (long)m * 1024 + n) = o;
            }
        acc_zero(acc);
#pragma unroll
        for (int i = 0; i < 4; ++i) {
            int r = (tid >> 3) + 32 * i;
            ap[i] = p.ynsa + (long)(m0 + r) * 512;
            bp[i] = p.wt_brn + ((long)l * 1024 + n0 + r) * 512;
        }
        gemm_main(acc, ap, bp, 512, KId());
#pragma unroll
        for (int i = 0; i < 4; ++i)
#pragma unroll
            for (int j = 0; j < 4; ++j) {
                const int m = m0 + EPI_M(j), n = n0 + EPI_N(i);
                const uint2 gb = *(const uint2*)(p.yb + (long)m * NIN + C_GNSA + n);
                const float4 st = *(const float4*)(p.pre1 + (long)m * 1024 + n);
                st_bf4(p.merged + (long)m * 1024 + n,
                       st.x + sigmoidf_(bf2f((u16)(gb.x & 0xffff))) * acc[i][j][0],
                       st.y + sigmoidf_(bf2f((u16)(gb.x >> 16))) * acc[i][j][1],
                       st.z + sigmoidf_(bf2f((u16)(gb.y & 0xffff))) * acc[i][j][2],
                       st.w + sigmoidf_(bf2f((u16)(gb.y >> 16))) * acc[i][j][3]);
            }
    }
}
__device__ __forceinline__ void phase_wo(const Params& p, int l, unsigned* ctr) {
    const int tid = tid__;
    XQ q; q.init(ctr, 32 * 8);
    for (;;) {
        int it = q.next();
        if (it < 0) break;
        int mt, nt; xq_decode(it, 32, 8, mt, nt);
        const int m0 = mt * 128, n0 = nt * 128;
        const u16* ap[4]; const u16* bp[4];
        f32x4 acc[4][4]; acc_zero(acc);
#pragma unroll
        for (int i = 0; i < 4; ++i) {
            int r = (tid >> 3) + 32 * i;
            ap[i] = p.merged + (long)(m0 + r) * 1024;
            bp[i] = p.wt_o + ((long)l * 1024 + n0 + r) * 1024;
        }
        gemm_main(acc, ap, bp, 1024, KId());
        EPI_COORDS
#pragma unroll
        for (int i = 0; i < 4; ++i)
#pragma unroll
            for (int j = 0; j < 4; ++j) {
                const int m = m0 + EPI_M(j), n = n0 + EPI_N(i);
                const float4 hv = *(const float4*)(p.hf + (long)m * 1024 + n);
                float4 o;
                o.x = DN_ALPHA * hv.x + acc[i][j][0]; o.y = DN_ALPHA * hv.y + acc[i][j][1];
                o.z = DN_ALPHA * hv.z + acc[i][j][2]; o.w = DN_ALPHA * hv.w + acc[i][j][3];
                *(float4*)(p.pre1 + (long)m * 1024 + n) = o;
            }
    }
}
__device__ __forceinline__ float wave_sum(float v) {
#pragma unroll
    for (int s = 32; s >= 1; s >>= 1) v += __shfl_xor(v, s);
    return v;
}
__device__ __forceinline__ void phase_ln(const Params& p, int l, int mode, unsigned* ctr) {
    const int lane = tid__ & 63, wave = tid__ >> 6;
    const float* gam = (mode == 1 ? p.ln1_g : p.ln2_g) + l * 1024;
    const float* bet = (mode == 1 ? p.ln1_b : p.ln2_b) + l * 1024;
    WorkQ q; q.init(ctr);
    for (;;) {
        int it = q.next();
        if (it >= TT / 64) break;
        for (int rr = 0; rr < 16; ++rr) {
            const long row = (long)it * 64 + wave * 16 + rr;
            float v[16];
#pragma unroll
            for (int i = 0; i < 4; ++i) {
                const int col = i * 256 + lane * 4;
                float4 a;
                if (mode == 1) a = *(const float4*)(p.pre1 + row * 1024 + col);
                else {
                    a = *(const float4*)(p.h1f + row * 1024 + col);
                    a.x *= DN_ALPHA; a.y *= DN_ALPHA; a.z *= DN_ALPHA; a.w *= DN_ALPHA;
                    const uint2 pl = *(const uint2*)(p.ple + row * 1024 + col);
                    a.x += bf2f((u16)(pl.x & 0xffff)); a.y += bf2f((u16)(pl.x >> 16));
                    a.z += bf2f((u16)(pl.y & 0xffff)); a.w += bf2f((u16)(pl.y >> 16));
#pragma unroll
                    for (int s = 0; s < 4; ++s) {
                        const uint2 y = *(const uint2*)(p.y4 + (row * 4 + s) * 1024 + col);
                        a.x += bf2f((u16)(y.x & 0xffff)); a.y += bf2f((u16)(y.x >> 16));
                        a.z += bf2f((u16)(y.y & 0xffff)); a.w += bf2f((u16)(y.y >> 16));
                    }
                }
                v[i * 4 + 0] = a.x; v[i * 4 + 1] = a.y; v[i * 4 + 2] = a.z; v[i * 4 + 3] = a.w;
            }
            float s = 0.f;
#pragma unroll
            for (int i = 0; i < 16; ++i) s += v[i];
            const float mean = wave_sum(s) * (1.f / 1024.f);
            float s2 = 0.f;
#pragma unroll
            for (int i = 0; i < 16; ++i) { v[i] -= mean; s2 += v[i] * v[i]; }
            const float rstd = rsqrtf(wave_sum(s2) * (1.f / 1024.f) + 1e-5f);
#pragma unroll
            for (int i = 0; i < 4; ++i) {
                const int col = i * 256 + lane * 4;
                const float4 gg = *(const float4*)(gam + col), bb = *(const float4*)(bet + col);
                float4 y;
                y.x = v[i * 4 + 0] * rstd * gg.x + bb.x; y.y = v[i * 4 + 1] * rstd * gg.y + bb.y;
                y.z = v[i * 4 + 2] * rstd * gg.z + bb.z; y.w = v[i * 4 + 3] * rstd * gg.w + bb.w;
                if (mode == 1) {
                    *(float4*)(p.h1f + row * 1024 + col) = y;
                    const u16 h0 = f2bf(y.x), h1 = f2bf(y.y), h2 = f2bf(y.z), h3 = f2bf(y.w);
                    uint2 u; u.x = (unsigned)h0 | ((unsigned)h1 << 16); u.y = (unsigned)h2 | ((unsigned)h3 << 16);
                    *(uint2*)(p.h1b + row * 1024 + col) = u;
                    st_bf4(p.h1lo + row * 1024 + col, y.x - bf2f(h0), y.y - bf2f(h1), y.z - bf2f(h2), y.w - bf2f(h3));
                } else {
                    if (l == 3) *(float4*)(p.out + row * 1024 + col) = y;
                    else {
                        *(float4*)(p.hf + row * 1024 + col) = y;
                        st_bf4(p.hb + row * 1024 + col, y.x, y.y, y.z, y.w);
                    }
                }
            }
        }
    }
}
struct KRouter {
    long dlo;
    __device__ __forceinline__ long operator()(int k) const { return (k < 2048) ? (long)(k & 1023) : (dlo + (k - 2048)); }
};
__device__ __forceinline__ void phase_router_ple(const Params& p, int l, unsigned* ctr) {
    const int tid = tid__;
    XQ q; q.init(ctr, 32 * 9);
    for (;;) {
        int it = q.next();
        if (it < 0) break;
        int mt, nt; xq_decode(it, 32, 9, mt, nt);
        const u16* ap[4]; const u16* bp[4];
        if (nt == 8) {
            const int m0 = mt * 128;
            f32x4 acc[4][4]; acc_zero(acc);
#pragma unroll
            for (int i = 0; i < 4; ++i) {
                int r = (tid >> 3) + 32 * i;
                ap[i] = p.h1b + (long)(m0 + r) * 1024;
                bp[i] = p.wt_r + ((long)l * 32 + (r & 31)) * 3072;
            }
            KRouter kr; kr.dlo = (long)(p.h1lo - p.h1b);
            gemm_main(acc, ap, bp, 3072, kr);
            EPI_COORDS
#pragma unroll
            for (int i = 0; i < 4; ++i)
#pragma unroll
                for (int j = 0; j < 4; ++j) {
                    const int m = m0 + EPI_M(j), n = EPI_N(i);
                    if (n < 32) {
                        const float4 bb = *(const float4*)(p.b_router + l * 32 + n);
                        float4 o; o.x = acc[i][j][0] + bb.x; o.y = acc[i][j][1] + bb.y; o.z = acc[i][j][2] + bb.z; o.w = acc[i][j][3] + bb.w;
                        *(float4*)(p.logits + (long)m * 32 + n) = o;
                    }
                }
        } else {
            const int m0 = mt * 128, n0 = nt * 128;
            f32x4 acc[4][4];
            acc_zero(acc);
#pragma unroll
            for (int i = 0; i < 4; ++i) {
                int r = (tid >> 3) + 32 * i;
                ap[i] = p.pb + ((long)l * TT + m0 + r) * 256;
                bp[i] = p.wt_pp + ((long)l * 1024 + n0 + r) * 256;
            }
            gemm_main(acc, ap, bp, 256, KId());
            EPI_COORDS
#pragma unroll
            for (int i = 0; i < 4; ++i)
#pragma unroll
                for (int j = 0; j < 4; ++j) {
                    const int m = m0 + EPI_M(j), n = n0 + EPI_N(i);
                    float4 o; o.x = acc[i][j][0]; o.y = acc[i][j][1]; o.z = acc[i][j][2]; o.w = acc[i][j][3];
                    *(float4*)(p.pre1 + (long)m * 1024 + n) = o;
                }
            acc_zero(acc);
#pragma unroll
            for (int i = 0; i < 4; ++i) {
                int r = (tid >> 3) + 32 * i;
                ap[i] = p.h1b + (long)(m0 + r) * 1024;
                bp[i] = p.wt_pg + ((long)l * 1024 + n0 + r) * 1024;
            }
            gemm_main(acc, ap, bp, 1024, KId());
#pragma unroll
            for (int i = 0; i < 4; ++i)
#pragma unroll
                for (int j = 0; j < 4; ++j) {
                    const int m = m0 + EPI_M(j), n = n0 + EPI_N(i);
                    const float4 st = *(const float4*)(p.pre1 + (long)m * 1024 + n);
                    st_bf4(p.ple + (long)m * 1024 + n, sigmoidf_(acc[i][j][0]) * st.x, sigmoidf_(acc[i][j][1]) * st.y,
                           sigmoidf_(acc[i][j][2]) * st.z, sigmoidf_(acc[i][j][3]) * st.w);
                }
        }
    }
}
__device__ __forceinline__ void phase_route(const Params& p, int l, unsigned* ctr) {
    const int tid = tid__;
    int* s_cnt = s_misc;
    int* s_base = s_misc + 32;
    WorkQ q; q.init(ctr);
    for (;;) {
        int it = q.next();
        if (it >= TT / 256) break;
        if (tid < 32) s_cnt[tid] = 0;
        __syncthreads();
        const int t = it * 256 + tid;
        float lg[32];
#pragma unroll
        for (int i = 0; i < 8; ++i) {
            const float4 v = *(const float4*)(p.logits + (long)t * 32 + i * 4);
            lg[i * 4 + 0] = v.x; lg[i * 4 + 1] = v.y; lg[i * 4 + 2] = v.z; lg[i * 4 + 3] = v.w;
        }
        unsigned taken = 0u;
        int ek[4]; float vk[4];
#pragma unroll
        for (int k = 0; k < 4; ++k) {
            float best = -3.0e38f; int bi = 0;
#pragma unroll
            for (int e = 0; e < 32; ++e) {
                const bool ok = !((taken >> e) & 1u) && (lg[e] > best);
                best = ok ? lg[e] : best;
                bi = ok ? e : bi;
            }
            taken |= 1u << bi;
            ek[k] = bi; vk[k] = best;
        }
        float wsum = 0.f;
        float v0 = -3.0e38f, v1 = 0.f, v2 = 0.f, v3 = 0.f;
#pragma unroll
        for (int e = 0; e < 32; ++e) {
            v0 = (e == ek[0]) ? lg[e] : v0;
            v1 = (e == ek[1]) ? lg[e] : v1;
            v2 = (e == ek[2]) ? lg[e] : v2;
            v3 = (e == ek[3]) ? lg[e] : v3;
        }
        vk[0] = 1.f; vk[1] = __expf(v1 - v0); vk[2] = __expf(v2 - v0); vk[3] = __expf(v3 - v0);
        wsum = vk[0] + vk[1] + vk[2] + vk[3];
        const float winv = 1.f / wsum;
        int lp[4];
#pragma unroll
        for (int k = 0; k < 4; ++k) lp[k] = atomicAdd(&s_cnt[ek[k]], 1);
        __syncthreads();
        if (tid < 32) s_base[tid] = (int)atomicAdd(&p.ecnt[l * 32 + tid], (unsigned)s_cnt[tid]);
        __syncthreads();
#pragma unroll
        for (int k = 0; k < 4; ++k) {
            const long idx = (long)ek[k] * TT + s_base[ek[k]] + lp[k];
            p.ent_id[idx] = t * 4 + k;
            p.ent_w[idx] = vk[k] * winv;
        }
    }
}
__device__ __forceinline__ void moe_prefix(const Params& p, int l) {
    __syncthreads();
    if (tid__ == 0) {
        int acc = 0;
        for (int e = 0; e < 32; ++e) {
            const int n = (int)__hip_atomic_load(&p.ecnt[l * 32 + e], __ATOMIC_RELAXED, __HIP_MEMORY_SCOPE_AGENT);
            s_misc[e] = acc;
            s_misc[40 + e] = n;
            acc += (n + 127) >> 7;
        }
        s_misc[32] = acc;
    }
    __syncthreads();
}
__device__ __forceinline__ void phase_moe_gu(const Params& p, int l, unsigned* ctr) {
    const int tid = tid__;
    moe_prefix(p, l);
    const int mtotal = s_misc[32];
    const int mpx = (((mtotal + 7) >> 3) + 7) & ~7;
    XQ q; q.init(ctr, mpx * 16);
    for (;;) {
        int it = q.next();
        if (it < 0) break;
        int mtg, nt; xq_decode(it, mpx, 16, mtg, nt);
        if (mtg >= mtotal) continue;
        int e = 0;
        for (int i = 1; i < 32; ++i) e = (s_misc[i] <= mtg) ? i : e;
        const int mt = mtg - s_misc[e], ne = s_misc[40 + e];
        const u16* ap[4]; const u16* bp[4];
#pragma unroll
        for (int i = 0; i < 4; ++i) {
            const int r = (tid >> 3) + 32 * i;
            int idx = mt * 128 + r; if (idx > ne - 1) idx = ne - 1;
            const int tok = p.ent_id[(long)e * TT + idx] >> 2;
            ap[i] = p.h1b + (long)tok * 1024;
            const int isup = (r >> 5) & 1, col = (r >> 6) * 32 + (r & 31);
            bp[i] = p.wt_gu + (((long)l * 32 + e) * 2048 + isup * 1024 + nt * 64 + col) * 1024;
        }
        f32x4 acc[4][4]; acc_zero(acc);
        gemm_main(acc, ap, bp, 1024, KId());
        EPI_COORDS
        const float* bg = p.b_gu + ((long)l * 32 + e) * 2048;
#pragma unroll
        for (int i = 0; i < 2; ++i)
#pragma unroll
            for (int j = 0; j < 4; ++j) {
                const long rowa = (long)mtg * 128 + EPI_M(j);
                const int col = nt * 64 + wn_ * 32 + i * 16 + (lane_ >> 4) * 4;
                float v[4];
#pragma unroll
                for (int r = 0; r < 4; ++r) {
                    float gate = acc[i][j][r] + bg[col + r];
                    float up = acc[i + 2][j][r] + bg[1024 + col + r];
                    gate = fminf(gate, 7.f);
                    up = fminf(fmaxf(up, -7.f), 7.f);
                    v[r] = (up + 1.f) * gate * sigmoidf_(1.702f * gate);
                }
                st_bf4(p.act + rowa * 1024 + col, v[0], v[1], v[2], v[3]);
            }
    }
}
__device__ __forceinline__ void phase_moe_down(const Params& p, int l, unsigned* ctr) {
    const int tid = tid__;
    moe_prefix(p, l);
    const int mtotal = s_misc[32];
    const int mpx = (((mtotal + 7) >> 3) + 7) & ~7;
    XQ q; q.init(ctr, mpx * 8);
    for (;;) {
        int it = q.next();
        if (it < 0) break;
        int mtg, nt; xq_decode(it, mpx, 8, mtg, nt);
        if (mtg >= mtotal) continue;
        int e = 0;
        for (int i = 1; i < 32; ++i) e = (s_misc[i] <= mtg) ? i : e;
        const int mt = mtg - s_misc[e], ne = s_misc[40 + e];
        const u16* ap[4]; const u16* bp[4];
#pragma unroll
        for (int i = 0; i < 4; ++i) {
            const int r = (tid >> 3) + 32 * i;
            ap[i] = p.act + ((long)mtg * 128 + r) * 1024;
            bp[i] = p.wt_dn + (((long)l * 32 + e) * 1024 + nt * 128 + r) * 1024;
        }
        f32x4 acc[4][4]; acc_zero(acc);
        gemm_main(acc, ap, bp, 1024, KId());
        EPI_COORDS
        const float* bd = p.b_down + ((long)l * 32 + e) * 1024;
#pragma unroll
        for (int j = 0; j < 4; ++j) {
            const int idx = mt * 128 + EPI_M(j);
            if (idx < ne) {
                const int id = p.ent_id[(long)e * TT + idx];
                const float cw = p.ent_w[(long)e * TT + idx];
#pragma unroll
                for (int i = 0; i < 4; ++i) {
                    const int n = nt * 128 + EPI_N(i);
                    const float4 bb = *(const float4*)(bd + n);
                    st_bf4(p.y4 + (long)id * 1024 + n, cw * (acc[i][j][0] + bb.x), cw * (acc[i][j][1] + bb.y),
                           cw * (acc[i][j][2] + bb.z), cw * (acc[i][j][3] + bb.w));
                }
            }
        }
    }
}

};
#ifndef PH0_EN
#define PH0_EN 1
#endif
__device__ __forceinline__ void run_phase(const Params& p, int ph, int coff) {
    unsigned* ctr = p.ctr + (ph + coff) * 8;
    Ctx cx;
    {
        int t_ = threadIdx.x;
        asm volatile("" : "+v"(t_));
        cx.tid__ = t_;
    }
    if (ph == 0) { if (PH0_EN) cx.phase_prologue(p, ctr); return; }
    const int l = (ph - 1) / NPH_LAYER, s = (ph - 1) % NPH_LAYER;
#ifndef ONLY_S
#define ONLY_S -1
#endif
#ifndef SKIP_S
#define SKIP_S -1
#endif
#define PH_EN(x) ((ONLY_S < 0 || ONLY_S == (x)) && SKIP_S != (x))
    if (PH_EN(0) && s == 0) cx.phase_gemm_in(p, l, ctr);
    if (PH_EN(1) && s == 1) cx.phase_cmp1_sb(p, l, ctr);
    if (PH_EN(2) && s == 2) cx.phase_cmp2(p, l, ctr);
    if (PH_EN(3) && s == 3) cx.phase_nsa(p, ctr);
    if (PH_EN(4) && s == 4) cx.phase_br(p, l, ctr);
    if (PH_EN(5) && s == 5) cx.phase_wo(p, l, ctr);
    if (PH_EN(6) && s == 6) cx.phase_ln(p, l, 1, ctr);
    if (PH_EN(7) && s == 7) cx.phase_router_ple(p, l, ctr);
    if (PH_EN(8) && s == 8) cx.phase_route(p, l, ctr);
    if (PH_EN(9) && s == 9) cx.phase_moe_gu(p, l, ctr);
    if (PH_EN(10) && s == 10) cx.phase_moe_down(p, l, ctr);
    if (PH_EN(11) && s == 11) cx.phase_ln(p, l, 2, ctr);
}

__global__ void __launch_bounds__(256, 2) mega_kernel(Params p, int ph0, int ph1) {
    __shared__ uint4 xb_words;
    if (threadIdx.x == 0) xb_words = make_uint4(0u, 0u, 0u, 0u);
    __syncthreads();
    __shared__ Params s_p;
    if (threadIdx.x == 0) {
        const void* const* src_ = (const void* const*)&p;
        const void** dst_ = (const void**)&s_p;
#pragma unroll
        for (int i = 0; i < (int)(sizeof(Params) / sizeof(void*)); ++i) dst_[i] = src_[i];
    }
    __syncthreads();
    XcdBarrier bar = xcd_barrier_post(p.bar, (volatile LAS unsigned*)&xb_words);
    for (int ph = ph0; ph < ph1; ++ph) {
        if (ph > ph0) xcd_barrier(bar);
        asm volatile("" ::: "memory");
        run_phase(s_p, ph, 0);
#if REP_MASK
        if (ph > 0 && ((REP_MASK >> ((ph - 1) % NPH_LAYER)) & 1)) {
            xcd_barrier(bar);
            asm volatile("" ::: "memory");
            run_phase(s_p, ph, 64);
        }
#endif
    }
}

#ifndef REP_MASK
#define REP_MASK 0
#endif
#ifndef MK_SPLIT
#define MK_SPLIT 0
#endif

extern "C" void kernel_launch(void* const* d_in, const int* in_sizes, int n_in, void* d_out, int out_size, void* d_ws,
                              size_t ws_size, hipStream_t stream) {
    static int grid = 0;
    if (!grid) {
        int dev = 0, cus = 0, per_cu = 0;
        hipGetDevice(&dev);
        hipDeviceGetAttribute(&cus, hipDeviceAttributeMultiprocessorCount, dev);
        hipOccupancyMaxActiveBlocksPerMultiprocessor(&per_cu, mega_kernel, 256, 0);
        if (per_cu < 1) per_cu = 1;
        grid = cus * (per_cu < 2 ? per_cu : 2);
    }
    Params p;
    memset(&p, 0, sizeof(p));
    const float** pin = (const float**)&p;
    for (int i = 0; i < 21; ++i) pin[i] = (const float*)d_in[i];
    p.out = (float*)d_out;
    char* w = (char*)d_ws;
    size_t off = 0;
    auto take = [&](size_t bytes) { char* r = w + off; off += (bytes + 255) & ~(size_t)255; return r; };
    const size_t sync_bytes = (XCD_BAR_WORDS + 1024 + 128) * sizeof(unsigned);
    p.bar = (unsigned*)take(sync_bytes);
    p.ctr = p.bar + XCD_BAR_WORDS;
    p.ecnt = p.ctr + 1024;
    p.wt_in = (u16*)take((size_t)4 * NIN * 1024 * 2);
    p.wt_brs = (u16*)take((size_t)4 * 512 * 1024 * 2);
    p.wt_brn = (u16*)take((size_t)4 * 512 * 1024 * 2);
    p.wt_o = (u16*)take((size_t)4 * 1024 * 1024 * 2);
    p.wt_pg = (u16*)take((size_t)4 * 1024 * 1024 * 2);
    p.wt_pp = (u16*)take((size_t)4 * 256 * 1024 * 2);
    p.wt_gu = (u16*)take((size_t)128 * 2048 * 1024 * 2);
    p.wt_dn = (u16*)take((size_t)128 * 1024 * 1024 * 2);
    p.wt_c1 = (u16*)take((size_t)8 * 128 * 2048 * 2);
    p.wt_c2 = (u16*)take((size_t)8 * 64 * 128 * 2);
    p.wt_r = (u16*)take((size_t)4 * 32 * 3072 * 2);
    p.cbias = (float*)take(1024 * 4);
    p.hf = (float*)take((size_t)TT * 1024 * 4);
    p.pre1 = (float*)take((size_t)TT * 1024 * 4);
    p.h1f = (float*)take((size_t)TT * 1024 * 4);
    p.logits = (float*)take((size_t)TT * 32 * 4);
    p.ynf = (float*)take((size_t)TT * 512 * 4);
    p.ent_w = (float*)take((size_t)32 * TT * 4);
    p.hb = (u16*)take((size_t)TT * 1024 * 2);
    p.pb = (u16*)take((size_t)4 * TT * 256 * 2);
    p.yb = (u16*)take((size_t)TT * NIN * 2);
    p.ysb = (u16*)take((size_t)TT * 512 * 2);
    p.ynsa = (u16*)take((size_t)TT * 512 * 2);
    p.merged = (u16*)take((size_t)TT * 1024 * 2);
    p.h1b = (u16*)take((size_t)TT * 1024 * 2);
    p.h1lo = (u16*)take((size_t)TT * 1024 * 2);
    p.ple = (u16*)take((size_t)TT * 1024 * 2);
    p.hid = (u16*)take((size_t)2 * 2048 * 128 * 2);
    p.kvc = (u16*)take((size_t)2 * 2048 * 64 * 2);
    p.act = (u16*)take((size_t)(TT * 4 + 32 * 128) * 1024 * 2);
    p.y4 = (u16*)take((size_t)TT * 4 * 1024 * 2);
    p.ent_id = (int*)take((size_t)32 * TT * 4);
    if (off > ws_size) { fprintf(stderr, "workspace too small: need %zu have %zu\n", off, ws_size); return; }
    hipMemsetAsync(p.bar, 0, sync_bytes, stream);
#if MK_SPLIT
    for (int ph = 0; ph < NPHASE; ++ph) mega_kernel<<<dim3(grid), dim3(256), 0, stream>>>(p, ph, ph + 1);
#else
    mega_kernel<<<dim3(grid), dim3(256), 0, stream>>>(p, 0, NPHASE);
#endif
}
```

```cpp
#define NSA_HPB 2
#include <hip/hip_runtime.h>
#include <stdint.h>
#include <cstdio>
#include <cstring>
#include <cstdlib>
#include <vector>

#define XB_TMO      128
#define XB_XCNT(j)  (256  + 64 * (j))
#define XB_XSUB(j)  (1280 + 64 * (j))
#define XB_XGEN(j)  (2304 + 64 * (j))
#define XB_TOP      3328
#define XB_TOPGEN   3392
#define XCD_BAR_WORDS 3456
#define XB_SPIN_CAP (1u << 18)
#define LAS __attribute__((address_space(3)))

__device__ __forceinline__ unsigned xb_ld(unsigned* p)              { return __hip_atomic_load(p, __ATOMIC_RELAXED, __HIP_MEMORY_SCOPE_AGENT); }
__device__ __forceinline__ unsigned xb_add(unsigned* p, unsigned v) { return __hip_atomic_fetch_add(p, v, __ATOMIC_RELAXED, __HIP_MEMORY_SCOPE_AGENT); }
__device__ __forceinline__ unsigned xb_xcc_id() { return (unsigned)__builtin_amdgcn_s_getreg((3 << 11) | 20) & 0xFu; }
#define XB_SPIN(cond, bar) do { unsigned _sp = 0; while (cond) { __builtin_amdgcn_s_sleep(1); \
    if ((++_sp & 255u) == 0u) { if (xb_ld(&(bar)[XB_TMO])) break; if (_sp > XB_SPIN_CAP) { atomicAdd(&(bar)[XB_TMO], 1u); break; } } } } while (0)

struct XcdBarrier {
    unsigned* bar; unsigned x;
    volatile LAS unsigned* st;
};

__device__ __forceinline__ XcdBarrier xcd_barrier_post(unsigned* bar, volatile LAS unsigned* st, const bool xb_t0) {
    XcdBarrier b; b.bar = bar; b.x = xb_xcc_id(); b.st = st;
    if (xb_t0) (void)xb_add(&bar[XB_XCNT(b.x)], 1u);
    return b;
}
__device__ __forceinline__ void xcd_barrier_complete(unsigned* bar, unsigned x, unsigned& nloc, unsigned& nx) {
    const unsigned G = gridDim.x * gridDim.y * gridDim.z;
    unsigned sum, cnt, mine, sp = 0u;
    for (;;) {
        sum = 0u; cnt = 0u; mine = 0u;
#pragma unroll
        for (unsigned j = 0; j < 16; ++j) { const unsigned c = xb_ld(&bar[XB_XCNT(j)]); sum += c; cnt += (c > 0u) ? 1u : 0u; mine = (j == x) ? c : mine; }
        if (sum == G) break;
        __builtin_amdgcn_s_sleep(1);
        if ((++sp & 255u) == 0u) { if (xb_ld(&bar[XB_TMO])) break; if (sp > XB_SPIN_CAP) { atomicAdd(&bar[XB_TMO], 1u); break; } }
    }
    nloc = mine > 0u ? mine : 1u; nx = cnt > 0u ? cnt : 1u;
}

__device__ __forceinline__ void xcd_barrier(const XcdBarrier& b, const bool xb_t0) {
    asm volatile("s_waitcnt vmcnt(0)" ::: "memory");
    __syncthreads();
    if (xb_t0) {
        unsigned* bar = b.bar;
        __builtin_amdgcn_s_waitcnt(0);
        unsigned nloc = b.st[0], nx = b.st[1];
        if (nloc == 0u) { xcd_barrier_complete(bar, b.x, nloc, nx); b.st[0] = nloc; b.st[1] = nx; }
        const unsigned old = xb_add(&bar[XB_XSUB(b.x)], 1u);
        const unsigned gen = old / nloc;
        if (old + 1u == (gen + 1u) * nloc) {
            __builtin_amdgcn_fence(__ATOMIC_RELEASE, "agent");
            asm volatile("s_waitcnt vmcnt(0)" ::: "memory");
            const unsigned og = xb_add(&bar[XB_TOP], 1u);
            const unsigned tg = og / nx;
            if (og + 1u == (tg + 1u) * nx) xb_add(&bar[XB_TOPGEN], 1u);
            else XB_SPIN(xb_ld(&bar[XB_TOPGEN]) == tg, bar);
            __builtin_amdgcn_fence(__ATOMIC_ACQUIRE, "agent");
            xb_add(&bar[XB_XGEN(b.x)], 1u);
            asm volatile("s_waitcnt vmcnt(0)" ::: "memory");
        } else {
            XB_SPIN(xb_ld(&bar[XB_XGEN(b.x)]) == gen, bar);
            __builtin_amdgcn_fence(__ATOMIC_ACQUIRE, "agent");
            asm volatile("s_waitcnt vmcnt(0)" ::: "memory");
        }
    }
    __syncthreads();
}


#ifndef REP_MASK
#define REP_MASK 0
#endif
typedef unsigned short u16;
typedef __attribute__((ext_vector_type(8))) short bf16x8;
typedef __attribute__((ext_vector_type(4))) float f32x4;
typedef __attribute__((ext_vector_type(4))) unsigned u32x4;
#define MFMA(a, b, c) __builtin_amdgcn_mfma_f32_16x16x32_bf16(a, b, c, 0, 0, 0)

#define TT 32768
#define SS 4096
#define DD 1024
#define NIN 4888
#define C_SBQ 0
#define C_SBK 512
#define C_SBV 1024
#define C_NQ 1536
#define C_KC 2048
#define C_VC 2176
#define C_KS 2304
#define C_VS 2432
#define C_KW 2560
#define C_VW 2688
#define C_NG 2816
#define C_GSB 2840
#define C_GNSA 3864
#define DN_ALPHA 1.681792830507429f
#define NPH_LAYER 12
#define NPHASE (1 + 4 * NPH_LAYER)
#define KSTR 72
#define VSTR 136
#define SSTR 68

struct Params {
    const float *x, *p, *w_in, *w_cmp1, *w_cmp2, *pe_cmp, *w_br_sb, *w_br_nsa, *w_o, *ln1_g, *ln1_b, *ln2_g, *ln2_b,
        *w_router, *b_router, *w_gu, *b_gu, *w_down, *b_down, *w_ple_gate, *w_ple_proj;
    float* out;
    unsigned *bar, *ctr, *ecnt;
    u16 *wt_in, *wt_brs, *wt_brn, *wt_o, *wt_pg, *wt_pp, *wt_gu, *wt_dn, *wt_c1, *wt_c2, *wt_r;
    float *cbias, *hf, *pre1, *h1f, *logits, *ynf, *ent_w;
    u16 *hb, *pb, *yb, *ysb, *ynsa, *merged, *h1b, *h1lo, *ple, *hid, *kvc, *act, *y4;
    int* ent_id;
};

__device__ __forceinline__ u16 f2bf(float f) {
    unsigned u = __float_as_uint(f);
    u += 0x7fffu + ((u >> 16) & 1u);
    return (u16)(u >> 16);
}
__device__ __forceinline__ float bf2f(u16 h) { return __uint_as_float(((unsigned)h) << 16); }
__device__ __forceinline__ void st_bf4(u16* p, float a, float b, float c, float d) {
    uint2 u;
    u.x = (unsigned)f2bf(a) | ((unsigned)f2bf(b) << 16);
    u.y = (unsigned)f2bf(c) | ((unsigned)f2bf(d) << 16);
    *(uint2*)p = u;
}
__device__ __forceinline__ float sigmoidf_(float x) { return 1.f / (1.f + __expf(-x)); }

__shared__ __attribute__((aligned(16))) unsigned char g_smem[62464];
__shared__ int s_item;
__shared__ int s_misc[80];
__shared__ unsigned long long s_mask[4][16];
__shared__ unsigned long long s_union[4];

struct WorkQ {
    unsigned* ctr;
    int nxt;
    bool t0;
    __device__ __forceinline__ void init(unsigned* c, bool t0_) {
        ctr = c;
        nxt = 0;
        t0 = t0_;
        if (t0) nxt = (int)atomicAdd(ctr, 1u);
    }
    __device__ __forceinline__ int next() {
        __syncthreads();
        if (t0) s_item = nxt;
        __syncthreads();
        int it = s_item;
        if (t0) nxt = (int)atomicAdd(ctr, 1u);
        return it;
    }
};


struct XQ {
    unsigned* ctr;
    int per, x0, k, nxt;
    bool t0;
    __device__ __forceinline__ void init(unsigned* c, int per_, bool t0_) {
        ctr = c; per = per_; k = 0; nxt = 0; t0 = t0_;
        x0 = (int)(xb_xcc_id() & 7u);
        if (t0) nxt = (int)atomicAdd(&ctr[x0], 1u);
    }
    __device__ __forceinline__ int next() {
        __syncthreads();
        if (t0) {
            int v = nxt;
            while (v >= per && k < 8) {
                ++k;
                if (k < 8) v = (int)atomicAdd(&ctr[(x0 + k) & 7], 1u);
            }
            if (k < 8) {
                s_item = ((x0 + k) & 7) * per + v;
                nxt = (int)atomicAdd(&ctr[(x0 + k) & 7], 1u);
            } else s_item = -1;
        }
        __syncthreads();
        return s_item;
    }
};
__device__ __forceinline__ void xq_decode(int item, int mpx, int NT, int& mt, int& nt) {
    const int per = mpx * NT;
    const int q = item / per, idx = item - q * per;
    const int sm = idx / (8 * NT), rem = idx - sm * (8 * NT);
    nt = rem >> 3;
    mt = q * mpx + sm * 8 + (rem & 7);
}
struct Ctx {
    int tid__;
struct KId {
    __device__ __forceinline__ long operator()(int k) const { return k; }
};
template <class KOA>
__device__ __forceinline__ void gemm_main(f32x4 (&acc)[4][4], const u16* (&ap)[4], const u16* (&bp)[4], int K, KOA koa) {
    u16* sA = (u16*)g_smem;
    u16* sB = sA + 128 * KSTR;
    const int tid = tid__, lane = tid & 63, wave = tid >> 6;
    const int wn = wave & 1, wm = wave >> 1;
    const int kc = (tid & 7) * 8;
    const int lrow = tid >> 3;
    u32x4 ra[4], rb[4];
    {
        const long oa = koa(kc);
#pragma unroll
        for (int i = 0; i < 4; ++i) {
            ra[i] = *(const u32x4*)(ap[i] + oa);
            rb[i] = *(const u32x4*)(bp[i] + kc);
        }
    }
    for (int k0 = 0; k0 < K; k0 += 64) {
        __syncthreads();
#pragma unroll
        for (int i = 0; i < 4; ++i) {
            *(u32x4*)(sA + (lrow + 32 * i) * KSTR + kc) = ra[i];
            *(u32x4*)(sB + (lrow + 32 * i) * KSTR + kc) = rb[i];
        }
        __syncthreads();
        if (k0 + 64 < K) {
            const long oa = koa(k0 + 64 + kc);
#pragma unroll
            for (int i = 0; i < 4; ++i) {
                ra[i] = *(const u32x4*)(ap[i] + oa);
                rb[i] = *(const u32x4*)(bp[i] + (k0 + 64 + kc));
            }
        }
#pragma unroll
        for (int ks = 0; ks < 2; ++ks) {
            bf16x8 af[4], bfr[4];
#pragma unroll
            for (int j = 0; j < 4; ++j)
                af[j] = *(const bf16x8*)(sA + (wm * 64 + j * 16 + (lane & 15)) * KSTR + ks * 32 + (lane >> 4) * 8);
#pragma unroll
            for (int i = 0; i < 4; ++i)
                bfr[i] = *(const bf16x8*)(sB + (wn * 64 + i * 16 + (lane & 15)) * KSTR + ks * 32 + (lane >> 4) * 8);
#pragma unroll
            for (int i = 0; i < 4; ++i)
#pragma unroll
                for (int j = 0; j < 4; ++j) acc[i][j] = MFMA(bfr[i], af[j], acc[i][j]);
        }
    }
}
__device__ __forceinline__ void acc_zero(f32x4 (&acc)[4][4]) {
#pragma unroll
    for (int i = 0; i < 4; ++i)
#pragma unroll
        for (int j = 0; j < 4; ++j) acc[i][j] = f32x4{0.f, 0.f, 0.f, 0.f};
}
#define EPI_COORDS                                         \
    const int lane_ = tid__ & 63, wave_ = tid__ >> 6; \
    const int wn_ = wave_ & 1, wm_ = wave_ >> 1;
#define EPI_M(j) (wm_ * 64 + (j) * 16 + (lane_ & 15))
#define EPI_N(i) (wn_ * 64 + (i) * 16 + (lane_ >> 4) * 4)

__device__ __forceinline__ void xjob(const Params& p, int j, const float*& src, u16*& dst, int& nb, int& K, int& N) {
    switch (j) {
        case 0: src = p.w_in; dst = p.wt_in; nb = 4; K = 1024; N = NIN; break;
        case 1: src = p.w_br_sb; dst = p.wt_brs; nb = 4; K = 512; N = 1024; break;
        case 2: src = p.w_br_nsa; dst = p.wt_brn; nb = 4; K = 512; N = 1024; break;
        case 3: src = p.w_o; dst = p.wt_o; nb = 4; K = 1024; N = 1024; break;
        case 4: src = p.w_ple_gate; dst = p.wt_pg; nb = 4; K = 1024; N = 1024; break;
        case 5: src = p.w_ple_proj; dst = p.wt_pp; nb = 4; K = 256; N = 1024; break;
        case 6: src = p.w_gu; dst = p.wt_gu; nb = 128; K = 1024; N = 2048; break;
        case 7: src = p.w_down; dst = p.wt_dn; nb = 128; K = 1024; N = 1024; break;
        case 8: src = p.w_cmp1; dst = p.wt_c1; nb = 8; K = 2048; N = 128; break;
        default: src = p.w_cmp2; dst = p.wt_c2; nb = 8; K = 128; N = 64; break;
    }
}
__device__ __forceinline__ int xjob_tiles(int nb, int K, int N) { return nb * (K / 128) * ((N + 63) / 64); }

__device__ __forceinline__ void phase_prologue(const Params& p, unsigned* ctr) {
    const int tid = tid__;
    int ntr = 0;
    for (int j = 0; j < 10; ++j) {
        const float* s; u16* d; int nb, K, N;
        xjob(p, j, s, d, nb, K, N);
        ntr += xjob_tiles(nb, K, N);
    }
    const int n_x = TT * DD / 8192, n_p = 4 * TT * 256 / 8192, n_r = 16, n_b = 16;
    const int total = ntr + n_x + n_p + n_r + n_b;
    float* st = (float*)g_smem;
    WorkQ q; q.init(ctr, tid__ == 0);
    for (;;) {
        int it = q.next();
        if (it >= total) break;
        it = (it < n_b + n_r) ? (ntr + n_x + n_p + (it < n_b ? n_r + it : it - n_b)) : it - (n_b + n_r);
        if (it < ntr) {
            const float* src = nullptr; u16* dst = nullptr; int nb = 0, K = 0, N = 0;
            int rem = it;
            for (int j = 0; j < 10; ++j) {
                xjob(p, j, src, dst, nb, K, N);
                int nt = xjob_tiles(nb, K, N);
                if (rem < nt) break;
                rem -= nt;
            }
            const int ktn = K / 128, ntn = (N + 63) / 64;
            const int tpm = ktn * ntn;
            const int b = rem / tpm; rem -= b * tpm;
            const int kt = rem % ktn, nt = rem / ktn;
            src += (long)b * K * N; dst += (long)b * K * N;
            const int k0 = kt * 128, n0 = nt * 64;
            float4 v[8];
#pragma unroll
            for (int i = 0; i < 8; ++i) {
                int k = (tid >> 4) + 16 * i, n = (tid & 15) * 4;
                v[i] = make_float4(0.f, 0.f, 0.f, 0.f);
                if (n0 + n < N) v[i] = *(const float4*)(src + (long)(k0 + k) * N + n0 + n);
            }
#pragma unroll
            for (int i = 0; i < 8; ++i) {
                int k = (tid >> 4) + 16 * i, n = (tid & 15) * 4;
                st[k * 65 + n + 0] = v[i].x; st[k * 65 + n + 1] = v[i].y; st[k * 65 + n + 2] = v[i].z; st[k * 65 + n + 3] = v[i].w;
            }
            __syncthreads();
#pragma unroll
            for (int i = 0; i < 4; ++i) {
                int n = (tid >> 4) + 16 * i, k8 = (tid & 15) * 8;
                if (n0 + n < N) {
                    uint4 u;
                    u.x = (unsigned)f2bf(st[(k8 + 0) * 65 + n]) | ((unsigned)f2bf(st[(k8 + 1) * 65 + n]) << 16);
                    u.y = (unsigned)f2bf(st[(k8 + 2) * 65 + n]) | ((unsigned)f2bf(st[(k8 + 3) * 65 + n]) << 16);
                    u.z = (unsigned)f2bf(st[(k8 + 4) * 65 + n]) | ((unsigned)f2bf(st[(k8 + 5) * 65 + n]) << 16);
                    u.w = (unsigned)f2bf(st[(k8 + 6) * 65 + n]) | ((unsigned)f2bf(st[(k8 + 7) * 65 + n]) << 16);
                    *(uint4*)(dst + (long)(n0 + n) * K + k0 + k8) = u;
                }
            }
        } else if (it < ntr + n_x + n_p) {
            int e = it - ntr;
            const float* src; u16* db; float* df = nullptr;
            if (e < n_x) { src = p.x + (long)e * 8192; db = p.hb + (long)e * 8192; df = p.hf + (long)e * 8192; }
            else { e -= n_x; src = p.p + (long)e * 8192; db = p.pb + (long)e * 8192; }
#pragma unroll
            for (int i = 0; i < 8; ++i) {
                int o = i * 1024 + tid * 4;
                float4 v = *(const float4*)(src + o);
                if (df) *(float4*)(df + o) = v;
                st_bf4(db + o, v.x, v.y, v.z, v.w);
            }
        } else if (it < ntr + n_x + n_p + n_r) {
            int e0 = (it - ntr - n_x - n_p) * 8192;
            for (int i = 0; i < 32; ++i) {
                int idx = e0 + i * 256 + tid;
                int k = idx & 1023, le = idx >> 10, e = le & 31, l = le >> 5;
                float w = p.w_router[((long)l * 1024 + k) * 32 + e];
                u16 hi = f2bf(w); u16 lo = f2bf(w - bf2f(hi));
                u16* d = p.wt_r + (long)le * 3072;
                d[k] = hi; d[1024 + k] = lo; d[2048 + k] = hi;
            }
        } else {
            const int bi = it - ntr - n_x - n_p - n_r;
            const int lk = bi >> 1, h = (bi & 1) * 64 + (tid & 63), jp = tid >> 6;
            const float* pe = p.pe_cmp + (long)lk * 2048 + jp * 512;
            const float* w1 = p.w_cmp1 + ((long)lk * 2048 + jp * 512) * 128 + h;
            float sacc = 0.f;
#pragma unroll 8
            for (int j = 0; j < 512; ++j) sacc += pe[j] * w1[(long)j * 128];
            st[tid] = sacc;
            __syncthreads();
            if (tid < 64) p.cbias[lk * 128 + h] = (st[tid] + st[tid + 64]) + (st[tid + 128] + st[tid + 192]);
        }
    }
}

__device__ __forceinline__ void phase_gemm_in(const Params& p, int l, unsigned* ctr) {
    const int NTN = (NIN + 127) / 128;
    const int tid = tid__;
    const u16* W = p.wt_in + (long)l * NIN * 1024;
    XQ q; q.init(ctr, 32 * NTN, tid__ == 0);
    for (;;) {
        int it = q.next();
        if (it < 0) break;
        int mt, nt; xq_decode(it, 32, NTN, mt, nt);
        const int m0 = mt * 128, n0 = nt * 128;
        const u16* ap[4]; const u16* bp[4];
#pragma unroll
        for (int i = 0; i < 4; ++i) {
            int r = (tid >> 3) + 32 * i;
            ap[i] = p.hb + (long)(m0 + r) * 1024;
            int n = n0 + r; if (n > NIN - 1) n = NIN - 1;
            bp[i] = W + (long)n * 1024;
        }
        f32x4 acc[4][4]; acc_zero(acc);
        gemm_main(acc, ap, bp, 1024, KId());
        EPI_COORDS
#pragma unroll
        for (int i = 0; i < 4; ++i)
#pragma unroll
            for (int j = 0; j < 4; ++j) {
                int m = m0 + EPI_M(j), n = n0 + EPI_N(i);
                if (n < NIN) st_bf4(p.yb + (long)m * NIN + n, acc[i][j][0], acc[i][j][1], acc[i][j][2], acc[i][j][3]);
            }
    }
}

struct KCmp {
    __device__ __forceinline__ long operator()(int k) const { return (long)(k >> 6) * NIN + (k & 63); }
};
__device__ __forceinline__ void tile_cmp1(const Params& p, int l, int it) {
    const int tid = tid__;
    const int kv = it >> 4, mt = it & 15;
    const u16* W = p.wt_c1 + (long)(l * 2 + kv) * 128 * 2048;
    const u16* ap[4]; const u16* bp[4];
#pragma unroll
    for (int i = 0; i < 4; ++i) {
        int r = (tid >> 3) + 32 * i;
        int mrow = mt * 128 + r;
        int c = mrow & 127, bg = mrow >> 7, g = bg & 1, b = bg >> 1;
        ap[i] = p.yb + (long)(b * SS + c * 32) * NIN + (kv ? C_VC : C_KC) + g * 64;
        bp[i] = W + (long)r * 2048;
    }
    f32x4 acc[4][4]; acc_zero(acc);
    gemm_main(acc, ap, bp, 2048, KCmp());
    EPI_COORDS
    const float* cb = p.cbias + (l * 2 + kv) * 128;
#pragma unroll
    for (int i = 0; i < 4; ++i)
#pragma unroll
        for (int j = 0; j < 4; ++j) {
            int m = mt * 128 + EPI_M(j), n = EPI_N(i);
            float v[4];
#pragma unroll
            for (int r = 0; r < 4; ++r) { float a = acc[i][j][r] + cb[n + r]; v[r] = a * sigmoidf_(a); }
            st_bf4(p.hid + ((long)kv * 2048 + m) * 128 + n, v[0], v[1], v[2], v[3]);
        }
}
__device__ __forceinline__ void phase_cmp2(const Params& p, int l, unsigned* ctr) {
    const int tid = tid__;
    WorkQ q; q.init(ctr, tid__ == 0);
    for (;;) {
        int it = q.next();
        if (it >= 32) break;
        const int kv = it >> 4, mt = it & 15;
        const u16* W = p.wt_c2 + (long)(l * 2 + kv) * 64 * 128;
        const u16* ap[4]; const u16* bp[4];
#pragma unroll
        for (int i = 0; i < 4; ++i) {
            int r = (tid >> 3) + 32 * i;
            ap[i] = p.hid + ((long)kv * 2048 + mt * 128 + r) * 128;
            bp[i] = W + (long)(r & 63) * 128;
        }
        f32x4 acc[4][4]; acc_zero(acc);
        gemm_main(acc, ap, bp, 128, KId());
        EPI_COORDS
#pragma unroll
        for (int i = 0; i < 4; ++i)
#pragma unroll
            for (int j = 0; j < 4; ++j) {
                int m = mt * 128 + EPI_M(j), n = EPI_N(i);
                if (n < 64) st_bf4(p.kvc + ((long)kv * 2048 + m) * 64 + n, acc[i][j][0], acc[i][j][1], acc[i][j][2], acc[i][j][3]);
            }
    }
}

struct AttnLds {
    u16* K;
    u16* Vt;
    float* S;
    u16* P;
};
__device__ __forceinline__ AttnLds attn_lds() {
    AttnLds a;
    a.K = (u16*)g_smem;
    a.Vt = (u16*)(g_smem + 18432);
    a.S = (float*)(g_smem + 18432 + 17408) + (tid__ >> 6) * 16 * SSTR;
    a.P = (u16*)(g_smem + 18432 + 17408 + 17408) + (tid__ >> 6) * 16 * KSTR;
    return a;
}
__device__ __forceinline__ void load_k_tile(u16* sK, int koff, const u16* base, long stride) {
    const int tid = tid__, key = tid >> 2, ch = (tid & 3) * 16;
    const u16* g = base + (long)key * stride + ch;
    uint4 a = *(const uint4*)g, b = *(const uint4*)(g + 8);
    *(uint4*)(sK + (koff + key) * KSTR + ch) = a;
    *(uint4*)(sK + (koff + key) * KSTR + ch + 8) = b;
}
__device__ __forceinline__ void load_v_tile(u16* sVt, int koff, const u16* base, long stride) {
    const int tid = tid__, key = tid & 63, d0 = (tid >> 6) * 16;
    const u16* g = base + (long)key * stride + d0;
    uint4 a = *(const uint4*)g, b = *(const uint4*)(g + 8);
    unsigned w[8] = {a.x, a.y, a.z, a.w, b.x, b.y, b.z, b.w};
#pragma unroll
    for (int i = 0; i < 8; ++i) {
        sVt[(d0 + 2 * i) * VSTR + koff + key] = (u16)(w[i] & 0xffffu);
        sVt[(d0 + 2 * i + 1) * VSTR + koff + key] = (u16)(w[i] >> 16);
    }
}
__device__ __forceinline__ void wave_qk(const AttnLds& L, int koff, const bf16x8 (&qf)[2]) {
    const int lane = tid__ & 63, quad = lane >> 4, c = lane & 15;
#pragma unroll
    for (int nt = 0; nt < 4; ++nt) {
        f32x4 a = {0.f, 0.f, 0.f, 0.f};
#pragma unroll
        for (int ks = 0; ks < 2; ++ks) {
            bf16x8 kf = *(const bf16x8*)(L.K + (koff + nt * 16 + c) * KSTR + ks * 32 + quad * 8);
            a = MFMA(qf[ks], kf, a);
        }
#pragma unroll
        for (int r = 0; r < 4; ++r) L.S[(quad * 4 + r) * SSTR + nt * 16 + c] = a[r];
    }
}
__device__ __forceinline__ void wave_pv(const AttnLds& L, int koff, f32x4 (&o)[4]) {
    const int lane = tid__ & 63, quad = lane >> 4, c = lane & 15;
#pragma unroll
    for (int ks = 0; ks < 2; ++ks) {
        bf16x8 pf = *(const bf16x8*)(L.P + c * KSTR + ks * 32 + quad * 8);
#pragma unroll
        for (int dt = 0; dt < 4; ++dt) {
            bf16x8 vf = *(const bf16x8*)(L.Vt + (dt * 16 + c) * VSTR + koff + ks * 32 + quad * 8);
            o[dt] = MFMA(pf, vf, o[dt]);
        }
    }
}
__device__ __forceinline__ void read_s16(const AttnLds& L, int row, int part, float (&z)[16]) {
#pragma unroll
    for (int i = 0; i < 4; ++i) {
        float4 v = *(const float4*)(L.S + row * SSTR + part * 16 + i * 4);
        z[i * 4 + 0] = v.x; z[i * 4 + 1] = v.y; z[i * 4 + 2] = v.z; z[i * 4 + 3] = v.w;
    }
}
__device__ __forceinline__ void write_p16(const AttnLds& L, int row, int part, const float (&pv)[16]) {
    uint4 a, b;
    a.x = (unsigned)f2bf(pv[0]) | ((unsigned)f2bf(pv[1]) << 16);
    a.y = (unsigned)f2bf(pv[2]) | ((unsigned)f2bf(pv[3]) << 16);
    a.z = (unsigned)f2bf(pv[4]) | ((unsigned)f2bf(pv[5]) << 16);
    a.w = (unsigned)f2bf(pv[6]) | ((unsigned)f2bf(pv[7]) << 16);
    b.x = (unsigned)f2bf(pv[8]) | ((unsigned)f2bf(pv[9]) << 16);
    b.y = (unsigned)f2bf(pv[10]) | ((unsigned)f2bf(pv[11]) << 16);
    b.z = (unsigned)f2bf(pv[12]) | ((unsigned)f2bf(pv[13]) << 16);
    b.w = (unsigned)f2bf(pv[14]) | ((unsigned)f2bf(pv[15]) << 16);
    *(uint4*)(L.P + row * KSTR + part * 16) = a;
    *(uint4*)(L.P + row * KSTR + part * 16 + 8) = b;
}
__device__ __forceinline__ float row4_max(float v) {
    v = fmaxf(v, __shfl_xor(v, 1));
    v = fmaxf(v, __shfl_xor(v, 2));
    return v;
}
__device__ __forceinline__ float row4_sum(float v) {
    v += __shfl_xor(v, 1);
    v += __shfl_xor(v, 2);
    return v;
}

__device__ __forceinline__ void item_sb(const Params& p, int it) {
    const int tid = tid__, lane = tid & 63, wave = tid >> 6, quad = lane >> 4, c = lane & 15;
    const int qb = it & 63, h = (it >> 6) & 7, b = it >> 9;
    const int t0 = qb * 64;
    AttnLds L = attn_lds();
    bf16x8 qf[2];
    {
        const u16* g = p.yb + (long)(b * SS + t0 + wave * 16 + c) * NIN + C_SBQ + h * 64 + quad * 8;
        qf[0] = *(const bf16x8*)g;
        qf[1] = *(const bf16x8*)(g + 32);
    }
    const int row = lane >> 2, part = lane & 3;
    const int t = t0 + wave * 16 + row;
    float R = 0.f;
    f32x4 o[4];
#pragma unroll
    for (int dt = 0; dt < 4; ++dt) o[dt] = f32x4{0.f, 0.f, 0.f, 0.f};
    for (int kb = qb; kb >= 0; --kb) {
        __syncthreads();
        const u16* kbase = p.yb + (long)(b * SS + kb * 64) * NIN + h * 64;
        load_k_tile(L.K, 0, kbase + C_SBK, NIN);
        load_v_tile(L.Vt, 0, kbase + C_SBV, NIN);
        __syncthreads();
        wave_qk(L, 0, qf);
        __syncthreads();
        float z[16], lat[16];
        read_s16(L, row, part, z);
        float run = 0.f;
#pragma unroll
        for (int i = 15; i >= 0; --i) {
            const int key = kb * 64 + part * 16 + i;
            const bool valid = key < t;
            const float zz = z[i] * 0.125f;
            const float sp = fmaxf(zz, 0.f) + __logf(1.f + __expf(-fabsf(zz)));
            lat[i] = run;
            z[i] = valid ? (zz - sp) : -1e30f;
            run += valid ? -sp : 0.f;
        }
        const int lb = lane & ~3;
        const float t0_ = __shfl(run, lb), t1_ = __shfl(run, lb + 1), t2_ = __shfl(run, lb + 2), t3_ = __shfl(run, lb + 3);
        float off = R;
        if (part < 3) off += t3_;
        if (part < 2) off += t2_;
        if (part < 1) off += t1_;
        float pv[16];
#pragma unroll
        for (int i = 0; i < 16; ++i) pv[i] = (z[i] > -1e29f) ? __expf(z[i] + lat[i] + off) : 0.f;
        write_p16(L, row, part, pv);
        R += (t0_ + t1_) + (t2_ + t3_);
        const int done = __syncthreads_and(R < -110.f);
        wave_pv(L, 0, o);
        if (done) break;
    }
#pragma unroll
    for (int dt = 0; dt < 4; ++dt)
#pragma unroll
        for (int r = 0; r < 4; ++r)
            p.ysb[(long)(b * SS + t0 + wave * 16 + quad * 4 + r) * 512 + h * 64 + dt * 16 + c] = f2bf(o[dt][r]);
}

__device__ __forceinline__ void phase_cmp1_sb(const Params& p, int l, unsigned* ctr) {
    const int total = 32 + 8 * 8 * 64;
    WorkQ q; q.init(ctr, tid__ == 0);
    for (;;) {
        int it = q.next();
        if (it >= total) break;
        if (it < 32) tile_cmp1(p, l, it);
        else item_sb(p, it - 32);
    }
}

template <int MODE>
__device__ __forceinline__ void nsa_step(const AttnLds& L, const bf16x8 (&qf)[2], f32x4 (&o)[4], float& m, float& l,
                                         float slope, int t, int kpos0, bool rowsel) {
    const int lane = tid__ & 63, quad = lane >> 4;
    const int row = lane >> 2, part = lane & 3;
    wave_qk(L, 0, qf);
    __syncthreads();
    float z[16];
    read_s16(L, row, part, z);
    float pm = -1e30f;
#pragma unroll
    for (int i = 0; i < 16; ++i) {
        const int dist = t - (kpos0 + part * 16 + i);
        bool valid = dist >= 0;
        if (MODE == 1) valid = valid && rowsel;
        if (MODE == 2) valid = valid && (dist < 512);
        z[i] = valid ? (z[i] * 0.125f - slope * (float)dist) : -1e30f;
        pm = fmaxf(pm, z[i]);
    }
    pm = row4_max(pm);
    const float mn = fmaxf(m, pm);
    const float alpha = __expf(m - mn);
    float ps = 0.f;
#pragma unroll
    for (int i = 0; i < 16; ++i) {
        z[i] = (z[i] > -1e29f) ? __expf(z[i] - mn) : 0.f;
        ps += z[i];
    }
    ps = row4_sum(ps);
    l = l * alpha + ps;
    m = mn;
    write_p16(L, row, part, z);
    float al[4];
#pragma unroll
    for (int r = 0; r < 4; ++r) al[r] = __shfl(alpha, (quad * 4 + r) * 4);
    __syncthreads();
#pragma unroll
    for (int dt = 0; dt < 4; ++dt)
#pragma unroll
        for (int r = 0; r < 4; ++r) o[dt][r] *= al[r];
    wave_pv(L, 0, o);
    __syncthreads();
}

__device__ __forceinline__ void item_nsa(const Params& p, int it) {
    const int tid = tid__, lane = tid & 63, wave = tid >> 6, quad = lane >> 4, c = lane & 15;
    const int qb = 63 - (it >> 4), bg = it & 15, g = bg & 1, b = bg >> 1;
    const int t0 = qb * 64;
    AttnLds L = attn_lds();
    const int row = lane >> 2, part = lane & 3;
    const int t = t0 + wave * 16 + row;
    const long tokbase = (long)b * SS + t0 + wave * 16;
    float* ynf = p.ynf;
    const int nct = (2 * qb + 2 > 64) ? 2 : 1;
    const int nv = (t + 1) >> 5;
    __syncthreads();
    for (int ct = 0; ct < nct; ++ct) {
        load_k_tile(L.K, ct * 64, p.kvc + ((long)(b * 2 + g) * 128 + ct * 64) * 64, 64);
        load_v_tile(L.Vt, ct * 64, p.kvc + ((long)2048 + (b * 2 + g) * 128 + ct * 64) * 64, 64);
    }
    __syncthreads();
    float imp[2][8];
#pragma unroll
    for (int a = 0; a < 2; ++a)
#pragma unroll
        for (int j = 0; j < 8; ++j) imp[a][j] = 0.f;
#pragma unroll 1
    for (int r = 0; r < 4; ++r) {
        const float slope = exp2f(-(float)(g * 4 + r + 1));
        float m = -1e30f, l = 0.f;
        bf16x8 qfa[2];
        {
            const u16* gq = p.yb + (tokbase + c) * NIN + C_NQ + (g * 4 + r) * 64 + quad * 8;
            qfa[0] = *(const bf16x8*)gq;
            qfa[1] = *(const bf16x8*)(gq + 32);
        }
        for (int ct = 0; ct < nct; ++ct) {
            wave_qk(L, ct * 64, qfa);
            __syncthreads();
            float z[16];
            read_s16(L, row, part, z);
            float pm = -1e30f;
#pragma unroll
            for (int i = 0; i < 16; ++i) {
                const int cc = ct * 64 + part * 16 + i;
                const bool valid = cc < nv;
                z[i] = valid ? (z[i] * 0.125f - slope * (float)(t - (cc * 32 + 31))) : -1e30f;
                pm = fmaxf(pm, z[i]);
            }
            pm = row4_max(pm);
            const float mn = fmaxf(m, pm);
            float ps = 0.f;
#pragma unroll
            for (int i = 0; i < 16; ++i) ps += (z[i] > -1e29f) ? __expf(z[i] - mn) : 0.f;
            ps = row4_sum(ps);
            l = l * __expf(m - mn) + ps;
            m = mn;
            __syncthreads();
        }
        const float inv = (l > 0.f) ? 1.f / l : 0.f;
        f32x4 o[4];
#pragma unroll
        for (int dt = 0; dt < 4; ++dt) o[dt] = f32x4{0.f, 0.f, 0.f, 0.f};
#pragma unroll 1
        for (int ct = 0; ct < nct; ++ct) {
            wave_qk(L, ct * 64, qfa);
            __syncthreads();
            float z[16];
            read_s16(L, row, part, z);
#pragma unroll
            for (int i = 0; i < 16; ++i) {
                const int cc = ct * 64 + part * 16 + i;
                const bool valid = cc < nv;
                const float s = z[i] * 0.125f - slope * (float)(t - (cc * 32 + 31));
                z[i] = valid ? __expf(s - m) * inv : 0.f;
            }
            const float f0 = (ct == 0) ? 1.f : 0.f, f1 = 1.f - f0;
#pragma unroll
            for (int j = 0; j < 8; ++j) {
                const float pr = z[2 * j] + z[2 * j + 1];
                imp[0][j] += f0 * pr;
                imp[1][j] += f1 * pr;
            }
            write_p16(L, row, part, z);
            __syncthreads();
            wave_pv(L, ct * 64, o);
            __syncthreads();
        }
#pragma unroll
        for (int rr = 0; rr < 4; ++rr) {
            const long tok = tokbase + quad * 4 + rr;
            const float gt = sigmoidf_(bf2f(p.yb[tok * NIN + C_NG + (g * 4 + r) * 3 + 0]));
#pragma unroll
            for (int dt = 0; dt < 4; ++dt) ynf[tok * 512 + (g * 4 + r) * 64 + dt * 16 + c] = gt * o[dt][rr];
        }
    }
#pragma unroll
    for (int a = 0; a < 2; ++a)
#pragma unroll
        for (int j = 0; j < 8; ++j) L.S[row * SSTR + a * 32 + part * 8 + j] = imp[a][j];
    __syncthreads();
    unsigned long long un = 0ull;
#ifndef NSA_NOTOPK
#define NSA_NOTOPK 0
#endif
#pragma unroll 1
    for (int rr = 0; rr < (NSA_NOTOPK ? 0 : 16); ++rr) {
        float v = L.S[rr * SSTR + lane];
        const bool forced = (lane == 0) || (lane == qb) || (lane == qb - 1);
        const bool validb = lane <= qb;
        v = forced ? 1e6f : (validb ? v : -1e30f);
        int rank = 0;
#pragma unroll 8
        for (int i = 0; i < 64; ++i) {
            const float vi = __shfl(v, i);
            rank += ((vi > v) || (vi == v && i < lane)) ? 1 : 0;
        }
        const unsigned long long mk = __ballot((rank < 16) && validb);
        if (lane == 0) s_mask[wave][rr] = mk;
        un |= mk;
    }
    if (lane == 0) s_union[wave] = un;
    __syncthreads();
    const unsigned long long rowmask = s_mask[wave][row];
    unsigned long long umask;
    {
        const unsigned long long um_ = s_union[0] | s_union[1] | s_union[2] | s_union[3];
        const unsigned lo_ = __builtin_amdgcn_readfirstlane((unsigned)um_), hi_ = __builtin_amdgcn_readfirstlane((unsigned)(um_ >> 32));
        umask = ((unsigned long long)hi_ << 32) | lo_;
    }
#ifndef NSA_HPB
#define NSA_HPB 1
#endif
#ifndef NSA_NOBC
#define NSA_NOBC 0
#endif
#pragma unroll 1
    for (int hp = 0; hp < (NSA_NOBC ? 0 : 4 / NSA_HPB); ++hp) {
#pragma unroll 1
        for (int mode = 1; mode <= 2; ++mode) {
            f32x4 o[NSA_HPB][4];
            float m[NSA_HPB], l[NSA_HPB];
#pragma unroll
            for (int r = 0; r < NSA_HPB; ++r) {
                m[r] = -1e30f; l[r] = 0.f;
#pragma unroll
                for (int dt = 0; dt < 4; ++dt) o[r][dt] = f32x4{0.f, 0.f, 0.f, 0.f};
            }
            const int kb_lo = (mode == 1) ? 0 : ((qb - 8 > 0) ? qb - 8 : 0);
            const int colk = (mode == 1) ? C_KS : C_KW, colv = (mode == 1) ? C_VS : C_VW;
            for (int kb = kb_lo; kb <= qb; ++kb) {
                if (mode == 1 && !((umask >> kb) & 1ull)) continue;
                const u16* kbase = p.yb + (long)(b * SS + kb * 64) * NIN + g * 64;
                bf16x8 qf[NSA_HPB][2];
#pragma unroll
                for (int r = 0; r < NSA_HPB; ++r) {
                    const u16* gq = p.yb + (tokbase + c) * NIN + C_NQ + (g * 4 + hp * NSA_HPB + r) * 64 + quad * 8;
                    qf[r][0] = *(const bf16x8*)gq;
                    qf[r][1] = *(const bf16x8*)(gq + 32);
                }
                load_k_tile(L.K, 0, kbase + colk, NIN);
                load_v_tile(L.Vt, 0, kbase + colv, NIN);
                __syncthreads();
                const bool rowsel = (rowmask >> kb) & 1ull;
#pragma unroll
                for (int r = 0; r < NSA_HPB; ++r) {
                    const float slope = exp2f(-(float)(g * 4 + hp * NSA_HPB + r + 1));
                    if (mode == 1) nsa_step<1>(L, qf[r], o[r], m[r], l[r], slope, t, kb * 64, rowsel);
                    else nsa_step<2>(L, qf[r], o[r], m[r], l[r], slope, t, kb * 64, rowsel);
                }
            }
#pragma unroll
            for (int r = 0; r < NSA_HPB; ++r) {
                const int hh = g * 4 + hp * NSA_HPB + r;
#pragma unroll
                for (int rr = 0; rr < 4; ++rr) {
                    const long tok = tokbase + quad * 4 + rr;
                    const float lr = __shfl(l[r], (quad * 4 + rr) * 4);
                    const float gt = sigmoidf_(bf2f(p.yb[tok * NIN + C_NG + hh * 3 + mode])) / lr;
#pragma unroll
                    for (int dt = 0; dt < 4; ++dt) {
                        const long oi = tok * 512 + hh * 64 + dt * 16 + c;
                        const float v = ynf[oi] + gt * o[r][dt][rr];
                        if (mode == 1) ynf[oi] = v;
                        else p.ynsa[oi] = f2bf(v);
                    }
                }
            }
        }
    }
}
__device__ __forceinline__ void phase_nsa(const Params& p, unsigned* ctr) {
    WorkQ q; q.init(ctr, tid__ == 0);
    for (;;) {
        int it = q.next();
        if (it >= 1024) break;
        item_nsa(p, it);
    }
}

__device__ __forceinline__ void phase_br(const Params& p, int l, unsigned* ctr) {
    const int tid = tid__;
    XQ q; q.init(ctr, 32 * 8, tid__ == 0);
    for (;;) {
        int it = q.next();
        if (it < 0) break;
        int mt, nt; xq_decode(it, 32, 8, mt, nt);
        const int m0 = mt * 128, n0 = nt * 128;
        const u16* ap[4]; const u16* bp[4];
        f32x4 acc[4][4];
        acc_zero(acc);
#pragma unroll
        for (int i = 0; i < 4; ++i) {
            int r = (tid >> 3) + 32 * i;
            ap[i] = p.ysb + (long)(m0 + r) * 512;
            bp[i] = p.wt_brs + ((long)l * 1024 + n0 + r) * 512;
        }
        gemm_main(acc, ap, bp, 512, KId());
        EPI_COORDS
#pragma unroll
        for (int i = 0; i < 4; ++i)
#pragma unroll
            for (int j = 0; j < 4; ++j) {
                const int m = m0 + EPI_M(j), n = n0 + EPI_N(i);
                const uint2 ga = *(const uint2*)(p.yb + (long)m * NIN + C_GSB + n);
                float4 o;
                o.x = sigmoidf_(bf2f((u16)(ga.x & 0xffff))) * acc[i][j][0];
                o.y = sigmoidf_(bf2f((u16)(ga.x >> 16))) * acc[i][j][1];
                o.z = sigmoidf_(bf2f((u16)(ga.y & 0xffff))) * acc[i][j][2];
                o.w = sigmoidf_(bf2f((u16)(ga.y >> 16))) * acc[i][j][3];
                *(float4*)(p.pre1 + (long)m * 1024 + n) = o;
            }
        acc_zero(acc);
#pragma unroll
        for (int i = 0; i < 4; ++i) {
            int r = (tid >> 3) + 32 * i;
            ap[i] = p.ynsa + (long)(m0 + r) * 512;
            bp[i] = p.wt_brn + ((long)l * 1024 + n0 + r) * 512;
        }
        gemm_main(acc, ap, bp, 512, KId());
#pragma unroll
        for (int i = 0; i < 4; ++i)
#pragma unroll
            for (int j = 0; j < 4; ++j) {
                const int m = m0 + EPI_M(j), n = n0 + EPI_N(i);
                const uint2 gb = *(const uint2*)(p.yb + (long)m * NIN + C_GNSA + n);
                const float4 st = *(const float4*)(p.pre1 + (long)m * 1024 + n);
                st_bf4(p.merged + (long)m * 1024 + n,
                       st.x + sigmoidf_(bf2f((u16)(gb.x & 0xffff))) * acc[i][j][0],
                       st.y + sigmoidf_(bf2f((u16)(gb.x >> 16))) * acc[i][j][1],
                       st.z + sigmoidf_(bf2f((u16)(gb.y & 0xffff))) * acc[i][j][2],
                       st.w + sigmoidf_(bf2f((u16)(gb.y >> 16))) * acc[i][j][3]);
            }
    }
}
__device__ __forceinline__ void phase_wo(const Params& p, int l, unsigned* ctr) {
    const int tid = tid__;
    XQ q; q.init(ctr, 32 * 8, tid__ == 0);
    for (;;) {
        int it = q.next();
        if (it < 0) break;
        int mt, nt; xq_decode(it, 32, 8, mt, nt);
        const int m0 = mt * 128, n0 = nt * 128;
        const u16* ap[4]; const u16* bp[4];
        f32x4 acc[4][4]; acc_zero(acc);
#pragma unroll
        for (int i = 0; i < 4; ++i) {
            int r = (tid >> 3) + 32 * i;
            ap[i] = p.merged + (long)(m0 + r) * 1024;
            bp[i] = p.wt_o + ((long)l * 1024 + n0 + r) * 1024;
        }
        gemm_main(acc, ap, bp, 1024, KId());
        EPI_COORDS
#pragma unroll
        for (int i = 0; i < 4; ++i)
#pragma unroll
            for (int j = 0; j < 4; ++j) {
                const int m = m0 + EPI_M(j), n = n0 + EPI_N(i);
                const float4 hv = *(const float4*)(p.hf + (long)m * 1024 + n);
                float4 o;
                o.x = DN_ALPHA * hv.x + acc[i][j][0]; o.y = DN_ALPHA * hv.y + acc[i][j][1];
                o.z = DN_ALPHA * hv.z + acc[i][j][2]; o.w = DN_ALPHA * hv.w + acc[i][j][3];
                *(float4*)(p.pre1 + (long)m * 1024 + n) = o;
            }
    }
}
__device__ __forceinline__ float wave_sum(float v) {
#pragma unroll
    for (int s = 32; s >= 1; s >>= 1) v += __shfl_xor(v, s);
    return v;
}
__device__ __forceinline__ void phase_ln(const Params& p, int l, int mode, unsigned* ctr) {
    const int lane = tid__ & 63, wave = tid__ >> 6;
    const float* gam = (mode == 1 ? p.ln1_g : p.ln2_g) + l * 1024;
    const float* bet = (mode == 1 ? p.ln1_b : p.ln2_b) + l * 1024;
    WorkQ q; q.init(ctr, tid__ == 0);
    for (;;) {
        int it = q.next();
        if (it >= TT / 64) break;
        for (int rr = 0; rr < 16; ++rr) {
            const long row = (long)it * 64 + wave * 16 + rr;
            float v[16];
#pragma unroll
            for (int i = 0; i < 4; ++i) {
                const int col = i * 256 + lane * 4;
                float4 a;
                if (mode == 1) a = *(const float4*)(p.pre1 + row * 1024 + col);
                else {
                    a = *(const float4*)(p.h1f + row * 1024 + col);
                    a.x *= DN_ALPHA; a.y *= DN_ALPHA; a.z *= DN_ALPHA; a.w *= DN_ALPHA;
                    const uint2 pl = *(const uint2*)(p.ple + row * 1024 + col);
                    a.x += bf2f((u16)(pl.x & 0xffff)); a.y += bf2f((u16)(pl.x >> 16));
                    a.z += bf2f((u16)(pl.y & 0xffff)); a.w += bf2f((u16)(pl.y >> 16));
#pragma unroll
                    for (int s = 0; s < 4; ++s) {
                        const uint2 y = *(const uint2*)(p.y4 + (row * 4 + s) * 1024 + col);
                        a.x += bf2f((u16)(y.x & 0xffff)); a.y += bf2f((u16)(y.x >> 16));
                        a.z += bf2f((u16)(y.y & 0xffff)); a.w += bf2f((u16)(y.y >> 16));
                    }
                }
                v[i * 4 + 0] = a.x; v[i * 4 + 1] = a.y; v[i * 4 + 2] = a.z; v[i * 4 + 3] = a.w;
            }
            float s = 0.f;
#pragma unroll
            for (int i = 0; i < 16; ++i) s += v[i];
            const float mean = wave_sum(s) * (1.f / 1024.f);
            float s2 = 0.f;
#pragma unroll
            for (int i = 0; i < 16; ++i) { v[i] -= mean; s2 += v[i] * v[i]; }
            const float rstd = rsqrtf(wave_sum(s2) * (1.f / 1024.f) + 1e-5f);
#pragma unroll
            for (int i = 0; i < 4; ++i) {
                const int col = i * 256 + lane * 4;
                const float4 gg = *(const float4*)(gam + col), bb = *(const float4*)(bet + col);
                float4 y;
                y.x = v[i * 4 + 0] * rstd * gg.x + bb.x; y.y = v[i * 4 + 1] * rstd * gg.y + bb.y;
                y.z = v[i * 4 + 2] * rstd * gg.z + bb.z; y.w = v[i * 4 + 3] * rstd * gg.w + bb.w;
                if (mode == 1) {
                    *(float4*)(p.h1f + row * 1024 + col) = y;
                    const u16 h0 = f2bf(y.x), h1 = f2bf(y.y), h2 = f2bf(y.z), h3 = f2bf(y.w);
                    uint2 u; u.x = (unsigned)h0 | ((unsigned)h1 << 16); u.y = (unsigned)h2 | ((unsigned)h3 << 16);
                    *(uint2*)(p.h1b + row * 1024 + col) = u;
                    st_bf4(p.h1lo + row * 1024 + col, y.x - bf2f(h0), y.y - bf2f(h1), y.z - bf2f(h2), y.w - bf2f(h3));
                } else {
                    if (l == 3) *(float4*)(p.out + row * 1024 + col) = y;
                    else {
                        *(float4*)(p.hf + row * 1024 + col) = y;
                        st_bf4(p.hb + row * 1024 + col, y.x, y.y, y.z, y.w);
                    }
                }
            }
        }
    }
}
struct KRouter {
    long dlo;
    __device__ __forceinline__ long operator()(int k) const { return (k < 2048) ? (long)(k & 1023) : (dlo + (k - 2048)); }
};
__device__ __forceinline__ void phase_router_ple(const Params& p, int l, unsigned* ctr) {
    const int tid = tid__;
    XQ q; q.init(ctr, 32 * 9, tid__ == 0);
    for (;;) {
        int it = q.next();
        if (it < 0) break;
        int mt, nt; xq_decode(it, 32, 9, mt, nt);
        const u16* ap[4]; const u16* bp[4];
        if (nt == 8) {
            const int m0 = mt * 128;
            f32x4 acc[4][4]; acc_zero(acc);
#pragma unroll
            for (int i = 0; i < 4; ++i) {
                int r = (tid >> 3) + 32 * i;
                ap[i] = p.h1b + (long)(m0 + r) * 1024;
                bp[i] = p.wt_r + ((long)l * 32 + (r & 31)) * 3072;
            }
            KRouter kr; kr.dlo = (long)(p.h1lo - p.h1b);
            gemm_main(acc, ap, bp, 3072, kr);
            EPI_COORDS
#pragma unroll
            for (int i = 0; i < 4; ++i)
#pragma unroll
                for (int j = 0; j < 4; ++j) {
                    const int m = m0 + EPI_M(j), n = EPI_N(i);
                    if (n < 32) {
                        const float4 bb = *(const float4*)(p.b_router + l * 32 + n);
                        float4 o; o.x = acc[i][j][0] + bb.x; o.y = acc[i][j][1] + bb.y; o.z = acc[i][j][2] + bb.z; o.w = acc[i][j][3] + bb.w;
                        *(float4*)(p.logits + (long)m * 32 + n) = o;
                    }
                }
        } else {
            const int m0 = mt * 128, n0 = nt * 128;
            f32x4 acc[4][4];
            acc_zero(acc);
#pragma unroll
            for (int i = 0; i < 4; ++i) {
                int r = (tid >> 3) + 32 * i;
                ap[i] = p.pb + ((long)l * TT + m0 + r) * 256;
                bp[i] = p.wt_pp + ((long)l * 1024 + n0 + r) * 256;
            }
            gemm_main(acc, ap, bp, 256, KId());
            EPI_COORDS
#pragma unroll
            for (int i = 0; i < 4; ++i)
#pragma unroll
                for (int j = 0; j < 4; ++j) {
                    const int m = m0 + EPI_M(j), n = n0 + EPI_N(i);
                    float4 o; o.x = acc[i][j][0]; o.y = acc[i][j][1]; o.z = acc[i][j][2]; o.w = acc[i][j][3];
                    *(float4*)(p.pre1 + (long)m * 1024 + n) = o;
                }
            acc_zero(acc);
#pragma unroll
            for (int i = 0; i < 4; ++i) {
                int r = (tid >> 3) + 32 * i;
                ap[i] = p.h1b + (long)(m0 + r) * 1024;
                bp[i] = p.wt_pg + ((long)l * 1024 + n0 + r) * 1024;
            }
            gemm_main(acc, ap, bp, 1024, KId());
#pragma unroll
            for (int i = 0; i < 4; ++i)
#pragma unroll
                for (int j = 0; j < 4; ++j) {
                    const int m = m0 + EPI_M(j), n = n0 + EPI_N(i);
                    const float4 st = *(const float4*)(p.pre1 + (long)m * 1024 + n);
                    st_bf4(p.ple + (long)m * 1024 + n, sigmoidf_(acc[i][j][0]) * st.x, sigmoidf_(acc[i][j][1]) * st.y,
                           sigmoidf_(acc[i][j][2]) * st.z, sigmoidf_(acc[i][j][3]) * st.w);
                }
        }
    }
}
__device__ __forceinline__ void phase_route(const Params& p, int l, unsigned* ctr) {
    const int tid = tid__;
    int* s_cnt = s_misc;
    int* s_base = s_misc + 32;
    WorkQ q; q.init(ctr, tid__ == 0);
    for (;;) {
        int it = q.next();
        if (it >= TT / 256) break;
        if (tid < 32) s_cnt[tid] = 0;
        __syncthreads();
        const int t = it * 256 + tid;
        float lg[32];
#pragma unroll
        for (int i = 0; i < 8; ++i) {
            const float4 v = *(const float4*)(p.logits + (long)t * 32 + i * 4);
            lg[i * 4 + 0] = v.x; lg[i * 4 + 1] = v.y; lg[i * 4 + 2] = v.z; lg[i * 4 + 3] = v.w;
        }
        unsigned taken = 0u;
        int ek[4]; float vk[4];
#pragma unroll
        for (int k = 0; k < 4; ++k) {
            float best = -3.0e38f; int bi = 0;
#pragma unroll
            for (int e = 0; e < 32; ++e) {
                const bool ok = !((taken >> e) & 1u) && (lg[e] > best);
                best = ok ? lg[e] : best;
                bi = ok ? e : bi;
            }
            taken |= 1u << bi;
            ek[k] = bi; vk[k] = best;
        }
        float wsum = 0.f;
        float v0 = -3.0e38f, v1 = 0.f, v2 = 0.f, v3 = 0.f;
#pragma unroll
        for (int e = 0; e < 32; ++e) {
            v0 = (e == ek[0]) ? lg[e] : v0;
            v1 = (e == ek[1]) ? lg[e] : v1;
            v2 = (e == ek[2]) ? lg[e] : v2;
            v3 = (e == ek[3]) ? lg[e] : v3;
        }
        vk[0] = 1.f; vk[1] = __expf(v1 - v0); vk[2] = __expf(v2 - v0); vk[3] = __expf(v3 - v0);
        wsum = vk[0] + vk[1] + vk[2] + vk[3];
        const float winv = 1.f / wsum;
        int lp[4];
#pragma unroll
        for (int k = 0; k < 4; ++k) lp[k] = atomicAdd(&s_cnt[ek[k]], 1);
        __syncthreads();
        if (tid < 32) s_base[tid] = (int)atomicAdd(&p.ecnt[l * 32 + tid], (unsigned)s_cnt[tid]);
        __syncthreads();
#pragma unroll
        for (int k = 0; k < 4; ++k) {
            const long idx = (long)ek[k] * TT + s_base[ek[k]] + lp[k];
            p.ent_id[idx] = t * 4 + k;
            p.ent_w[idx] = vk[k] * winv;
        }
    }
}
__device__ __forceinline__ void moe_prefix(const Params& p, int l) {
    __syncthreads();
    if (tid__ == 0) {
        int acc = 0;
        for (int e = 0; e < 32; ++e) {
            const int n = (int)__hip_atomic_load(&p.ecnt[l * 32 + e], __ATOMIC_RELAXED, __HIP_MEMORY_SCOPE_AGENT);
            s_misc[e] = acc;
            s_misc[40 + e] = n;
            acc += (n + 127) >> 7;
        }
        s_misc[32] = acc;
    }
    __syncthreads();
}
__device__ __forceinline__ void phase_moe_gu(const Params& p, int l, unsigned* ctr) {
    const int tid = tid__;
    moe_prefix(p, l);
    const int mtotal = s_misc[32];
    const int mpx = (((mtotal + 7) >> 3) + 7) & ~7;
    XQ q; q.init(ctr, mpx * 16, tid__ == 0);
    for (;;) {
        int it = q.next();
        if (it < 0) break;
        int mtg, nt; xq_decode(it, mpx, 16, mtg, nt);
        if (mtg >= mtotal) continue;
        int e = 0;
        for (int i = 1; i < 32; ++i) e = (s_misc[i] <= mtg) ? i : e;
        const int mt = mtg - s_misc[e], ne = s_misc[40 + e];
        const u16* ap[4]; const u16* bp[4];
#pragma unroll
        for (int i = 0; i < 4; ++i) {
            const int r = (tid >> 3) + 32 * i;
            int idx = mt * 128 + r; if (idx > ne - 1) idx = ne - 1;
            const int tok = p.ent_id[(long)e * TT + idx] >> 2;
            ap[i] = p.h1b + (long)tok * 1024;
            const int isup = (r >> 5) & 1, col = (r >> 6) * 32 + (r & 31);
            bp[i] = p.wt_gu + (((long)l * 32 + e) * 2048 + isup * 1024 + nt * 64 + col) * 1024;
        }
        f32x4 acc[4][4]; acc_zero(acc);
        gemm_main(acc, ap, bp, 1024, KId());
        EPI_COORDS
        const float* bg = p.b_gu + ((long)l * 32 + e) * 2048;
#pragma unroll
        for (int i = 0; i < 2; ++i)
#pragma unroll
            for (int j = 0; j < 4; ++j) {
                const long rowa = (long)mtg * 128 + EPI_M(j);
                const int col = nt * 64 + wn_ * 32 + i * 16 + (lane_ >> 4) * 4;
                float v[4];
#pragma unroll
                for (int r = 0; r < 4; ++r) {
                    float gate = acc[i][j][r] + bg[col + r];
                    float up = acc[i + 2][j][r] + bg[1024 + col + r];
                    gate = fminf(gate, 7.f);
                    up = fminf(fmaxf(up, -7.f), 7.f);
                    v[r] = (up + 1.f) * gate * sigmoidf_(1.702f * gate);
                }
                st_bf4(p.act + rowa * 1024 + col, v[0], v[1], v[2], v[3]);
            }
    }
}
__device__ __forceinline__ void phase_moe_down(const Params& p, int l, unsigned* ctr) {
    const int tid = tid__;
    moe_prefix(p, l);
    const int mtotal = s_misc[32];
    const int mpx = (((mtotal + 7) >> 3) + 7) & ~7;
    XQ q; q.init(ctr, mpx * 8, tid__ == 0);
    for (;;) {
        int it = q.next();
        if (it < 0) break;
        int mtg, nt; xq_decode(it, mpx, 8, mtg, nt);
        if (mtg >= mtotal) continue;
        int e = 0;
        for (int i = 1; i < 32; ++i) e = (s_misc[i] <= mtg) ? i : e;
        const int mt = mtg - s_misc[e], ne = s_misc[40 + e];
        const u16* ap[4]; const u16* bp[4];
#pragma unroll
        for (int i = 0; i < 4; ++i) {
            const int r = (tid >> 3) + 32 * i;
            ap[i] = p.act + ((long)mtg * 128 + r) * 1024;
            bp[i] = p.wt_dn + (((long)l * 32 + e) * 1024 + nt * 128 + r) * 1024;
        }
        f32x4 acc[4][4]; acc_zero(acc);
        gemm_main(acc, ap, bp, 1024, KId());
        EPI_COORDS
        const float* bd = p.b_down + ((long)l * 32 + e) * 1024;
#pragma unroll
        for (int j = 0; j < 4; ++j) {
            const int idx = mt * 128 + EPI_M(j);
            if (idx < ne) {
                const int id = p.ent_id[(long)e * TT + idx];
                const float cw = p.ent_w[(long)e * TT + idx];
#pragma unroll
                for (int i = 0; i < 4; ++i) {
                    const int n = nt * 128 + EPI_N(i);
                    const float4 bb = *(const float4*)(bd + n);
                    st_bf4(p.y4 + (long)id * 1024 + n, cw * (acc[i][j][0] + bb.x), cw * (acc[i][j][1] + bb.y),
                           cw * (acc[i][j][2] + bb.z), cw * (acc[i][j][3] + bb.w));
                }
            }
        }
    }
}

};
#ifndef PH0_EN
#define PH0_EN 1
#endif
__device__ __forceinline__ void run_phase(const Params& p, int ph, int coff, int wv) {
    unsigned* ctr = p.ctr + (ph + coff) * 8;
    Ctx cx;
    {
        int t_ = wv * 64 + (int)__lane_id();
        asm volatile("" : "+v"(t_));
        cx.tid__ = t_;
    }
    if (ph == 0) { if (PH0_EN) cx.phase_prologue(p, ctr); return; }
    const int l = (ph - 1) / NPH_LAYER, s = (ph - 1) % NPH_LAYER;
#ifndef ONLY_S
#define ONLY_S -1
#endif
#ifndef SKIP_S
#define SKIP_S -1
#endif
#define PH_EN(x) ((ONLY_S < 0 || ONLY_S == (x)) && SKIP_S != (x))
    if (PH_EN(0) && s == 0) cx.phase_gemm_in(p, l, ctr);
    if (PH_EN(1) && s == 1) cx.phase_cmp1_sb(p, l, ctr);
    if (PH_EN(2) && s == 2) cx.phase_cmp2(p, l, ctr);
    if (PH_EN(3) && s == 3) cx.phase_nsa(p, ctr);
    if (PH_EN(4) && s == 4) cx.phase_br(p, l, ctr);
    if (PH_EN(5) && s == 5) cx.phase_wo(p, l, ctr);
    if (PH_EN(6) && s == 6) cx.phase_ln(p, l, 1, ctr);
    if (PH_EN(7) && s == 7) cx.phase_router_ple(p, l, ctr);
    if (PH_EN(8) && s == 8) cx.phase_route(p, l, ctr);
    if (PH_EN(9) && s == 9) cx.phase_moe_gu(p, l, ctr);
    if (PH_EN(10) && s == 10) cx.phase_moe_down(p, l, ctr);
    if (PH_EN(11) && s == 11) cx.phase_ln(p, l, 2, ctr);
}

__global__ void __launch_bounds__(256, 2) mega_kernel(Params p, int ph0, int ph1) {
    __shared__ uint4 xb_words;
    const int wv = __builtin_amdgcn_readfirstlane((int)(threadIdx.x >> 6));
    const bool t0 = (threadIdx.x == 0);
    if (t0) xb_words = make_uint4(0u, 0u, 0u, 0u);
    __syncthreads();
    __shared__ Params s_p;
    if (t0) {
        const void* const* src_ = (const void* const*)&p;
        const void** dst_ = (const void**)&s_p;
#pragma unroll
        for (int i = 0; i < (int)(sizeof(Params) / sizeof(void*)); ++i) dst_[i] = src_[i];
    }
    __syncthreads();
    XcdBarrier bar = xcd_barrier_post(p.bar, (volatile LAS unsigned*)&xb_words, t0);
    for (int ph = ph0; ph < ph1; ++ph) {
        const bool t0p = (wv == 0) && (__lane_id() == 0);
        if (ph > ph0) xcd_barrier(bar, t0p);
        asm volatile("" ::: "memory");
        run_phase(s_p, ph, 0, wv);
#if REP_MASK
        if (ph > 0 && ((REP_MASK >> ((ph - 1) % NPH_LAYER)) & 1)) {
            xcd_barrier(bar, t0p);
            asm volatile("" ::: "memory");
            run_phase(s_p, ph, 64, wv);
        }
#endif
    }
}

#ifndef REP_MASK
#define REP_MASK 0
#endif
#ifndef MK_SPLIT
#define MK_SPLIT 0
#endif

extern "C" void kernel_launch(void* const* d_in, const int* in_sizes, int n_in, void* d_out, int out_size, void* d_ws,
                              size_t ws_size, hipStream_t stream) {
    static int grid = 0;
    if (!grid) {
        int dev = 0, cus = 0, per_cu = 0;
        hipGetDevice(&dev);
        hipDeviceGetAttribute(&cus, hipDeviceAttributeMultiprocessorCount, dev);
        hipOccupancyMaxActiveBlocksPerMultiprocessor(&per_cu, mega_kernel, 256, 0);
        if (per_cu < 1) per_cu = 1;
        grid = cus * (per_cu < 2 ? per_cu : 2);
    }
    Params p;
    memset(&p, 0, sizeof(p));
    const float** pin = (const float**)&p;
    for (int i = 0; i < 21; ++i) pin[i] = (const float*)d_in[i];
    p.out = (float*)d_out;
    char* w = (char*)d_ws;
    size_t off = 0;
    auto take = [&](size_t bytes) { char* r = w + off; off += (bytes + 255) & ~(size_t)255; return r; };
    const size_t sync_bytes = (XCD_BAR_WORDS + 1024 + 128) * sizeof(unsigned);
    p.bar = (unsigned*)take(sync_bytes);
    p.ctr = p.bar + XCD_BAR_WORDS;
    p.ecnt = p.ctr + 1024;
    p.wt_in = (u16*)take((size_t)4 * NIN * 1024 * 2);
    p.wt_brs = (u16*)take((size_t)4 * 512 * 1024 * 2);
    p.wt_brn = (u16*)take((size_t)4 * 512 * 1024 * 2);
    p.wt_o = (u16*)take((size_t)4 * 1024 * 1024 * 2);
    p.wt_pg = (u16*)take((size_t)4 * 1024 * 1024 * 2);
    p.wt_pp = (u16*)take((size_t)4 * 256 * 1024 * 2);
    p.wt_gu = (u16*)take((size_t)128 * 2048 * 1024 * 2);
    p.wt_dn = (u16*)take((size_t)128 * 1024 * 1024 * 2);
    p.wt_c1 = (u16*)take((size_t)8 * 128 * 2048 * 2);
    p.wt_c2 = (u16*)take((size_t)8 * 64 * 128 * 2);
    p.wt_r = (u16*)take((size_t)4 * 32 * 3072 * 2);
    p.cbias = (float*)take(1024 * 4);
    p.hf = (float*)take((size_t)TT * 1024 * 4);
    p.pre1 = (float*)take((size_t)TT * 1024 * 4);
    p.h1f = (float*)take((size_t)TT * 1024 * 4);
    p.logits = (float*)take((size_t)TT * 32 * 4);
    p.ynf = (float*)take((size_t)TT * 512 * 4);
    p.ent_w = (float*)take((size_t)32 * TT * 4);
    p.hb = (u16*)take((size_t)TT * 1024 * 2);
    p.pb = (u16*)take((size_t)4 * TT * 256 * 2);
    p.yb = (u16*)take((size_t)TT * NIN * 2);
    p.ysb = (u16*)take((size_t)TT * 512 * 2);
    p.ynsa = (u16*)take((size_t)TT * 512 * 2);
    p.merged = (u16*)take((size_t)TT * 1024 * 2);
    p.h1b = (u16*)take((size_t)TT * 1024 * 2);
    p.h1lo = (u16*)take((size_t)TT * 1024 * 2);
    p.ple = (u16*)take((size_t)TT * 1024 * 2);
    p.hid = (u16*)take((size_t)2 * 2048 * 128 * 2);
    p.kvc = (u16*)take((size_t)2 * 2048 * 64 * 2);
    p.act = (u16*)take((size_t)(TT * 4 + 32 * 128) * 1024 * 2);
    p.y4 = (u16*)take((size_t)TT * 4 * 1024 * 2);
    p.ent_id = (int*)take((size_t)32 * TT * 4);
    if (off > ws_size) { fprintf(stderr, "workspace too small: need %zu have %zu\n", off, ws_size); return; }
    hipMemsetAsync(p.bar, 0, sync_bytes, stream);
#if MK_SPLIT
    for (int ph = 0; ph < NPHASE; ++ph) mega_kernel<<<dim3(grid), dim3(256), 0, stream>>>(p, ph, ph + 1);
#else
    mega_kernel<<<dim3(grid), dim3(256), 0, stream>>>(p, 0, NPHASE);
#endif
}
```

```cpp
#define NSA_HPB 2
#include <hip/hip_runtime.h>
#include <stdint.h>
#include <cstdio>
#include <cstring>
#include <cstdlib>
#include <vector>

#define XB_TMO      128
#define XB_XCNT(j)  (256  + 64 * (j))
#define XB_XSUB(j)  (1280 + 64 * (j))
#define XB_XGEN(j)  (2304 + 64 * (j))
#define XB_TOP      3328
#define XB_TOPGEN   3392
#define XCD_BAR_WORDS 3456
#define XB_SPIN_CAP (1u << 18)
#define LAS __attribute__((address_space(3)))

__device__ __forceinline__ unsigned xb_ld(unsigned* p)              { return __hip_atomic_load(p, __ATOMIC_RELAXED, __HIP_MEMORY_SCOPE_AGENT); }
__device__ __forceinline__ unsigned xb_add(unsigned* p, unsigned v) { return __hip_atomic_fetch_add(p, v, __ATOMIC_RELAXED, __HIP_MEMORY_SCOPE_AGENT); }
__device__ __forceinline__ unsigned xb_xcc_id() { return (unsigned)__builtin_amdgcn_s_getreg((3 << 11) | 20) & 0xFu; }
#define XB_SPIN(cond, bar) do { unsigned _sp = 0; while (cond) { __builtin_amdgcn_s_sleep(1); \
    if ((++_sp & 255u) == 0u) { if (xb_ld(&(bar)[XB_TMO])) break; if (_sp > XB_SPIN_CAP) { atomicAdd(&(bar)[XB_TMO], 1u); break; } } } } while (0)

struct XcdBarrier {
    unsigned* bar; unsigned x;
    volatile LAS unsigned* st;
};

__device__ __forceinline__ XcdBarrier xcd_barrier_post(unsigned* bar, volatile LAS unsigned* st, const bool xb_t0) {
    XcdBarrier b; b.bar = bar; b.x = xb_xcc_id(); b.st = st;
    if (xb_t0) (void)xb_add(&bar[XB_XCNT(b.x)], 1u);
    return b;
}
__device__ __forceinline__ void xcd_barrier_complete(unsigned* bar, unsigned x, unsigned& nloc, unsigned& nx) {
    const unsigned G = gridDim.x * gridDim.y * gridDim.z;
    unsigned sum, cnt, mine, sp = 0u;
    for (;;) {
        sum = 0u; cnt = 0u; mine = 0u;
#pragma unroll
        for (unsigned j = 0; j < 16; ++j) { const unsigned c = xb_ld(&bar[XB_XCNT(j)]); sum += c; cnt += (c > 0u) ? 1u : 0u; mine = (j == x) ? c : mine; }
        if (sum == G) break;
        __builtin_amdgcn_s_sleep(1);
        if ((++sp & 255u) == 0u) { if (xb_ld(&bar[XB_TMO])) break; if (sp > XB_SPIN_CAP) { atomicAdd(&bar[XB_TMO], 1u); break; } }
    }
    nloc = mine > 0u ? mine : 1u; nx = cnt > 0u ? cnt : 1u;
}

__device__ __forceinline__ void xcd_barrier(const XcdBarrier& b, const bool xb_t0) {
    asm volatile("s_waitcnt vmcnt(0)" ::: "memory");
    __syncthreads();
    if (xb_t0) {
        unsigned* bar = b.bar;
        __builtin_amdgcn_s_waitcnt(0);
        unsigned nloc = b.st[0], nx = b.st[1];
        if (nloc == 0u) { xcd_barrier_complete(bar, b.x, nloc, nx); b.st[0] = nloc; b.st[1] = nx; }
        const unsigned old = xb_add(&bar[XB_XSUB(b.x)], 1u);
        const unsigned gen = old / nloc;
        if (old + 1u == (gen + 1u) * nloc) {
            __builtin_amdgcn_fence(__ATOMIC_RELEASE, "agent");
            asm volatile("s_waitcnt vmcnt(0)" ::: "memory");
            const unsigned og = xb_add(&bar[XB_TOP], 1u);
            const unsigned tg = og / nx;
            if (og + 1u == (tg + 1u) * nx) xb_add(&bar[XB_TOPGEN], 1u);
            else XB_SPIN(xb_ld(&bar[XB_TOPGEN]) == tg, bar);
            __builtin_amdgcn_fence(__ATOMIC_ACQUIRE, "agent");
            xb_add(&bar[XB_XGEN(b.x)], 1u);
            asm volatile("s_waitcnt vmcnt(0)" ::: "memory");
        } else {
            XB_SPIN(xb_ld(&bar[XB_XGEN(b.x)]) == gen, bar);
            __builtin_amdgcn_fence(__ATOMIC_ACQUIRE, "agent");
            asm volatile("s_waitcnt vmcnt(0)" ::: "memory");
        }
    }
    __syncthreads();
}


#ifndef REP_MASK
#define REP_MASK 0
#endif
typedef unsigned short u16;
typedef __attribute__((ext_vector_type(8))) short bf16x8;
typedef __attribute__((ext_vector_type(4))) float f32x4;
typedef __attribute__((ext_vector_type(4))) unsigned u32x4;
#define MFMA(a, b, c) __builtin_amdgcn_mfma_f32_16x16x32_bf16(a, b, c, 0, 0, 0)

#define TT 32768
#define SS 4096
#define DD 1024
#define NIN 4888
#define C_SBQ 0
#define C_SBK 512
#define C_SBV 1024
#define C_NQ 1536
#define C_KC 2048
#define C_VC 2176
#define C_KS 2304
#define C_VS 2432
#define C_KW 2560
#define C_VW 2688
#define C_NG 2816
#define C_GSB 2840
#define C_GNSA 3864
#define DN_ALPHA 1.681792830507429f
#define NPH_LAYER 12
#define NPHASE (1 + 4 * NPH_LAYER)
#define KSTR 72
#define VSTR 136
#define SSTR 68

struct Params {
    const float *x, *p, *w_in, *w_cmp1, *w_cmp2, *pe_cmp, *w_br_sb, *w_br_nsa, *w_o, *ln1_g, *ln1_b, *ln2_g, *ln2_b,
        *w_router, *b_router, *w_gu, *b_gu, *w_down, *b_down, *w_ple_gate, *w_ple_proj;
    float* out;
    unsigned *bar, *ctr, *ecnt;
    u16 *wt_in, *wt_brs, *wt_brn, *wt_o, *wt_pg, *wt_pp, *wt_gu, *wt_dn, *wt_c1, *wt_c2, *wt_r;
    float *cbias, *hf, *pre1, *h1f, *logits, *ynf, *ent_w;
    u16 *hb, *pb, *yb, *ysb, *ynsa, *merged, *h1b, *h1lo, *ple, *hid, *kvc, *act, *y4;
    int* ent_id;
};

__device__ __forceinline__ u16 f2bf(float f) {
    unsigned u = __float_as_uint(f);
    u += 0x7fffu + ((u >> 16) & 1u);
    return (u16)(u >> 16);
}
__device__ __forceinline__ float bf2f(u16 h) { return __uint_as_float(((unsigned)h) << 16); }
__device__ __forceinline__ void st_bf4(u16* p, float a, float b, float c, float d) {
    uint2 u;
    u.x = (unsigned)f2bf(a) | ((unsigned)f2bf(b) << 16);
    u.y = (unsigned)f2bf(c) | ((unsigned)f2bf(d) << 16);
    *(uint2*)p = u;
}
__device__ __forceinline__ float sigmoidf_(float x) { return 1.f / (1.f + __expf(-x)); }

__shared__ __attribute__((aligned(16))) unsigned char g_smem[62464];
__shared__ int s_item;
__shared__ int s_misc[80];
__shared__ unsigned long long s_mask[4][16];
__shared__ unsigned long long s_union[4];

struct WorkQ {
    unsigned* ctr;
    int nxt;
    bool t0;
    __device__ __forceinline__ void init(unsigned* c, bool t0_) {
        ctr = c;
        nxt = 0;
        t0 = t0_;
        if (t0) nxt = (int)atomicAdd(ctr, 1u);
    }
    __device__ __forceinline__ int next() {
        __syncthreads();
        if (t0) s_item = nxt;
        __syncthreads();
        int it = s_item;
        if (t0) nxt = (int)atomicAdd(ctr, 1u);
        return it;
    }
};


struct XQ {
    unsigned* ctr;
    int per, x0, k, nxt;
    bool t0;
    __device__ __forceinline__ void init(unsigned* c, int per_, bool t0_) {
        ctr = c; per = per_; k = 0; nxt = 0; t0 = t0_;
        x0 = (int)(xb_xcc_id() & 7u);
        if (t0) nxt = (int)atomicAdd(&ctr[x0], 1u);
    }
    __device__ __forceinline__ int next() {
        __syncthreads();
        if (t0) {
            int v = nxt;
            while (v >= per && k < 8) {
                ++k;
                if (k < 8) v = (int)atomicAdd(&ctr[(x0 + k) & 7], 1u);
            }
            if (k < 8) {
                s_item = ((x0 + k) & 7) * per + v;
                nxt = (int)atomicAdd(&ctr[(x0 + k) & 7], 1u);
            } else s_item = -1;
        }
        __syncthreads();
        return s_item;
    }
};
__device__ __forceinline__ void xq_decode(int item, int mpx, int NT, int& mt, int& nt) {
    const int per = mpx * NT;
    const int q = item / per, idx = item - q * per;
    const int sm = idx / (8 * NT), rem = idx - sm * (8 * NT);
    nt = rem >> 3;
    mt = q * mpx + sm * 8 + (rem & 7);
}
struct Ctx {
    int tid__;
struct KId {
    __device__ __forceinline__ long operator()(int k) const { return k; }
};
template <class KOA>
__device__ __forceinline__ void gemm_main(f32x4 (&acc)[4][4], const u16* (&ap)[4], const u16* (&bp)[4], int K, KOA koa) {
    u16* sA = (u16*)g_smem;
    u16* sB = sA + 128 * KSTR;
    const int tid = tid__, lane = tid & 63, wave = tid >> 6;
    const int wn = wave & 1, wm = wave >> 1;
    const int kc = (tid & 7) * 8;
    const int lrow = tid >> 3;
    u32x4 ra[4], rb[4];
    {
        const long oa = koa(kc);
#pragma unroll
        for (int i = 0; i < 4; ++i) {
            ra[i] = *(const u32x4*)(ap[i] + oa);
            rb[i] = *(const u32x4*)(bp[i] + kc);
        }
    }
    for (int k0 = 0; k0 < K; k0 += 64) {
        __syncthreads();
#pragma unroll
        for (int i = 0; i < 4; ++i) {
            *(u32x4*)(sA + (lrow + 32 * i) * KSTR + kc) = ra[i];
            *(u32x4*)(sB + (lrow + 32 * i) * KSTR + kc) = rb[i];
        }
        __syncthreads();
        if (k0 + 64 < K) {
            const long oa = koa(k0 + 64 + kc);
#pragma unroll
            for (int i = 0; i < 4; ++i) {
                ra[i] = *(const u32x4*)(ap[i] + oa);
                rb[i] = *(const u32x4*)(bp[i] + (k0 + 64 + kc));
            }
        }
#pragma unroll
        for (int ks = 0; ks < 2; ++ks) {
            bf16x8 af[4], bfr[4];
#pragma unroll
            for (int j = 0; j < 4; ++j)
                af[j] = *(const bf16x8*)(sA + (wm * 64 + j * 16 + (lane & 15)) * KSTR + ks * 32 + (lane >> 4) * 8);
#pragma unroll
            for (int i = 0; i < 4; ++i)
                bfr[i] = *(const bf16x8*)(sB + (wn * 64 + i * 16 + (lane & 15)) * KSTR + ks * 32 + (lane >> 4) * 8);
#pragma unroll
            for (int i = 0; i < 4; ++i)
#pragma unroll
                for (int j = 0; j < 4; ++j) acc[i][j] = MFMA(bfr[i], af[j], acc[i][j]);
        }
    }
}
__device__ __forceinline__ void acc_zero(f32x4 (&acc)[4][4]) {
#pragma unroll
    for (int i = 0; i < 4; ++i)
#pragma unroll
        for (int j = 0; j < 4; ++j) acc[i][j] = f32x4{0.f, 0.f, 0.f, 0.f};
}
#define EPI_COORDS                                         \
    const int lane_ = tid__ & 63, wave_ = tid__ >> 6; \
    const int wn_ = wave_ & 1, wm_ = wave_ >> 1;
#define EPI_M(j) (wm_ * 64 + (j) * 16 + (lane_ & 15))
#define EPI_N(i) (wn_ * 64 + (i) * 16 + (lane_ >> 4) * 4)

__device__ __forceinline__ void xjob(const Params& p, int j, const float*& src, u16*& dst, int& nb, int& K, int& N) {
    switch (j) {
        case 0: src = p.w_in; dst = p.wt_in; nb = 4; K = 1024; N = NIN; break;
        case 1: src = p.w_br_sb; dst = p.wt_brs; nb = 4; K = 512; N = 1024; break;
        case 2: src = p.w_br_nsa; dst = p.wt_brn; nb = 4; K = 512; N = 1024; break;
        case 3: src = p.w_o; dst = p.wt_o; nb = 4; K = 1024; N = 1024; break;
        case 4: src = p.w_ple_gate; dst = p.wt_pg; nb = 4; K = 1024; N = 1024; break;
        case 5: src = p.w_ple_proj; dst = p.wt_pp; nb = 4; K = 256; N = 1024; break;
        case 6: src = p.w_gu; dst = p.wt_gu; nb = 128; K = 1024; N = 2048; break;
        case 7: src = p.w_down; dst = p.wt_dn; nb = 128; K = 1024; N = 1024; break;
        case 8: src = p.w_cmp1; dst = p.wt_c1; nb = 8; K = 2048; N = 128; break;
        default: src = p.w_cmp2; dst = p.wt_c2; nb = 8; K = 128; N = 64; break;
    }
}
__device__ __forceinline__ int xjob_tiles(int nb, int K, int N) { return nb * (K / 128) * ((N + 63) / 64); }

__device__ __forceinline__ void phase_prologue(const Params& p, unsigned* ctr) {
    const int tid = tid__;
    int ntr = 0;
    for (int j = 0; j < 10; ++j) {
        const float* s; u16* d; int nb, K, N;
        xjob(p, j, s, d, nb, K, N);
        ntr += xjob_tiles(nb, K, N);
    }
    const int n_x = TT * DD / 8192, n_p = 4 * TT * 256 / 8192, n_r = 16, n_b = 16;
    const int total = ntr + n_x + n_p + n_r + n_b;
    float* st = (float*)g_smem;
    WorkQ q; q.init(ctr, tid__ == 0);
    for (;;) {
        int it = q.next();
        if (it >= total) break;
        it = (it < n_b + n_r) ? (ntr + n_x + n_p + (it < n_b ? n_r + it : it - n_b)) : it - (n_b + n_r);
        if (it < ntr) {
            const float* src = nullptr; u16* dst = nullptr; int nb = 0, K = 0, N = 0;
            int rem = it;
            for (int j = 0; j < 10; ++j) {
                xjob(p, j, src, dst, nb, K, N);
                int nt = xjob_tiles(nb, K, N);
                if (rem < nt) break;
                rem -= nt;
            }
            const int ktn = K / 128, ntn = (N + 63) / 64;
            const int tpm = ktn * ntn;
            const int b = rem / tpm; rem -= b * tpm;
            const int kt = rem % ktn, nt = rem / ktn;
            src += (long)b * K * N; dst += (long)b * K * N;
            const int k0 = kt * 128, n0 = nt * 64;
            float4 v[8];
#pragma unroll
            for (int i = 0; i < 8; ++i) {
                int k = (tid >> 4) + 16 * i, n = (tid & 15) * 4;
                v[i] = make_float4(0.f, 0.f, 0.f, 0.f);
                if (n0 + n < N) v[i] = *(const float4*)(src + (long)(k0 + k) * N + n0 + n);
            }
#pragma unroll
            for (int i = 0; i < 8; ++i) {
                int k = (tid >> 4) + 16 * i, n = (tid & 15) * 4;
                st[k * 65 + n + 0] = v[i].x; st[k * 65 + n + 1] = v[i].y; st[k * 65 + n + 2] = v[i].z; st[k * 65 + n + 3] = v[i].w;
            }
            __syncthreads();
#pragma unroll
            for (int i = 0; i < 4; ++i) {
                int n = (tid >> 4) + 16 * i, k8 = (tid & 15) * 8;
                if (n0 + n < N) {
                    uint4 u;
                    u.x = (unsigned)f2bf(st[(k8 + 0) * 65 + n]) | ((unsigned)f2bf(st[(k8 + 1) * 65 + n]) << 16);
                    u.y = (unsigned)f2bf(st[(k8 + 2) * 65 + n]) | ((unsigned)f2bf(st[(k8 + 3) * 65 + n]) << 16);
                    u.z = (unsigned)f2bf(st[(k8 + 4) * 65 + n]) | ((unsigned)f2bf(st[(k8 + 5) * 65 + n]) << 16);
                    u.w = (unsigned)f2bf(st[(k8 + 6) * 65 + n]) | ((unsigned)f2bf(st[(k8 + 7) * 65 + n]) << 16);
                    *(uint4*)(dst + (long)(n0 + n) * K + k0 + k8) = u;
                }
            }
        } else if (it < ntr + n_x + n_p) {
            int e = it - ntr;
            const float* src; u16* db; float* df = nullptr;
            if (e < n_x) { src = p.x + (long)e * 8192; db = p.hb + (long)e * 8192; df = p.hf + (long)e * 8192; }
            else { e -= n_x; src = p.p + (long)e * 8192; db = p.pb + (long)e * 8192; }
#pragma unroll
            for (int i = 0; i < 8; ++i) {
                int o = i * 1024 + tid * 4;
                float4 v = *(const float4*)(src + o);
                if (df) *(float4*)(df + o) = v;
                st_bf4(db + o, v.x, v.y, v.z, v.w);
            }
        } else if (it < ntr + n_x + n_p + n_r) {
            int e0 = (it - ntr - n_x - n_p) * 8192;
            for (int i = 0; i < 32; ++i) {
                int idx = e0 + i * 256 + tid;
                int k = idx & 1023, le = idx >> 10, e = le & 31, l = le >> 5;
                float w = p.w_router[((long)l * 1024 + k) * 32 + e];
                u16 hi = f2bf(w); u16 lo = f2bf(w - bf2f(hi));
                u16* d = p.wt_r + (long)le * 3072;
                d[k] = hi; d[1024 + k] = lo; d[2048 + k] = hi;
            }
        } else {
            const int bi = it - ntr - n_x - n_p - n_r;
            const int lk = bi >> 1, h = (bi & 1) * 64 + (tid & 63), jp = tid >> 6;
            const float* pe = p.pe_cmp + (long)lk * 2048 + jp * 512;
            const float* w1 = p.w_cmp1 + ((long)lk * 2048 + jp * 512) * 128 + h;
            float sacc = 0.f;
#pragma unroll 8
            for (int j = 0; j < 512; ++j) sacc += pe[j] * w1[(long)j * 128];
            st[tid] = sacc;
            __syncthreads();
            if (tid < 64) p.cbias[lk * 128 + h] = (st[tid] + st[tid + 64]) + (st[tid + 128] + st[tid + 192]);
        }
    }
}

__device__ __forceinline__ void phase_gemm_in(const Params& p, int l, unsigned* ctr) {
    const int NTN = (NIN + 127) / 128;
    const int tid = tid__;
    const u16* W = p.wt_in + (long)l * NIN * 1024;
    XQ q; q.init(ctr, 32 * NTN, tid__ == 0);
    for (;;) {
        int it = q.next();
        if (it < 0) break;
        int mt, nt; xq_decode(it, 32, NTN, mt, nt);
        const int m0 = mt * 128, n0 = nt * 128;
        const u16* ap[4]; const u16* bp[4];
#pragma unroll
        for (int i = 0; i < 4; ++i) {
            int r = (tid >> 3) + 32 * i;
            ap[i] = p.hb + (long)(m0 + r) * 1024;
            int n = n0 + r; if (n > NIN - 1) n = NIN - 1;
            bp[i] = W + (long)n * 1024;
        }
        f32x4 acc[4][4]; acc_zero(acc);
        gemm_main(acc, ap, bp, 1024, KId());
        EPI_COORDS
#pragma unroll
        for (int i = 0; i < 4; ++i)
#pragma unroll
            for (int j = 0; j < 4; ++j) {
                int m = m0 + EPI_M(j), n = n0 + EPI_N(i);
                if (n < NIN) st_bf4(p.yb + (long)m * NIN + n, acc[i][j][0], acc[i][j][1], acc[i][j][2], acc[i][j][3]);
            }
    }
}

struct KCmp {
    __device__ __forceinline__ long operator()(int k) const { return (long)(k >> 6) * NIN + (k & 63); }
};
__device__ __forceinline__ void tile_cmp1(const Params& p, int l, int it) {
    const int tid = tid__;
    const int kv = it >> 4, mt = it & 15;
    const u16* W = p.wt_c1 + (long)(l * 2 + kv) * 128 * 2048;
    const u16* ap[4]; const u16* bp[4];
#pragma unroll
    for (int i = 0; i < 4; ++i) {
        int r = (tid >> 3) + 32 * i;
        int mrow = mt * 128 + r;
        int c = mrow & 127, bg = mrow >> 7, g = bg & 1, b = bg >> 1;
        ap[i] = p.yb + (long)(b * SS + c * 32) * NIN + (kv ? C_VC : C_KC) + g * 64;
        bp[i] = W + (long)r * 2048;
    }
    f32x4 acc[4][4]; acc_zero(acc);
    gemm_main(acc, ap, bp, 2048, KCmp());
    EPI_COORDS
    const float* cb = p.cbias + (l * 2 + kv) * 128;
#pragma unroll
    for (int i = 0; i < 4; ++i)
#pragma unroll
        for (int j = 0; j < 4; ++j) {
            int m = mt * 128 + EPI_M(j), n = EPI_N(i);
            float v[4];
#pragma unroll
            for (int r = 0; r < 4; ++r) { float a = acc[i][j][r] + cb[n + r]; v[r] = a * sigmoidf_(a); }
            st_bf4(p.hid + ((long)kv * 2048 + m) * 128 + n, v[0], v[1], v[2], v[3]);
        }
}
__device__ __forceinline__ void phase_cmp2(const Params& p, int l, unsigned* ctr) {
    const int tid = tid__;
    WorkQ q; q.init(ctr, tid__ == 0);
    for (;;) {
        int it = q.next();
        if (it >= 32) break;
        const int kv = it >> 4, mt = it & 15;
        const u16* W = p.wt_c2 + (long)(l * 2 + kv) * 64 * 128;
        const u16* ap[4]; const u16* bp[4];
#pragma unroll
        for (int i = 0; i < 4; ++i) {
            int r = (tid >> 3) + 32 * i;
            ap[i] = p.hid + ((long)kv * 2048 + mt * 128 + r) * 128;
            bp[i] = W + (long)(r & 63) * 128;
        }
        f32x4 acc[4][4]; acc_zero(acc);
        gemm_main(acc, ap, bp, 128, KId());
        EPI_COORDS
#pragma unroll
        for (int i = 0; i < 4; ++i)
#pragma unroll
            for (int j = 0; j < 4; ++j) {
                int m = mt * 128 + EPI_M(j), n = EPI_N(i);
                if (n < 64) st_bf4(p.kvc + ((long)kv * 2048 + m) * 64 + n, acc[i][j][0], acc[i][j][1], acc[i][j][2], acc[i][j][3]);
            }
    }
}

struct AttnLds {
    u16* K;
    u16* Vt;
    float* S;
    u16* P;
};
__device__ __forceinline__ AttnLds attn_lds() {
    AttnLds a;
    a.K = (u16*)g_smem;
    a.Vt = (u16*)(g_smem + 18432);
    a.S = (float*)(g_smem + 18432 + 17408) + (tid__ >> 6) * 16 * SSTR;
    a.P = (u16*)(g_smem + 18432 + 17408 + 17408) + (tid__ >> 6) * 16 * KSTR;
    return a;
}
__device__ __forceinline__ void load_k_tile(u16* sK, int koff, const u16* base, long stride) {
    const int tid = tid__, key = tid >> 2, ch = (tid & 3) * 16;
    const u16* g = base + (long)key * stride + ch;
    uint4 a = *(const uint4*)g, b = *(const uint4*)(g + 8);
    *(uint4*)(sK + (koff + key) * KSTR + ch) = a;
    *(uint4*)(sK + (koff + key) * KSTR + ch + 8) = b;
}
__device__ __forceinline__ void load_v_tile(u16* sVt, int koff, const u16* base, long stride) {
    const int tid = tid__, key = tid & 63, d0 = (tid >> 6) * 16;
    const u16* g = base + (long)key * stride + d0;
    uint4 a = *(const uint4*)g, b = *(const uint4*)(g + 8);
    unsigned w[8] = {a.x, a.y, a.z, a.w, b.x, b.y, b.z, b.w};
#pragma unroll
    for (int i = 0; i < 8; ++i) {
        sVt[(d0 + 2 * i) * VSTR + koff + key] = (u16)(w[i] & 0xffffu);
        sVt[(d0 + 2 * i + 1) * VSTR + koff + key] = (u16)(w[i] >> 16);
    }
}
__device__ __forceinline__ void wave_qk(const AttnLds& L, int koff, const bf16x8 (&qf)[2]) {
    const int lane = tid__ & 63, quad = lane >> 4, c = lane & 15;
#pragma unroll
    for (int nt = 0; nt < 4; ++nt) {
        f32x4 a = {0.f, 0.f, 0.f, 0.f};
#pragma unroll
        for (int ks = 0; ks < 2; ++ks) {
            bf16x8 kf = *(const bf16x8*)(L.K + (koff + nt * 16 + c) * KSTR + ks * 32 + quad * 8);
            a = MFMA(qf[ks], kf, a);
        }
#pragma unroll
        for (int r = 0; r < 4; ++r) L.S[(quad * 4 + r) * SSTR + nt * 16 + c] = a[r];
    }
}
__device__ __forceinline__ void wave_pv(const AttnLds& L, int koff, f32x4 (&o)[4]) {
    const int lane = tid__ & 63, quad = lane >> 4, c = lane & 15;
#pragma unroll
    for (int ks = 0; ks < 2; ++ks) {
        bf16x8 pf = *(const bf16x8*)(L.P + c * KSTR + ks * 32 + quad * 8);
#pragma unroll
        for (int dt = 0; dt < 4; ++dt) {
            bf16x8 vf = *(const bf16x8*)(L.Vt + (dt * 16 + c) * VSTR + koff + ks * 32 + quad * 8);
            o[dt] = MFMA(pf, vf, o[dt]);
        }
    }
}
__device__ __forceinline__ void read_s16(const AttnLds& L, int row, int part, float (&z)[16]) {
#pragma unroll
    for (int i = 0; i < 4; ++i) {
        float4 v = *(const float4*)(L.S + row * SSTR + part * 16 + i * 4);
        z[i * 4 + 0] = v.x; z[i * 4 + 1] = v.y; z[i * 4 + 2] = v.z; z[i * 4 + 3] = v.w;
    }
}
__device__ __forceinline__ void write_p16(const AttnLds& L, int row, int part, const float (&pv)[16]) {
    uint4 a, b;
    a.x = (unsigned)f2bf(pv[0]) | ((unsigned)f2bf(pv[1]) << 16);
    a.y = (unsigned)f2bf(pv[2]) | ((unsigned)f2bf(pv[3]) << 16);
    a.z = (unsigned)f2bf(pv[4]) | ((unsigned)f2bf(pv[5]) << 16);
    a.w = (unsigned)f2bf(pv[6]) | ((unsigned)f2bf(pv[7]) << 16);
    b.x = (unsigned)f2bf(pv[8]) | ((unsigned)f2bf(pv[9]) << 16);
    b.y = (unsigned)f2bf(pv[10]) | ((unsigned)f2bf(pv[11]) << 16);
    b.z = (unsigned)f2bf(pv[12]) | ((unsigned)f2bf(pv[13]) << 16);
    b.w = (unsigned)f2bf(pv[14]) | ((unsigned)f2bf(pv[15]) << 16);
    *(uint4*)(L.P + row * KSTR + part * 16) = a;
    *(uint4*)(L.P + row * KSTR + part * 16 + 8) = b;
}
__device__ __forceinline__ float row4_max(float v) {
    v = fmaxf(v, __shfl_xor(v, 1));
    v = fmaxf(v, __shfl_xor(v, 2));
    return v;
}
__device__ __forceinline__ float row4_sum(float v) {
    v += __shfl_xor(v, 1);
    v += __shfl_xor(v, 2);
    return v;
}

__device__ __forceinline__ void item_sb(const Params& p, int it) {
    const int tid = tid__, lane = tid & 63, wave = tid >> 6, quad = lane >> 4, c = lane & 15;
    const int qb = it & 63, h = (it >> 6) & 7, b = it >> 9;
    const int t0 = qb * 64;
    AttnLds L = attn_lds();
    bf16x8 qf[2];
    {
        const u16* g = p.yb + (long)(b * SS + t0 + wave * 16 + c) * NIN + C_SBQ + h * 64 + quad * 8;
        qf[0] = *(const bf16x8*)g;
        qf[1] = *(const bf16x8*)(g + 32);
    }
    const int row = lane >> 2, part = lane & 3;
    const int t = t0 + wave * 16 + row;
    float R = 0.f;
    f32x4 o[4];
#pragma unroll
    for (int dt = 0; dt < 4; ++dt) o[dt] = f32x4{0.f, 0.f, 0.f, 0.f};
    for (int kb = qb; kb >= 0; --kb) {
        __syncthreads();
        const u16* kbase = p.yb + (long)(b * SS + kb * 64) * NIN + h * 64;
        load_k_tile(L.K, 0, kbase + C_SBK, NIN);
        load_v_tile(L.Vt, 0, kbase + C_SBV, NIN);
        __syncthreads();
        wave_qk(L, 0, qf);
        __syncthreads();
        float z[16], lat[16];
        read_s16(L, row, part, z);
        float run = 0.f;
#pragma unroll
        for (int i = 15; i >= 0; --i) {
            const int key = kb * 64 + part * 16 + i;
            const bool valid = key < t;
            const float zz = z[i] * 0.125f;
            const float sp = fmaxf(zz, 0.f) + __logf(1.f + __expf(-fabsf(zz)));
            lat[i] = run;
            z[i] = valid ? (zz - sp) : -1e30f;
            run += valid ? -sp : 0.f;
        }
        const int lb = lane & ~3;
        const float t0_ = __shfl(run, lb), t1_ = __shfl(run, lb + 1), t2_ = __shfl(run, lb + 2), t3_ = __shfl(run, lb + 3);
        float off = R;
        if (part < 3) off += t3_;
        if (part < 2) off += t2_;
        if (part < 1) off += t1_;
        float pv[16];
#pragma unroll
        for (int i = 0; i < 16; ++i) pv[i] = (z[i] > -1e29f) ? __expf(z[i] + lat[i] + off) : 0.f;
        write_p16(L, row, part, pv);
        R += (t0_ + t1_) + (t2_ + t3_);
        const int done = __syncthreads_and(R < -110.f);
        wave_pv(L, 0, o);
        if (done) break;
    }
#pragma unroll
    for (int dt = 0; dt < 4; ++dt)
#pragma unroll
        for (int r = 0; r < 4; ++r)
            p.ysb[(long)(b * SS + t0 + wave * 16 + quad * 4 + r) * 512 + h * 64 + dt * 16 + c] = f2bf(o[dt][r]);
}

__device__ __forceinline__ void phase_cmp1_sb(const Params& p, int l, unsigned* ctr) {
    const int total = 32 + 8 * 8 * 64;
    WorkQ q; q.init(ctr, tid__ == 0);
    for (;;) {
        int it = q.next();
        if (it >= total) break;
        if (it < 32) tile_cmp1(p, l, it);
        else item_sb(p, it - 32);
    }
}

template <int MODE>
__device__ __forceinline__ void nsa_step(const AttnLds& L, const bf16x8 (&qf)[2], f32x4 (&o)[4], float& m, float& l,
                                         float slope, int t, int kpos0, bool rowsel) {
    const int lane = tid__ & 63, quad = lane >> 4;
    const int row = lane >> 2, part = lane & 3;
    wave_qk(L, 0, qf);
    __syncthreads();
    float z[16];
    read_s16(L, row, part, z);
    float pm = -1e30f;
#pragma unroll
    for (int i = 0; i < 16; ++i) {
        const int dist = t - (kpos0 + part * 16 + i);
        bool valid = dist >= 0;
        if (MODE == 1) valid = valid && rowsel;
        if (MODE == 2) valid = valid && (dist < 512);
        z[i] = valid ? (z[i] * 0.125f - slope * (float)dist) : -1e30f;
        pm = fmaxf(pm, z[i]);
    }
    pm = row4_max(pm);
    const float mn = fmaxf(m, pm);
    const float alpha = __expf(m - mn);
    float ps = 0.f;
#pragma unroll
    for (int i = 0; i < 16; ++i) {
        z[i] = (z[i] > -1e29f) ? __expf(z[i] - mn) : 0.f;
        ps += z[i];
    }
    ps = row4_sum(ps);
    l = l * alpha + ps;
    m = mn;
    write_p16(L, row, part, z);
    float al[4];
#pragma unroll
    for (int r = 0; r < 4; ++r) al[r] = __shfl(alpha, (quad * 4 + r) * 4);
    __syncthreads();
#pragma unroll
    for (int dt = 0; dt < 4; ++dt)
#pragma unroll
        for (int r = 0; r < 4; ++r) o[dt][r] *= al[r];
    wave_pv(L, 0, o);
    __syncthreads();
}

__device__ __forceinline__ void item_nsa(const Params& p, int it) {
    const int tid = tid__, lane = tid & 63, wave = tid >> 6, quad = lane >> 4, c = lane & 15;
    const int qb = 63 - (it >> 4), bg = it & 15, g = bg & 1, b = bg >> 1;
    const int t0 = qb * 64;
    AttnLds L = attn_lds();
    const int row = lane >> 2, part = lane & 3;
    const int t = t0 + wave * 16 + row;
    const long tokbase = (long)b * SS + t0 + wave * 16;
    float* ynf = p.ynf;
    const int nct = (2 * qb + 2 > 64) ? 2 : 1;
    const int nv = (t + 1) >> 5;
    __syncthreads();
    for (int ct = 0; ct < nct; ++ct) {
        load_k_tile(L.K, ct * 64, p.kvc + ((long)(b * 2 + g) * 128 + ct * 64) * 64, 64);
        load_v_tile(L.Vt, ct * 64, p.kvc + ((long)2048 + (b * 2 + g) * 128 + ct * 64) * 64, 64);
    }
    __syncthreads();
    float imp[2][8];
#pragma unroll
    for (int a = 0; a < 2; ++a)
#pragma unroll
        for (int j = 0; j < 8; ++j) imp[a][j] = 0.f;
#pragma unroll 1
    for (int r = 0; r < 4; ++r) {
        const float slope = exp2f(-(float)(g * 4 + r + 1));
        float m = -1e30f, l = 0.f;
        bf16x8 qfa[2];
        {
            const u16* gq = p.yb + (tokbase + c) * NIN + C_NQ + (g * 4 + r) * 64 + quad * 8;
            qfa[0] = *(const bf16x8*)gq;
            qfa[1] = *(const bf16x8*)(gq + 32);
        }
        for (int ct = 0; ct < nct; ++ct) {
            wave_qk(L, ct * 64, qfa);
            __syncthreads();
            float z[16];
            read_s16(L, row, part, z);
            float pm = -1e30f;
#pragma unroll
            for (int i = 0; i < 16; ++i) {
                const int cc = ct * 64 + part * 16 + i;
                const bool valid = cc < nv;
                z[i] = valid ? (z[i] * 0.125f - slope * (float)(t - (cc * 32 + 31))) : -1e30f;
                pm = fmaxf(pm, z[i]);
            }
            pm = row4_max(pm);
            const float mn = fmaxf(m, pm);
            float ps = 0.f;
#pragma unroll
            for (int i = 0; i < 16; ++i) ps += (z[i] > -1e29f) ? __expf(z[i] - mn) : 0.f;
            ps = row4_sum(ps);
            l = l * __expf(m - mn) + ps;
            m = mn;
            __syncthreads();
        }
        const float inv = (l > 0.f) ? 1.f / l : 0.f;
        f32x4 o[4];
#pragma unroll
        for (int dt = 0; dt < 4; ++dt) o[dt] = f32x4{0.f, 0.f, 0.f, 0.f};
#pragma unroll 1
        for (int ct = 0; ct < nct; ++ct) {
            wave_qk(L, ct * 64, qfa);
            __syncthreads();
            float z[16];
            read_s16(L, row, part, z);
#pragma unroll
            for (int i = 0; i < 16; ++i) {
                const int cc = ct * 64 + part * 16 + i;
                const bool valid = cc < nv;
                const float s = z[i] * 0.125f - slope * (float)(t - (cc * 32 + 31));
                z[i] = valid ? __expf(s - m) * inv : 0.f;
            }
            const float f0 = (ct == 0) ? 1.f : 0.f, f1 = 1.f - f0;
#pragma unroll
            for (int j = 0; j < 8; ++j) {
                const float pr = z[2 * j] + z[2 * j + 1];
                imp[0][j] += f0 * pr;
                imp[1][j] += f1 * pr;
            }
            write_p16(L, row, part, z);
            __syncthreads();
            wave_pv(L, ct * 64, o);
            __syncthreads();
        }
#pragma unroll
        for (int rr = 0; rr < 4; ++rr) {
            const long tok = tokbase + quad * 4 + rr;
            const float gt = sigmoidf_(bf2f(p.yb[tok * NIN + C_NG + (g * 4 + r) * 3 + 0]));
#pragma unroll
            for (int dt = 0; dt < 4; ++dt) ynf[tok * 512 + (g * 4 + r) * 64 + dt * 16 + c] = gt * o[dt][rr];
        }
    }
#pragma unroll
    for (int a = 0; a < 2; ++a)
#pragma unroll
        for (int j = 0; j < 8; ++j) L.S[row * SSTR + a * 32 + part * 8 + j] = imp[a][j];
    __syncthreads();
    unsigned long long un = 0ull;
#ifndef NSA_NOTOPK
#define NSA_NOTOPK 0
#endif
#pragma unroll 1
    for (int rr = 0; rr < (NSA_NOTOPK ? 0 : 16); ++rr) {
        float v = L.S[rr * SSTR + lane];
        const bool forced = (lane == 0) || (lane == qb) || (lane == qb - 1);
        const bool validb = lane <= qb;
        v = forced ? 1e6f : (validb ? v : -1e30f);
        int rank = 0;
#pragma unroll 8
        for (int i = 0; i < 64; ++i) {
            const float vi = __shfl(v, i);
            rank += ((vi > v) || (vi == v && i < lane)) ? 1 : 0;
        }
        const unsigned long long mk = __ballot((rank < 16) && validb);
        if (lane == 0) s_mask[wave][rr] = mk;
        un |= mk;
    }
    if (lane == 0) s_union[wave] = un;
    __syncthreads();
    const unsigned long long rowmask = s_mask[wave][row];
    unsigned long long umask;
    {
        const unsigned long long um_ = s_union[0] | s_union[1] | s_union[2] | s_union[3];
        const unsigned lo_ = __builtin_amdgcn_readfirstlane((unsigned)um_), hi_ = __builtin_amdgcn_readfirstlane((unsigned)(um_ >> 32));
        umask = ((unsigned long long)hi_ << 32) | lo_;
    }
#ifndef NSA_HPB
#define NSA_HPB 1
#endif
#ifndef NSA_NOBC
#define NSA_NOBC 0
#endif
#pragma unroll 1
    for (int hp = 0; hp < (NSA_NOBC ? 0 : 4 / NSA_HPB); ++hp) {
#pragma unroll 1
        for (int mode = 1; mode <= 2; ++mode) {
            f32x4 o[NSA_HPB][4];
            float m[NSA_HPB], l[NSA_HPB];
#pragma unroll
            for (int r = 0; r < NSA_HPB; ++r) {
                m[r] = -1e30f; l[r] = 0.f;
#pragma unroll
                for (int dt = 0; dt < 4; ++dt) o[r][dt] = f32x4{0.f, 0.f, 0.f, 0.f};
            }
            const int kb_lo = (mode == 1) ? 0 : ((qb - 8 > 0) ? qb - 8 : 0);
            const int colk = (mode == 1) ? C_KS : C_KW, colv = (mode == 1) ? C_VS : C_VW;
            for (int kb = kb_lo; kb <= qb; ++kb) {
                if (mode == 1 && !((umask >> kb) & 1ull)) continue;
                const u16* kbase = p.yb + (long)(b * SS + kb * 64) * NIN + g * 64;
                bf16x8 qf[NSA_HPB][2];
#pragma unroll
                for (int r = 0; r < NSA_HPB; ++r) {
                    const u16* gq = p.yb + (tokbase + c) * NIN + C_NQ + (g * 4 + hp * NSA_HPB + r) * 64 + quad * 8;
                    qf[r][0] = *(const bf16x8*)gq;
                    qf[r][1] = *(const bf16x8*)(gq + 32);
                }
                load_k_tile(L.K, 0, kbase + colk, NIN);
                load_v_tile(L.Vt, 0, kbase + colv, NIN);
                __syncthreads();
                const bool rowsel = (rowmask >> kb) & 1ull;
#pragma unroll
                for (int r = 0; r < NSA_HPB; ++r) {
                    const float slope = exp2f(-(float)(g * 4 + hp * NSA_HPB + r + 1));
                    if (mode == 1) nsa_step<1>(L, qf[r], o[r], m[r], l[r], slope, t, kb * 64, rowsel);
                    else nsa_step<2>(L, qf[r], o[r], m[r], l[r], slope, t, kb * 64, rowsel);
                }
            }
#pragma unroll
            for (int r = 0; r < NSA_HPB; ++r) {
                const int hh = g * 4 + hp * NSA_HPB + r;
#pragma unroll
                for (int rr = 0; rr < 4; ++rr) {
                    const long tok = tokbase + quad * 4 + rr;
                    const float lr = __shfl(l[r], (quad * 4 + rr) * 4);
                    const float gt = sigmoidf_(bf2f(p.yb[tok * NIN + C_NG + hh * 3 + mode])) / lr;
#pragma unroll
                    for (int dt = 0; dt < 4; ++dt) {
                        const long oi = tok * 512 + hh * 64 + dt * 16 + c;
                        const float v = ynf[oi] + gt * o[r][dt][rr];
                        if (mode == 1) ynf[oi] = v;
                        else p.ynsa[oi] = f2bf(v);
                    }
                }
            }
        }
    }
}
__device__ __forceinline__ void phase_nsa(const Params& p, unsigned* ctr) {
    WorkQ q; q.init(ctr, tid__ == 0);
    for (;;) {
        int it = q.next();
        if (it >= 1024) break;
        item_nsa(p, it);
    }
}

__device__ __forceinline__ void phase_br(const Params& p, int l, unsigned* ctr) {
    const int tid = tid__;
    XQ q; q.init(ctr, 32 * 8, tid__ == 0);
    for (;;) {
        int it = q.next();
        if (it < 0) break;
        int mt, nt; xq_decode(it, 32, 8, mt, nt);
        const int m0 = mt * 128, n0 = nt * 128;
        const u16* ap[4]; const u16* bp[4];
        f32x4 acc[4][4];
        acc_zero(acc);
#pragma unroll
        for (int i = 0; i < 4; ++i) {
            int r = (tid >> 3) + 32 * i;
            ap[i] = p.ysb + (long)(m0 + r) * 512;
            bp[i] = p.wt_brs + ((long)l * 1024 + n0 + r) * 512;
        }
        gemm_main(acc, ap, bp, 512, KId());
        EPI_COORDS
#pragma unroll
        for (int i = 0; i < 4; ++i)
#pragma unroll
            for (int j = 0; j < 4; ++j) {
                const int m = m0 + EPI_M(j), n = n0 + EPI_N(i);
                const uint2 ga = *(const uint2*)(p.yb + (long)m * NIN + C_GSB + n);
                float4 o;
                o.x = sigmoidf_(bf2f((u16)(ga.x & 0xffff))) * acc[i][j][0];
                o.y = sigmoidf_(bf2f((u16)(ga.x >> 16))) * acc[i][j][1];
                o.z = sigmoidf_(bf2f((u16)(ga.y & 0xffff))) * acc[i][j][2];
                o.w = sigmoidf_(bf2f((u16)(ga.y >> 16))) * acc[i][j][3];
                *(float4*)(p.pre1 + (long)m * 1024 + n) = o;
            }
        acc_zero(acc);
#pragma unroll
        for (int i = 0; i < 4; ++i) {
            int r = (tid >> 3) + 32 * i;
            ap[i] = p.ynsa + (long)(m0 + r) * 512;
            bp[i] = p.wt_brn + ((long)l * 1024 + n0 + r) * 512;
        }
        gemm_main(acc, ap, bp, 512, KId());
#pragma unroll
        for (int i = 0; i < 4; ++i)
#pragma unroll
            for (int j = 0; j < 4; ++j) {
                const int m = m0 + EPI_M(j), n = n0 + EPI_N(i);
                const uint2 gb = *(const uint2*)(p.yb + (long)m * NIN + C_GNSA + n);
                const float4 st = *(const float4*)(p.pre1 + (long)m * 1024 + n);
                st_bf4(p.merged + (long)m * 1024 + n,
                       st.x + sigmoidf_(bf2f((u16)(gb.x & 0xffff))) * acc[i][j][0],
                       st.y + sigmoidf_(bf2f((u16)(gb.x >> 16))) * acc[i][j][1],
                       st.z + sigmoidf_(bf2f((u16)(gb.y & 0xffff))) * acc[i][j][2],
                       st.w + sigmoidf_(bf2f((u16)(gb.y >> 16))) * acc[i][j][3]);
            }
    }
}
__device__ __forceinline__ void phase_wo(const Params& p, int l, unsigned* ctr) {
    const int tid = tid__;
    XQ q; q.init(ctr, 32 * 8, tid__ == 0);
    for (;;) {
        int it = q.next();
        if (it < 0) break;
        int mt, nt; xq_decode(it, 32, 8, mt, nt);
        const int m0 = mt * 128, n0 = nt * 128;
        const u16* ap[4]; const u16* bp[4];
        f32x4 acc[4][4]; acc_zero(acc);
#pragma unroll
        for (int i = 0; i < 4; ++i) {
            int r = (tid >> 3) + 32 * i;
            ap[i] = p.merged + (long)(m0 + r) * 1024;
            bp[i] = p.wt_o + ((long)l * 1024 + n0 + r) * 1024;
        }
        gemm_main(acc, ap, bp, 1024, KId());
        EPI_COORDS
#pragma unroll
        for (int i = 0; i < 4; ++i)
#pragma unroll
            for (int j = 0; j < 4; ++j) {
                const int m = m0 + EPI_M(j), n = n0 + EPI_N(i);
                const float4 hv = *(const float4*)(p.hf + (long)m * 1024 + n);
                float4 o;
                o.x = DN_ALPHA * hv.x + acc[i][j][0]; o.y = DN_ALPHA * hv.y + acc[i][j][1];
                o.z = DN_ALPHA * hv.z + acc[i][j][2]; o.w = DN_ALPHA * hv.w + acc[i][j][3];
                *(float4*)(p.pre1 + (long)m * 1024 + n) = o;
            }
    }
}
__device__ __forceinline__ float wave_sum(float v) {
#pragma unroll
    for (int s = 32; s >= 1; s >>= 1) v += __shfl_xor(v, s);
    return v;
}
__device__ __forceinline__ void phase_ln(const Params& p, int l, int mode, unsigned* ctr) {
    const int lane = tid__ & 63, wave = tid__ >> 6;
    const float* gam = (mode == 1 ? p.ln1_g : p.ln2_g) + l * 1024;
    const float* bet = (mode == 1 ? p.ln1_b : p.ln2_b) + l * 1024;
    WorkQ q; q.init(ctr, tid__ == 0);
    for (;;) {
        int it = q.next();
        if (it >= TT / 64) break;
        for (int rr = 0; rr < 16; rr += 2) {
            float v[2][16];
#pragma unroll
            for (int u = 0; u < 2; ++u) {
                const long row = (long)it * 64 + wave * 16 + rr + u;
#pragma unroll
                for (int i = 0; i < 4; ++i) {
                    const int col = i * 256 + lane * 4;
                    float4 a;
                    if (mode == 1) a = *(const float4*)(p.pre1 + row * 1024 + col);
                    else {
                        a = *(const float4*)(p.h1f + row * 1024 + col);
                        a.x *= DN_ALPHA; a.y *= DN_ALPHA; a.z *= DN_ALPHA; a.w *= DN_ALPHA;
                        const uint2 pl = *(const uint2*)(p.ple + row * 1024 + col);
                        a.x += bf2f((u16)(pl.x & 0xffff)); a.y += bf2f((u16)(pl.x >> 16));
                        a.z += bf2f((u16)(pl.y & 0xffff)); a.w += bf2f((u16)(pl.y >> 16));
#pragma unroll
                        for (int s4 = 0; s4 < 4; ++s4) {
                            const uint2 y = *(const uint2*)(p.y4 + (row * 4 + s4) * 1024 + col);
                            a.x += bf2f((u16)(y.x & 0xffff)); a.y += bf2f((u16)(y.x >> 16));
                            a.z += bf2f((u16)(y.y & 0xffff)); a.w += bf2f((u16)(y.y >> 16));
                        }
                    }
                    v[u][i * 4 + 0] = a.x; v[u][i * 4 + 1] = a.y; v[u][i * 4 + 2] = a.z; v[u][i * 4 + 3] = a.w;
                }
            }
#pragma unroll
            for (int u = 0; u < 2; ++u) {
                const long row = (long)it * 64 + wave * 16 + rr + u;
                float sm = 0.f;
#pragma unroll
                for (int i = 0; i < 16; ++i) sm += v[u][i];
                const float mean = wave_sum(sm) * (1.f / 1024.f);
                float s2 = 0.f;
#pragma unroll
                for (int i = 0; i < 16; ++i) { v[u][i] -= mean; s2 += v[u][i] * v[u][i]; }
                const float rstd = rsqrtf(wave_sum(s2) * (1.f / 1024.f) + 1e-5f);
#pragma unroll
                for (int i = 0; i < 4; ++i) {
                    const int col = i * 256 + lane * 4;
                    const float4 gg = *(const float4*)(gam + col), bb = *(const float4*)(bet + col);
                    float4 y;
                    y.x = v[u][i * 4 + 0] * rstd * gg.x + bb.x; y.y = v[u][i * 4 + 1] * rstd * gg.y + bb.y;
                    y.z = v[u][i * 4 + 2] * rstd * gg.z + bb.z; y.w = v[u][i * 4 + 3] * rstd * gg.w + bb.w;
                    if (mode == 1) {
                        *(float4*)(p.h1f + row * 1024 + col) = y;
                        const u16 h0 = f2bf(y.x), h1 = f2bf(y.y), h2 = f2bf(y.z), h3 = f2bf(y.w);
                        uint2 uu; uu.x = (unsigned)h0 | ((unsigned)h1 << 16); uu.y = (unsigned)h2 | ((unsigned)h3 << 16);
                        *(uint2*)(p.h1b + row * 1024 + col) = uu;
                        st_bf4(p.h1lo + row * 1024 + col, y.x - bf2f(h0), y.y - bf2f(h1), y.z - bf2f(h2), y.w - bf2f(h3));
                    } else {
                        if (l == 3) *(float4*)(p.out + row * 1024 + col) = y;
                        else {
                            *(float4*)(p.hf + row * 1024 + col) = y;
                            st_bf4(p.hb + row * 1024 + col, y.x, y.y, y.z, y.w);
                        }
                    }
                }
            }
        }
    }
}
struct KRouter {
    long dlo;
    __device__ __forceinline__ long operator()(int k) const { return (k < 2048) ? (long)(k & 1023) : (dlo + (k - 2048)); }
};
__device__ __forceinline__ void phase_router_ple(const Params& p, int l, unsigned* ctr) {
    const int tid = tid__;
    XQ q; q.init(ctr, 32 * 9, tid__ == 0);
    for (;;) {
        int it = q.next();
        if (it < 0) break;
        int mt, nt; xq_decode(it, 32, 9, mt, nt);
        const u16* ap[4]; const u16* bp[4];
        if (nt == 8) {
            const int m0 = mt * 128;
            f32x4 acc[4][4]; acc_zero(acc);
#pragma unroll
            for (int i = 0; i < 4; ++i) {
                int r = (tid >> 3) + 32 * i;
                ap[i] = p.h1b + (long)(m0 + r) * 1024;
                bp[i] = p.wt_r + ((long)l * 32 + (r & 31)) * 3072;
            }
            KRouter kr; kr.dlo = (long)(p.h1lo - p.h1b);
            gemm_main(acc, ap, bp, 3072, kr);
            EPI_COORDS
#pragma unroll
            for (int i = 0; i < 4; ++i)
#pragma unroll
                for (int j = 0; j < 4; ++j) {
                    const int m = m0 + EPI_M(j), n = EPI_N(i);
                    if (n < 32) {
                        const float4 bb = *(const float4*)(p.b_router + l * 32 + n);
                        float4 o; o.x = acc[i][j][0] + bb.x; o.y = acc[i][j][1] + bb.y; o.z = acc[i][j][2] + bb.z; o.w = acc[i][j][3] + bb.w;
                        *(float4*)(p.logits + (long)m * 32 + n) = o;
                    }
                }
        } else {
            const int m0 = mt * 128, n0 = nt * 128;
            f32x4 acc[4][4];
            acc_zero(acc);
#pragma unroll
            for (int i = 0; i < 4; ++i) {
                int r = (tid >> 3) + 32 * i;
                ap[i] = p.pb + ((long)l * TT + m0 + r) * 256;
                bp[i] = p.wt_pp + ((long)l * 1024 + n0 + r) * 256;
            }
            gemm_main(acc, ap, bp, 256, KId());
            EPI_COORDS
#pragma unroll
            for (int i = 0; i < 4; ++i)
#pragma unroll
                for (int j = 0; j < 4; ++j) {
                    const int m = m0 + EPI_M(j), n = n0 + EPI_N(i);
                    float4 o; o.x = acc[i][j][0]; o.y = acc[i][j][1]; o.z = acc[i][j][2]; o.w = acc[i][j][3];
                    *(float4*)(p.pre1 + (long)m * 1024 + n) = o;
                }
            acc_zero(acc);
#pragma unroll
            for (int i = 0; i < 4; ++i) {
                int r = (tid >> 3) + 32 * i;
                ap[i] = p.h1b + (long)(m0 + r) * 1024;
                bp[i] = p.wt_pg + ((long)l * 1024 + n0 + r) * 1024;
            }
            gemm_main(acc, ap, bp, 1024, KId());
#pragma unroll
            for (int i = 0; i < 4; ++i)
#pragma unroll
                for (int j = 0; j < 4; ++j) {
                    const int m = m0 + EPI_M(j), n = n0 + EPI_N(i);
                    const float4 st = *(const float4*)(p.pre1 + (long)m * 1024 + n);
                    st_bf4(p.ple + (long)m * 1024 + n, sigmoidf_(acc[i][j][0]) * st.x, sigmoidf_(acc[i][j][1]) * st.y,
                           sigmoidf_(acc[i][j][2]) * st.z, sigmoidf_(acc[i][j][3]) * st.w);
                }
        }
    }
}
__device__ __forceinline__ void phase_route(const Params& p, int l, unsigned* ctr) {
    const int tid = tid__;
    int* s_cnt = s_misc;
    int* s_base = s_misc + 32;
    WorkQ q; q.init(ctr, tid__ == 0);
    for (;;) {
        int it = q.next();
        if (it >= TT / 256) break;
        if (tid < 32) s_cnt[tid] = 0;
        __syncthreads();
        const int t = it * 256 + tid;
        float lg[32];
#pragma unroll
        for (int i = 0; i < 8; ++i) {
            const float4 v = *(const float4*)(p.logits + (long)t * 32 + i * 4);
            lg[i * 4 + 0] = v.x; lg[i * 4 + 1] = v.y; lg[i * 4 + 2] = v.z; lg[i * 4 + 3] = v.w;
        }
        unsigned taken = 0u;
        int ek[4]; float vk[4];
#pragma unroll
        for (int k = 0; k < 4; ++k) {
            float best = -3.0e38f; int bi = 0;
#pragma unroll
            for (int e = 0; e < 32; ++e) {
                const bool ok = !((taken >> e) & 1u) && (lg[e] > best);
                best = ok ? lg[e] : best;
                bi = ok ? e : bi;
            }
            taken |= 1u << bi;
            ek[k] = bi; vk[k] = best;
        }
        float wsum = 0.f;
        float v0 = -3.0e38f, v1 = 0.f, v2 = 0.f, v3 = 0.f;
#pragma unroll
        for (int e = 0; e < 32; ++e) {
            v0 = (e == ek[0]) ? lg[e] : v0;
            v1 = (e == ek[1]) ? lg[e] : v1;
            v2 = (e == ek[2]) ? lg[e] : v2;
            v3 = (e == ek[3]) ? lg[e] : v3;
        }
        vk[0] = 1.f; vk[1] = __expf(v1 - v0); vk[2] = __expf(v2 - v0); vk[3] = __expf(v3 - v0);
        wsum = vk[0] + vk[1] + vk[2] + vk[3];
        const float winv = 1.f / wsum;
        int lp[4];
#pragma unroll
        for (int k = 0; k < 4; ++k) lp[k] = atomicAdd(&s_cnt[ek[k]], 1);
        __syncthreads();
        if (tid < 32) s_base[tid] = (int)atomicAdd(&p.ecnt[l * 32 + tid], (unsigned)s_cnt[tid]);
        __syncthreads();
#pragma unroll
        for (int k = 0; k < 4; ++k) {
            const long idx = (long)ek[k] * TT + s_base[ek[k]] + lp[k];
            p.ent_id[idx] = t * 4 + k;
            p.ent_w[idx] = vk[k] * winv;
        }
    }
}
__device__ __forceinline__ void moe_prefix(const Params& p, int l) {
    __syncthreads();
    if (tid__ == 0) {
        int acc = 0;
        for (int e = 0; e < 32; ++e) {
            const int n = (int)__hip_atomic_load(&p.ecnt[l * 32 + e], __ATOMIC_RELAXED, __HIP_MEMORY_SCOPE_AGENT);
            s_misc[e] = acc;
            s_misc[40 + e] = n;
            acc += (n + 127) >> 7;
        }
        s_misc[32] = acc;
    }
    __syncthreads();
}
__device__ __forceinline__ void phase_moe_gu(const Params& p, int l, unsigned* ctr) {
    const int tid = tid__;
    moe_prefix(p, l);
    const int mtotal = s_misc[32];
    const int mpx = (((mtotal + 7) >> 3) + 7) & ~7;
    XQ q; q.init(ctr, mpx * 16, tid__ == 0);
    for (;;) {
        int it = q.next();
        if (it < 0) break;
        int mtg, nt; xq_decode(it, mpx, 16, mtg, nt);
        if (mtg >= mtotal) continue;
        int e = 0;
        for (int i = 1; i < 32; ++i) e = (s_misc[i] <= mtg) ? i : e;
        const int mt = mtg - s_misc[e], ne = s_misc[40 + e];
        const u16* ap[4]; const u16* bp[4];
#pragma unroll
        for (int i = 0; i < 4; ++i) {
            const int r = (tid >> 3) + 32 * i;
            int idx = mt * 128 + r; if (idx > ne - 1) idx = ne - 1;
            const int tok = p.ent_id[(long)e * TT + idx] >> 2;
            ap[i] = p.h1b + (long)tok * 1024;
            const int isup = (r >> 5) & 1, col = (r >> 6) * 32 + (r & 31);
            bp[i] = p.wt_gu + (((long)l * 32 + e) * 2048 + isup * 1024 + nt * 64 + col) * 1024;
        }
        f32x4 acc[4][4]; acc_zero(acc);
        gemm_main(acc, ap, bp, 1024, KId());
        EPI_COORDS
        const float* bg = p.b_gu + ((long)l * 32 + e) * 2048;
#pragma unroll
        for (int i = 0; i < 2; ++i)
#pragma unroll
            for (int j = 0; j < 4; ++j) {
                const long rowa = (long)mtg * 128 + EPI_M(j);
                const int col = nt * 64 + wn_ * 32 + i * 16 + (lane_ >> 4) * 4;
                float v[4];
#pragma unroll
                for (int r = 0; r < 4; ++r) {
                    float gate = acc[i][j][r] + bg[col + r];
                    float up = acc[i + 2][j][r] + bg[1024 + col + r];
                    gate = fminf(gate, 7.f);
                    up = fminf(fmaxf(up, -7.f), 7.f);
                    v[r] = (up + 1.f) * gate * sigmoidf_(1.702f * gate);
                }
                st_bf4(p.act + rowa * 1024 + col, v[0], v[1], v[2], v[3]);
            }
    }
}
__device__ __forceinline__ void phase_moe_down(const Params& p, int l, unsigned* ctr) {
    const int tid = tid__;
    moe_prefix(p, l);
    const int mtotal = s_misc[32];
    const int mpx = (((mtotal + 7) >> 3) + 7) & ~7;
    XQ q; q.init(ctr, mpx * 8, tid__ == 0);
    for (;;) {
        int it = q.next();
        if (it < 0) break;
        int mtg, nt; xq_decode(it, mpx, 8, mtg, nt);
        if (mtg >= mtotal) continue;
        int e = 0;
        for (int i = 1; i < 32; ++i) e = (s_misc[i] <= mtg) ? i : e;
        const int mt = mtg - s_misc[e], ne = s_misc[40 + e];
        const u16* ap[4]; const u16* bp[4];
#pragma unroll
        for (int i = 0; i < 4; ++i) {
            const int r = (tid >> 3) + 32 * i;
            ap[i] = p.act + ((long)mtg * 128 + r) * 1024;
            bp[i] = p.wt_dn + (((long)l * 32 + e) * 1024 + nt * 128 + r) * 1024;
        }
        f32x4 acc[4][4]; acc_zero(acc);
        gemm_main(acc, ap, bp, 1024, KId());
        EPI_COORDS
        const float* bd = p.b_down + ((long)l * 32 + e) * 1024;
#pragma unroll
        for (int j = 0; j < 4; ++j) {
            const int idx = mt * 128 + EPI_M(j);
            if (idx < ne) {
                const int id = p.ent_id[(long)e * TT + idx];
                const float cw = p.ent_w[(long)e * TT + idx];
#pragma unroll
                for (int i = 0; i < 4; ++i) {
                    const int n = nt * 128 + EPI_N(i);
                    const float4 bb = *(const float4*)(bd + n);
                    st_bf4(p.y4 + (long)id * 1024 + n, cw * (acc[i][j][0] + bb.x), cw * (acc[i][j][1] + bb.y),
                           cw * (acc[i][j][2] + bb.z), cw * (acc[i][j][3] + bb.w));
                }
            }
        }
    }
}

};
#ifndef PH0_EN
#define PH0_EN 1
#endif
__device__ __forceinline__ void run_phase(const Params& p, int ph, int coff, int wv) {
    unsigned* ctr = p.ctr + (ph + coff) * 8;
    Ctx cx;
    {
        int t_ = wv * 64 + (int)__lane_id();
        asm volatile("" : "+v"(t_));
        cx.tid__ = t_;
    }
    if (ph == 0) { if (PH0_EN) cx.phase_prologue(p, ctr); return; }
    const int l = (ph - 1) / NPH_LAYER, s = (ph - 1) % NPH_LAYER;
#ifndef ONLY_S
#define ONLY_S -1
#endif
#ifndef SKIP_S
#define SKIP_S -1
#endif
#define PH_EN(x) ((ONLY_S < 0 || ONLY_S == (x)) && SKIP_S != (x))
    if (PH_EN(0) && s == 0) cx.phase_gemm_in(p, l, ctr);
    if (PH_EN(1) && s == 1) cx.phase_cmp1_sb(p, l, ctr);
    if (PH_EN(2) && s == 2) cx.phase_cmp2(p, l, ctr);
    if (PH_EN(3) && s == 3) cx.phase_nsa(p, ctr);
    if (PH_EN(4) && s == 4) cx.phase_br(p, l, ctr);
    if (PH_EN(5) && s == 5) cx.phase_wo(p, l, ctr);
    if (PH_EN(6) && s == 6) cx.phase_ln(p, l, 1, ctr);
    if (PH_EN(7) && s == 7) cx.phase_router_ple(p, l, ctr);
    if (PH_EN(8) && s == 8) cx.phase_route(p, l, ctr);
    if (PH_EN(9) && s == 9) cx.phase_moe_gu(p, l, ctr);
    if (PH_EN(10) && s == 10) cx.phase_moe_down(p, l, ctr);
    if (PH_EN(11) && s == 11) cx.phase_ln(p, l, 2, ctr);
}

__global__ void __launch_bounds__(256, 2) mega_kernel(Params p, int ph0, int ph1) {
    __shared__ uint4 xb_words;
    const int wv = __builtin_amdgcn_readfirstlane((int)(threadIdx.x >> 6));
    const bool t0 = (threadIdx.x == 0);
    if (t0) xb_words = make_uint4(0u, 0u, 0u, 0u);
    __syncthreads();
    __shared__ Params s_p;
    if (t0) {
        const void* const* src_ = (const void* const*)&p;
        const void** dst_ = (const void**)&s_p;
#pragma unroll
        for (int i = 0; i < (int)(sizeof(Params) / sizeof(void*)); ++i) dst_[i] = src_[i];
    }
    __syncthreads();
    XcdBarrier bar = xcd_barrier_post(p.bar, (volatile LAS unsigned*)&xb_words, t0);
    for (int ph = ph0; ph < ph1; ++ph) {
        const bool t0p = (wv == 0) && (__lane_id() == 0);
        if (ph > ph0) xcd_barrier(bar, t0p);
        asm volatile("" ::: "memory");
        run_phase(s_p, ph, 0, wv);
#if REP_MASK
        if (ph > 0 && ((REP_MASK >> ((ph - 1) % NPH_LAYER)) & 1)) {
            xcd_barrier(bar, t0p);
            asm volatile("" ::: "memory");
            run_phase(s_p, ph, 64, wv);
        }
#endif
    }
}

#ifndef REP_MASK
#define REP_MASK 0
#endif
#ifndef MK_SPLIT
#define MK_SPLIT 0
#endif

extern "C" void kernel_launch(void* const* d_in, const int* in_sizes, int n_in, void* d_out, int out_size, void* d_ws,
                              size_t ws_size, hipStream_t stream) {
    static int grid = 0;
    if (!grid) {
        int dev = 0, cus = 0, per_cu = 0;
        hipGetDevice(&dev);
        hipDeviceGetAttribute(&cus, hipDeviceAttributeMultiprocessorCount, dev);
        hipOccupancyMaxActiveBlocksPerMultiprocessor(&per_cu, mega_kernel, 256, 0);
        if (per_cu < 1) per_cu = 1;
        grid = cus * (per_cu < 2 ? per_cu : 2);
    }
    Params p;
    memset(&p, 0, sizeof(p));
    const float** pin = (const float**)&p;
    for (int i = 0; i < 21; ++i) pin[i] = (const float*)d_in[i];
    p.out = (float*)d_out;
    char* w = (char*)d_ws;
    size_t off = 0;
    auto take = [&](size_t bytes) { char* r = w + off; off += (bytes + 255) & ~(size_t)255; return r; };
    const size_t sync_bytes = (XCD_BAR_WORDS + 1024 + 128) * sizeof(unsigned);
    p.bar = (unsigned*)take(sync_bytes);
    p.ctr = p.bar + XCD_BAR_WORDS;
    p.ecnt = p.ctr + 1024;
    p.wt_in = (u16*)take((size_t)4 * NIN * 1024 * 2);
    p.wt_brs = (u16*)take((size_t)4 * 512 * 1024 * 2);
    p.wt_brn = (u16*)take((size_t)4 * 512 * 1024 * 2);
    p.wt_o = (u16*)take((size_t)4 * 1024 * 1024 * 2);
    p.wt_pg = (u16*)take((size_t)4 * 1024 * 1024 * 2);
    p.wt_pp = (u16*)take((size_t)4 * 256 * 1024 * 2);
    p.wt_gu = (u16*)take((size_t)128 * 2048 * 1024 * 2);
    p.wt_dn = (u16*)take((size_t)128 * 1024 * 1024 * 2);
    p.wt_c1 = (u16*)take((size_t)8 * 128 * 2048 * 2);
    p.wt_c2 = (u16*)take((size_t)8 * 64 * 128 * 2);
    p.wt_r = (u16*)take((size_t)4 * 32 * 3072 * 2);
    p.cbias = (float*)take(1024 * 4);
    p.hf = (float*)take((size_t)TT * 1024 * 4);
    p.pre1 = (float*)take((size_t)TT * 1024 * 4);
    p.h1f = (float*)take((size_t)TT * 1024 * 4);
    p.logits = (float*)take((size_t)TT * 32 * 4);
    p.ynf = (float*)take((size_t)TT * 512 * 4);
    p.ent_w = (float*)take((size_t)32 * TT * 4);
    p.hb = (u16*)take((size_t)TT * 1024 * 2);
    p.pb = (u16*)take((size_t)4 * TT * 256 * 2);
    p.yb = (u16*)take((size_t)TT * NIN * 2);
    p.ysb = (u16*)take((size_t)TT * 512 * 2);
    p.ynsa = (u16*)take((size_t)TT * 512 * 2);
    p.merged = (u16*)take((size_t)TT * 1024 * 2);
    p.h1b = (u16*)take((size_t)TT * 1024 * 2);
    p.h1lo = (u16*)take((size_t)TT * 1024 * 2);
    p.ple = (u16*)take((size_t)TT * 1024 * 2);
    p.hid = (u16*)take((size_t)2 * 2048 * 128 * 2);
    p.kvc = (u16*)take((size_t)2 * 2048 * 64 * 2);
    p.act = (u16*)take((size_t)(TT * 4 + 32 * 128) * 1024 * 2);
    p.y4 = (u16*)take((size_t)TT * 4 * 1024 * 2);
    p.ent_id = (int*)take((size_t)32 * TT * 4);
    if (off > ws_size) { fprintf(stderr, "workspace too small: need %zu have %zu\n", off, ws_size); return; }
    hipMemsetAsync(p.bar, 0, sync_bytes, stream);
#if MK_SPLIT
    for (int ph = 0; ph < NPHASE; ++ph) mega_kernel<<<dim3(grid), dim3(256), 0, stream>>>(p, ph, ph + 1);
#else
    mega_kernel<<<dim3(grid), dim3(256), 0, stream>>>(p, 0, NPHASE);
#endif
}
```

```cpp
#define NSA_HPB 2
#include <hip/hip_runtime.h>
#include <stdint.h>
#include <cstdio>
#include <cstring>
#include <cstdlib>
#include <vector>

#define XB_TMO      128
#define XB_XCNT(j)  (256  + 64 * (j))
#define XB_XSUB(j)  (1280 + 64 * (j))
#define XB_XGEN(j)  (2304 + 64 * (j))
#define XB_TOP      3328
#define XB_TOPGEN   3392
#define XCD_BAR_WORDS 3456
#define XB_SPIN_CAP (1u << 18)
#define LAS __attribute__((address_space(3)))

__device__ __forceinline__ unsigned xb_ld(unsigned* p)              { return __hip_atomic_load(p, __ATOMIC_RELAXED, __HIP_MEMORY_SCOPE_AGENT); }
__device__ __forceinline__ unsigned xb_add(unsigned* p, unsigned v) { return __hip_atomic_fetch_add(p, v, __ATOMIC_RELAXED, __HIP_MEMORY_SCOPE_AGENT); }
__device__ __forceinline__ unsigned xb_xcc_id() { return (unsigned)__builtin_amdgcn_s_getreg((3 << 11) | 20) & 0xFu; }
#define XB_SPIN(cond, bar) do { unsigned _sp = 0; while (cond) { __builtin_amdgcn_s_sleep(1); \
    if ((++_sp & 255u) == 0u) { if (xb_ld(&(bar)[XB_TMO])) break; if (_sp > XB_SPIN_CAP) { atomicAdd(&(bar)[XB_TMO], 1u); break; } } } } while (0)

struct XcdBarrier {
    unsigned* bar; unsigned x;
    volatile LAS unsigned* st;
};

__device__ __forceinline__ XcdBarrier xcd_barrier_post(unsigned* bar, volatile LAS unsigned* st, const bool xb_t0) {
    XcdBarrier b; b.bar = bar; b.x = xb_xcc_id(); b.st = st;
    if (xb_t0) (void)xb_add(&bar[XB_XCNT(b.x)], 1u);
    return b;
}
__device__ __forceinline__ void xcd_barrier_complete(unsigned* bar, unsigned x, unsigned& nloc, unsigned& nx) {
    const unsigned G = gridDim.x * gridDim.y * gridDim.z;
    unsigned sum, cnt, mine, sp = 0u;
    for (;;) {
        sum = 0u; cnt = 0u; mine = 0u;
#pragma unroll
        for (unsigned j = 0; j < 16; ++j) { const unsigned c = xb_ld(&bar[XB_XCNT(j)]); sum += c; cnt += (c > 0u) ? 1u : 0u; mine = (j == x) ? c : mine; }
        if (sum == G) break;
        __builtin_amdgcn_s_sleep(1);
        if ((++sp & 255u) == 0u) { if (xb_ld(&bar[XB_TMO])) break; if (sp > XB_SPIN_CAP) { atomicAdd(&bar[XB_TMO], 1u); break; } }
    }
    nloc = mine > 0u ? mine : 1u; nx = cnt > 0u ? cnt : 1u;
}

__device__ __forceinline__ void xcd_barrier(const XcdBarrier& b, const bool xb_t0) {
    asm volatile("s_waitcnt vmcnt(0)" ::: "memory");
    __syncthreads();
    if (xb_t0) {
        unsigned* bar = b.bar;
        __builtin_amdgcn_s_waitcnt(0);
        unsigned nloc = b.st[0], nx = b.st[1];
        if (nloc == 0u) { xcd_barrier_complete(bar, b.x, nloc, nx); b.st[0] = nloc; b.st[1] = nx; }
        const unsigned old = xb_add(&bar[XB_XSUB(b.x)], 1u);
        const unsigned gen = old / nloc;
        if (old + 1u == (gen + 1u) * nloc) {
            __builtin_amdgcn_fence(__ATOMIC_RELEASE, "agent");
            asm volatile("s_waitcnt vmcnt(0)" ::: "memory");
            const unsigned og = xb_add(&bar[XB_TOP], 1u);
            const unsigned tg = og / nx;
            if (og + 1u == (tg + 1u) * nx) xb_add(&bar[XB_TOPGEN], 1u);
            else XB_SPIN(xb_ld(&bar[XB_TOPGEN]) == tg, bar);
            __builtin_amdgcn_fence(__ATOMIC_ACQUIRE, "agent");
            xb_add(&bar[XB_XGEN(b.x)], 1u);
            asm volatile("s_waitcnt vmcnt(0)" ::: "memory");
        } else {
            XB_SPIN(xb_ld(&bar[XB_XGEN(b.x)]) == gen, bar);
            __builtin_amdgcn_fence(__ATOMIC_ACQUIRE, "agent");
            asm volatile("s_waitcnt vmcnt(0)" ::: "memory");
        }
    }
    __syncthreads();
}


#ifndef REP_MASK
#define REP_MASK 0
#endif
typedef unsigned short u16;
typedef __attribute__((ext_vector_type(8))) short bf16x8;
typedef __attribute__((ext_vector_type(4))) float f32x4;
typedef __attribute__((ext_vector_type(4))) unsigned u32x4;
#define MFMA(a, b, c) __builtin_amdgcn_mfma_f32_16x16x32_bf16(a, b, c, 0, 0, 0)

#define TT 32768
#define SS 4096
#define DD 1024
#define NIN 4888
#define C_SBQ 0
#define C_SBK 512
#define C_SBV 1024
#define C_NQ 1536
#define C_KC 2048
#define C_VC 2176
#define C_KS 2304
#define C_VS 2432
#define C_KW 2560
#define C_VW 2688
#define C_NG 2816
#define C_GSB 2840
#define C_GNSA 3864
#define DN_ALPHA 1.681792830507429f
#define NPH_LAYER 12
#define NPHASE (1 + 4 * NPH_LAYER)
#define KSTR 72
#define VSTR 136
#define SSTR 68

struct Params {
    const float *x, *p, *w_in, *w_cmp1, *w_cmp2, *pe_cmp, *w_br_sb, *w_br_nsa, *w_o, *ln1_g, *ln1_b, *ln2_g, *ln2_b,
        *w_router, *b_router, *w_gu, *b_gu, *w_down, *b_down, *w_ple_gate, *w_ple_proj;
    float* out;
    unsigned *bar, *ctr, *ecnt;
    u16 *wt_in, *wt_brs, *wt_brn, *wt_o, *wt_pg, *wt_pp, *wt_gu, *wt_dn, *wt_c1, *wt_c2, *wt_r;
    float *cbias, *hf, *pre1, *h1f, *logits, *ynf, *ent_w;
    u16 *hb, *pb, *yb, *ysb, *ynsa, *merged, *h1b, *h1lo, *ple, *hid, *kvc, *act, *y4;
    int* ent_id;
};

__device__ __forceinline__ u16 f2bf(float f) {
    unsigned u = __float_as_uint(f);
    u += 0x7fffu + ((u >> 16) & 1u);
    return (u16)(u >> 16);
}
__device__ __forceinline__ float bf2f(u16 h) { return __uint_as_float(((unsigned)h) << 16); }
__device__ __forceinline__ void st_bf4(u16* p, float a, float b, float c, float d) {
    uint2 u;
    u.x = (unsigned)f2bf(a) | ((unsigned)f2bf(b) << 16);
    u.y = (unsigned)f2bf(c) | ((unsigned)f2bf(d) << 16);
    *(uint2*)p = u;
}
__device__ __forceinline__ float sigmoidf_(float x) { return 1.f / (1.f + __expf(-x)); }

__shared__ __attribute__((aligned(16))) unsigned char g_smem[62464];
__shared__ int s_item;
__shared__ int s_misc[80];
__shared__ unsigned long long s_mask[4][16];
__shared__ unsigned long long s_union[4];

struct WorkQ {
    unsigned* ctr;
    int nxt;
    bool t0;
    __device__ __forceinline__ void init(unsigned* c, bool t0_) {
        ctr = c;
        nxt = 0;
        t0 = t0_;
        if (t0) nxt = (int)atomicAdd(ctr, 1u);
    }
    __device__ __forceinline__ int next() {
        __syncthreads();
        if (t0) s_item = nxt;
        __syncthreads();
        int it = s_item;
        if (t0) nxt = (int)atomicAdd(ctr, 1u);
        return it;
    }
};


struct XQ {
    unsigned* ctr;
    int per, x0, k, nxt;
    bool t0;
    __device__ __forceinline__ void init(unsigned* c, int per_, bool t0_) {
        ctr = c; per = per_; k = 0; nxt = 0; t0 = t0_;
        x0 = (int)(xb_xcc_id() & 7u);
        if (t0) nxt = (int)atomicAdd(&ctr[x0], 1u);
    }
    __device__ __forceinline__ int next() {
        __syncthreads();
        if (t0) {
            int v = nxt;
            while (v >= per && k < 8) {
                ++k;
                if (k < 8) v = (int)atomicAdd(&ctr[(x0 + k) & 7], 1u);
            }
            if (k < 8) {
                s_item = ((x0 + k) & 7) * per + v;
                nxt = (int)atomicAdd(&ctr[(x0 + k) & 7], 1u);
            } else s_item = -1;
        }
        __syncthreads();
        return s_item;
    }
};
__device__ __forceinline__ void xq_decode(int item, int mpx, int NT, int& mt, int& nt) {
    const int per = mpx * NT;
    const int q = item / per, idx = item - q * per;
    const int sm = idx / (8 * NT), rem = idx - sm * (8 * NT);
    nt = rem >> 3;
    mt = q * mpx + sm * 8 + (rem & 7);
}
struct Ctx {
    int tid__;
struct KId {
    __device__ __forceinline__ long operator()(int k) const { return k; }
};
template <class KOA>
__device__ __forceinline__ void gemm_main(f32x4 (&acc)[4][4], const u16* (&ap)[4], const u16* (&bp)[4], int K, KOA koa) {
    u16* sA = (u16*)g_smem;
    u16* sB = sA + 128 * KSTR;
    const int tid = tid__, lane = tid & 63, wave = tid >> 6;
    const int wn = wave & 1, wm = wave >> 1;
    const int kc = (tid & 7) * 8;
    const int lrow = tid >> 3;
    u32x4 ra[4], rb[4];
    {
        const long oa = koa(kc);
#pragma unroll
        for (int i = 0; i < 4; ++i) {
            ra[i] = *(const u32x4*)(ap[i] + oa);
            rb[i] = *(const u32x4*)(bp[i] + kc);
        }
    }
    for (int k0 = 0; k0 < K; k0 += 64) {
        __syncthreads();
#pragma unroll
        for (int i = 0; i < 4; ++i) {
            *(u32x4*)(sA + (lrow + 32 * i) * KSTR + kc) = ra[i];
            *(u32x4*)(sB + (lrow + 32 * i) * KSTR + kc) = rb[i];
        }
        __syncthreads();
        if (k0 + 64 < K) {
            const long oa = koa(k0 + 64 + kc);
#pragma unroll
            for (int i = 0; i < 4; ++i) {
                ra[i] = *(const u32x4*)(ap[i] + oa);
                rb[i] = *(const u32x4*)(bp[i] + (k0 + 64 + kc));
            }
        }
#pragma unroll
        for (int ks = 0; ks < 2; ++ks) {
            bf16x8 af[4], bfr[4];
#pragma unroll
            for (int j = 0; j < 4; ++j)
                af[j] = *(const bf16x8*)(sA + (wm * 64 + j * 16 + (lane & 15)) * KSTR + ks * 32 + (lane >> 4) * 8);
#pragma unroll
            for (int i = 0; i < 4; ++i)
                bfr[i] = *(const bf16x8*)(sB + (wn * 64 + i * 16 + (lane & 15)) * KSTR + ks * 32 + (lane >> 4) * 8);
#pragma unroll
            for (int i = 0; i < 4; ++i)
#pragma unroll
                for (int j = 0; j < 4; ++j) acc[i][j] = MFMA(bfr[i], af[j], acc[i][j]);
        }
    }
}
__device__ __forceinline__ void acc_zero(f32x4 (&acc)[4][4]) {
#pragma unroll
    for (int i = 0; i < 4; ++i)
#pragma unroll
        for (int j = 0; j < 4; ++j) acc[i][j] = f32x4{0.f, 0.f, 0.f, 0.f};
}
#define EPI_COORDS                                         \
    const int lane_ = tid__ & 63, wave_ = tid__ >> 6; \
    const int wn_ = wave_ & 1, wm_ = wave_ >> 1;
#define EPI_M(j) (wm_ * 64 + (j) * 16 + (lane_ & 15))
#define EPI_N(i) (wn_ * 64 + (i) * 16 + (lane_ >> 4) * 4)

__device__ __forceinline__ void xjob(const Params& p, int j, const float*& src, u16*& dst, int& nb, int& K, int& N) {
    switch (j) {
        case 0: src = p.w_in; dst = p.wt_in; nb = 4; K = 1024; N = NIN; break;
        case 1: src = p.w_br_sb; dst = p.wt_brs; nb = 4; K = 512; N = 1024; break;
        case 2: src = p.w_br_nsa; dst = p.wt_brn; nb = 4; K = 512; N = 1024; break;
        case 3: src = p.w_o; dst = p.wt_o; nb = 4; K = 1024; N = 1024; break;
        case 4: src = p.w_ple_gate; dst = p.wt_pg; nb = 4; K = 1024; N = 1024; break;
        case 5: src = p.w_ple_proj; dst = p.wt_pp; nb = 4; K = 256; N = 1024; break;
        case 6: src = p.w_gu; dst = p.wt_gu; nb = 128; K = 1024; N = 2048; break;
        case 7: src = p.w_down; dst = p.wt_dn; nb = 128; K = 1024; N = 1024; break;
        case 8: src = p.w_cmp1; dst = p.wt_c1; nb = 8; K = 2048; N = 128; break;
        default: src = p.w_cmp2; dst = p.wt_c2; nb = 8; K = 128; N = 64; break;
    }
}
__device__ __forceinline__ int xjob_tiles(int nb, int K, int N) { return nb * (K / 128) * ((N + 127) / 128); }

__device__ __forceinline__ void phase_prologue(const Params& p, unsigned* ctr) {
    const int tid = tid__;
    int ntr = 0;
    for (int j = 0; j < 10; ++j) {
        const float* s; u16* d; int nb, K, N;
        xjob(p, j, s, d, nb, K, N);
        ntr += xjob_tiles(nb, K, N);
    }
    const int n_x = TT * DD / 8192, n_p = 4 * TT * 256 / 8192, n_r = 16, n_b = 16;
    const int total = ntr + n_x + n_p + n_r + n_b;
    float* st = (float*)g_smem;
    WorkQ q; q.init(ctr, tid__ == 0);
    for (;;) {
        int it = q.next();
        if (it >= total) break;
        it = (it < n_b + n_r) ? (ntr + n_x + n_p + (it < n_b ? n_r + it : it - n_b)) : it - (n_b + n_r);
        if (it < ntr) {
            const float* src = nullptr; u16* dst = nullptr; int nb = 0, K = 0, N = 0;
            int rem = it;
            for (int j = 0; j < 10; ++j) {
                xjob(p, j, src, dst, nb, K, N);
                int nt = xjob_tiles(nb, K, N);
                if (rem < nt) break;
                rem -= nt;
            }
            const int ktn = K / 128, ntn = (N + 127) / 128;
            const int tpm = ktn * ntn;
            const int b = rem / tpm; rem -= b * tpm;
            const int kt = rem % ktn, nt = rem / ktn;
            src += (long)b * K * N; dst += (long)b * K * N;
            const int k0 = kt * 128, n0 = nt * 128;
            u16* st16 = (u16*)g_smem;
            float4 v[16];
#pragma unroll
            for (int i = 0; i < 16; ++i) {
                const int k = (tid >> 5) + 8 * i, n = (tid & 31) * 4;
                v[i] = make_float4(0.f, 0.f, 0.f, 0.f);
                if (n0 + n < N) v[i] = *(const float4*)(src + (long)(k0 + k) * N + n0 + n);
            }
#pragma unroll
            for (int i = 0; i < 16; ++i) {
                const int k = (tid >> 5) + 8 * i, n = (tid & 31) * 4;
                st_bf4(st16 + k * 136 + n, v[i].x, v[i].y, v[i].z, v[i].w);
            }
            __syncthreads();
#pragma unroll
            for (int i = 0; i < 8; ++i) {
                const int n = (tid >> 4) + 16 * i, k8 = (tid & 15) * 8;
                if (n0 + n < N) {
                    uint4 u;
                    u.x = (unsigned)st16[(k8 + 0) * 136 + n] | ((unsigned)st16[(k8 + 1) * 136 + n] << 16);
                    u.y = (unsigned)st16[(k8 + 2) * 136 + n] | ((unsigned)st16[(k8 + 3) * 136 + n] << 16);
                    u.z = (unsigned)st16[(k8 + 4) * 136 + n] | ((unsigned)st16[(k8 + 5) * 136 + n] << 16);
                    u.w = (unsigned)st16[(k8 + 6) * 136 + n] | ((unsigned)st16[(k8 + 7) * 136 + n] << 16);
                    *(uint4*)(dst + (long)(n0 + n) * K + k0 + k8) = u;
                }
            }
        } else if (it < ntr + n_x + n_p) {
            int e = it - ntr;
            const float* src; u16* db; float* df = nullptr;
            if (e < n_x) { src = p.x + (long)e * 8192; db = p.hb + (long)e * 8192; df = p.hf + (long)e * 8192; }
            else { e -= n_x; src = p.p + (long)e * 8192; db = p.pb + (long)e * 8192; }
#pragma unroll
            for (int i = 0; i < 8; ++i) {
                int o = i * 1024 + tid * 4;
                float4 v = *(const float4*)(src + o);
                if (df) *(float4*)(df + o) = v;
                st_bf4(db + o, v.x, v.y, v.z, v.w);
            }
        } else if (it < ntr + n_x + n_p + n_r) {
            int e0 = (it - ntr - n_x - n_p) * 8192;
            for (int i = 0; i < 32; ++i) {
                int idx = e0 + i * 256 + tid;
                int k = idx & 1023, le = idx >> 10, e = le & 31, l = le >> 5;
                float w = p.w_router[((long)l * 1024 + k) * 32 + e];
                u16 hi = f2bf(w); u16 lo = f2bf(w - bf2f(hi));
                u16* d = p.wt_r + (long)le * 3072;
                d[k] = hi; d[1024 + k] = lo; d[2048 + k] = hi;
            }
        } else {
            const int bi = it - ntr - n_x - n_p - n_r;
            const int lk = bi >> 1, h = (bi & 1) * 64 + (tid & 63), jp = tid >> 6;
            const float* pe = p.pe_cmp + (long)lk * 2048 + jp * 512;
            const float* w1 = p.w_cmp1 + ((long)lk * 2048 + jp * 512) * 128 + h;
            float sacc = 0.f;
#pragma unroll 8
            for (int j = 0; j < 512; ++j) sacc += pe[j] * w1[(long)j * 128];
            st[tid] = sacc;
            __syncthreads();
            if (tid < 64) p.cbias[lk * 128 + h] = (st[tid] + st[tid + 64]) + (st[tid + 128] + st[tid + 192]);
        }
    }
}

__device__ __forceinline__ void phase_gemm_in(const Params& p, int l, unsigned* ctr) {
    const int NTN = (NIN + 127) / 128;
    const int tid = tid__;
    const u16* W = p.wt_in + (long)l * NIN * 1024;
    XQ q; q.init(ctr, 32 * NTN, tid__ == 0);
    for (;;) {
        int it = q.next();
        if (it < 0) break;
        int mt, nt; xq_decode(it, 32, NTN, mt, nt);
        const int m0 = mt * 128, n0 = nt * 128;
        const u16* ap[4]; const u16* bp[4];
#pragma unroll
        for (int i = 0; i < 4; ++i) {
            int r = (tid >> 3) + 32 * i;
            ap[i] = p.hb + (long)(m0 + r) * 1024;
            int n = n0 + r; if (n > NIN - 1) n = NIN - 1;
            bp[i] = W + (long)n * 1024;
        }
        f32x4 acc[4][4]; acc_zero(acc);
        gemm_main(acc, ap, bp, 1024, KId());
        EPI_COORDS
#pragma unroll
        for (int i = 0; i < 4; ++i)
#pragma unroll
            for (int j = 0; j < 4; ++j) {
                int m = m0 + EPI_M(j), n = n0 + EPI_N(i);
                if (n < NIN) st_bf4(p.yb + (long)m * NIN + n, acc[i][j][0], acc[i][j][1], acc[i][j][2], acc[i][j][3]);
            }
    }
}

struct KCmp {
    __device__ __forceinline__ long operator()(int k) const { return (long)(k >> 6) * NIN + (k & 63); }
};
__device__ __forceinline__ void tile_cmp1(const Params& p, int l, int it) {
    const int tid = tid__;
    const int kv = it >> 4, mt = it & 15;
    const u16* W = p.wt_c1 + (long)(l * 2 + kv) * 128 * 2048;
    const u16* ap[4]; const u16* bp[4];
#pragma unroll
    for (int i = 0; i < 4; ++i) {
        int r = (tid >> 3) + 32 * i;
        int mrow = mt * 128 + r;
        int c = mrow & 127, bg = mrow >> 7, g = bg & 1, b = bg >> 1;
        ap[i] = p.yb + (long)(b * SS + c * 32) * NIN + (kv ? C_VC : C_KC) + g * 64;
        bp[i] = W + (long)r * 2048;
    }
    f32x4 acc[4][4]; acc_zero(acc);
    gemm_main(acc, ap, bp, 2048, KCmp());
    EPI_COORDS
    const float* cb = p.cbias + (l * 2 + kv) * 128;
#pragma unroll
    for (int i = 0; i < 4; ++i)
#pragma unroll
        for (int j = 0; j < 4; ++j) {
            int m = mt * 128 + EPI_M(j), n = EPI_N(i);
            float v[4];
#pragma unroll
            for (int r = 0; r < 4; ++r) { float a = acc[i][j][r] + cb[n + r]; v[r] = a * sigmoidf_(a); }
            st_bf4(p.hid + ((long)kv * 2048 + m) * 128 + n, v[0], v[1], v[2], v[3]);
        }
}
__device__ __forceinline__ void phase_cmp2(const Params& p, int l, unsigned* ctr) {
    const int tid = tid__;
    WorkQ q; q.init(ctr, tid__ == 0);
    for (;;) {
        int it = q.next();
        if (it >= 32) break;
        const int kv = it >> 4, mt = it & 15;
        const u16* W = p.wt_c2 + (long)(l * 2 + kv) * 64 * 128;
        const u16* ap[4]; const u16* bp[4];
#pragma unroll
        for (int i = 0; i < 4; ++i) {
            int r = (tid >> 3) + 32 * i;
            ap[i] = p.hid + ((long)kv * 2048 + mt * 128 + r) * 128;
            bp[i] = W + (long)(r & 63) * 128;
        }
        f32x4 acc[4][4]; acc_zero(acc);
        gemm_main(acc, ap, bp, 128, KId());
        EPI_COORDS
#pragma unroll
        for (int i = 0; i < 4; ++i)
#pragma unroll
            for (int j = 0; j < 4; ++j) {
                int m = mt * 128 + EPI_M(j), n = EPI_N(i);
                if (n < 64) st_bf4(p.kvc + ((long)kv * 2048 + m) * 64 + n, acc[i][j][0], acc[i][j][1], acc[i][j][2], acc[i][j][3]);
            }
    }
}

struct AttnLds {
    u16* K;
    u16* Vt;
    float* S;
    u16* P;
};
__device__ __forceinline__ AttnLds attn_lds() {
    AttnLds a;
    a.K = (u16*)g_smem;
    a.Vt = (u16*)(g_smem + 18432);
    a.S = (float*)(g_smem + 18432 + 17408) + (tid__ >> 6) * 16 * SSTR;
    a.P = (u16*)(g_smem + 18432 + 17408 + 17408) + (tid__ >> 6) * 16 * KSTR;
    return a;
}
__device__ __forceinline__ void load_k_tile(u16* sK, int koff, const u16* base, long stride) {
    const int tid = tid__, key = tid >> 2, ch = (tid & 3) * 16;
    const u16* g = base + (long)key * stride + ch;
    uint4 a = *(const uint4*)g, b = *(const uint4*)(g + 8);
    *(uint4*)(sK + (koff + key) * KSTR + ch) = a;
    *(uint4*)(sK + (koff + key) * KSTR + ch + 8) = b;
}
__device__ __forceinline__ void load_v_tile(u16* sVt, int koff, const u16* base, long stride) {
    const int tid = tid__, key = tid & 63, d0 = (tid >> 6) * 16;
    const u16* g = base + (long)key * stride + d0;
    uint4 a = *(const uint4*)g, b = *(const uint4*)(g + 8);
    unsigned w[8] = {a.x, a.y, a.z, a.w, b.x, b.y, b.z, b.w};
#pragma unroll
    for (int i = 0; i < 8; ++i) {
        sVt[(d0 + 2 * i) * VSTR + koff + key] = (u16)(w[i] & 0xffffu);
        sVt[(d0 + 2 * i + 1) * VSTR + koff + key] = (u16)(w[i] >> 16);
    }
}
__device__ __forceinline__ void wave_qk(const AttnLds& L, int koff, const bf16x8 (&qf)[2]) {
    const int lane = tid__ & 63, quad = lane >> 4, c = lane & 15;
#pragma unroll
    for (int nt = 0; nt < 4; ++nt) {
        f32x4 a = {0.f, 0.f, 0.f, 0.f};
#pragma unroll
        for (int ks = 0; ks < 2; ++ks) {
            bf16x8 kf = *(const bf16x8*)(L.K + (koff + nt * 16 + c) * KSTR + ks * 32 + quad * 8);
            a = MFMA(qf[ks], kf, a);
        }
#pragma unroll
        for (int r = 0; r < 4; ++r) L.S[(quad * 4 + r) * SSTR + nt * 16 + c] = a[r];
    }
}
__device__ __forceinline__ void wave_pv(const AttnLds& L, int koff, f32x4 (&o)[4]) {
    const int lane = tid__ & 63, quad = lane >> 4, c = lane & 15;
#pragma unroll
    for (int ks = 0; ks < 2; ++ks) {
        bf16x8 pf = *(const bf16x8*)(L.P + c * KSTR + ks * 32 + quad * 8);
#pragma unroll
        for (int dt = 0; dt < 4; ++dt) {
            bf16x8 vf = *(const bf16x8*)(L.Vt + (dt * 16 + c) * VSTR + koff + ks * 32 + quad * 8);
            o[dt] = MFMA(pf, vf, o[dt]);
        }
    }
}
__device__ __forceinline__ void read_s16(const AttnLds& L, int row, int part, float (&z)[16]) {
#pragma unroll
    for (int i = 0; i < 4; ++i) {
        float4 v = *(const float4*)(L.S + row * SSTR + part * 16 + i * 4);
        z[i * 4 + 0] = v.x; z[i * 4 + 1] = v.y; z[i * 4 + 2] = v.z; z[i * 4 + 3] = v.w;
    }
}
__device__ __forceinline__ void write_p16(const AttnLds& L, int row, int part, const float (&pv)[16]) {
    uint4 a, b;
    a.x = (unsigned)f2bf(pv[0]) | ((unsigned)f2bf(pv[1]) << 16);
    a.y = (unsigned)f2bf(pv[2]) | ((unsigned)f2bf(pv[3]) << 16);
    a.z = (unsigned)f2bf(pv[4]) | ((unsigned)f2bf(pv[5]) << 16);
    a.w = (unsigned)f2bf(pv[6]) | ((unsigned)f2bf(pv[7]) << 16);
    b.x = (unsigned)f2bf(pv[8]) | ((unsigned)f2bf(pv[9]) << 16);
    b.y = (unsigned)f2bf(pv[10]) | ((unsigned)f2bf(pv[11]) << 16);
    b.z = (unsigned)f2bf(pv[12]) | ((unsigned)f2bf(pv[13]) << 16);
    b.w = (unsigned)f2bf(pv[14]) | ((unsigned)f2bf(pv[15]) << 16);
    *(uint4*)(L.P + row * KSTR + part * 16) = a;
    *(uint4*)(L.P + row * KSTR + part * 16 + 8) = b;
}
__device__ __forceinline__ float row4_max(float v) {
    v = fmaxf(v, __shfl_xor(v, 1));
    v = fmaxf(v, __shfl_xor(v, 2));
    return v;
}
__device__ __forceinline__ float row4_sum(float v) {
    v += __shfl_xor(v, 1);
    v += __shfl_xor(v, 2);
    return v;
}

__device__ __forceinline__ void item_sb(const Params& p, int it) {
    const int tid = tid__, lane = tid & 63, wave = tid >> 6, quad = lane >> 4, c = lane & 15;
    const int qb = it & 63, h = (it >> 6) & 7, b = it >> 9;
    const int t0 = qb * 64;
    AttnLds L = attn_lds();
    bf16x8 qf[2];
    {
        const u16* g = p.yb + (long)(b * SS + t0 + wave * 16 + c) * NIN + C_SBQ + h * 64 + quad * 8;
        qf[0] = *(const bf16x8*)g;
        qf[1] = *(const bf16x8*)(g + 32);
    }
    const int row = lane >> 2, part = lane & 3;
    const int t = t0 + wave * 16 + row;
    float R = 0.f;
    f32x4 o[4];
#pragma unroll
    for (int dt = 0; dt < 4; ++dt) o[dt] = f32x4{0.f, 0.f, 0.f, 0.f};
    for (int kb = qb; kb >= 0; --kb) {
        __syncthreads();
        const u16* kbase = p.yb + (long)(b * SS + kb * 64) * NIN + h * 64;
        load_k_tile(L.K, 0, kbase + C_SBK, NIN);
        load_v_tile(L.Vt, 0, kbase + C_SBV, NIN);
        __syncthreads();
        wave_qk(L, 0, qf);
        __syncthreads();
        float z[16], lat[16];
        read_s16(L, row, part, z);
        float run = 0.f;
#pragma unroll
        for (int i = 15; i >= 0; --i) {
            const int key = kb * 64 + part * 16 + i;
            const bool valid = key < t;
            const float zz = z[i] * 0.125f;
            const float sp = fmaxf(zz, 0.f) + __logf(1.f + __expf(-fabsf(zz)));
            lat[i] = run;
            z[i] = valid ? (zz - sp) : -1e30f;
            run += valid ? -sp : 0.f;
        }
        const int lb = lane & ~3;
        const float t0_ = __shfl(run, lb), t1_ = __shfl(run, lb + 1), t2_ = __shfl(run, lb + 2), t3_ = __shfl(run, lb + 3);
        float off = R;
        if (part < 3) off += t3_;
        if (part < 2) off += t2_;
        if (part < 1) off += t1_;
        float pv[16];
#pragma unroll
        for (int i = 0; i < 16; ++i) pv[i] = (z[i] > -1e29f) ? __expf(z[i] + lat[i] + off) : 0.f;
        write_p16(L, row, part, pv);
        R += (t0_ + t1_) + (t2_ + t3_);
        const int done = __syncthreads_and(R < -110.f);
        wave_pv(L, 0, o);
        if (done) break;
    }
#pragma unroll
    for (int dt = 0; dt < 4; ++dt)
#pragma unroll
        for (int r = 0; r < 4; ++r)
            p.ysb[(long)(b * SS + t0 + wave * 16 + quad * 4 + r) * 512 + h * 64 + dt * 16 + c] = f2bf(o[dt][r]);
}

__device__ __forceinline__ void phase_cmp1_sb(const Params& p, int l, unsigned* ctr) {
    const int total = 32 + 8 * 8 * 64;
    WorkQ q; q.init(ctr, tid__ == 0);
    for (;;) {
        int it = q.next();
        if (it >= total) break;
        if (it < 32) tile_cmp1(p, l, it);
        else item_sb(p, it - 32);
    }
}

template <int MODE>
__device__ __forceinline__ void nsa_step(const AttnLds& L, const bf16x8 (&qf)[2], f32x4 (&o)[4], float& m, float& l,
                                         float slope, int t, int kpos0, bool rowsel) {
    const int lane = tid__ & 63, quad = lane >> 4;
    const int row = lane >> 2, part = lane & 3;
    wave_qk(L, 0, qf);
    __syncthreads();
    float z[16];
    read_s16(L, row, part, z);
    float pm = -1e30f;
#pragma unroll
    for (int i = 0; i < 16; ++i) {
        const int dist = t - (kpos0 + part * 16 + i);
        bool valid = dist >= 0;
        if (MODE == 1) valid = valid && rowsel;
        if (MODE == 2) valid = valid && (dist < 512);
        z[i] = valid ? (z[i] * 0.125f - slope * (float)dist) : -1e30f;
        pm = fmaxf(pm, z[i]);
    }
    pm = row4_max(pm);
    const float mn = fmaxf(m, pm);
    const float alpha = __expf(m - mn);
    float ps = 0.f;
#pragma unroll
    for (int i = 0; i < 16; ++i) {
        z[i] = (z[i] > -1e29f) ? __expf(z[i] - mn) : 0.f;
        ps += z[i];
    }
    ps = row4_sum(ps);
    l = l * alpha + ps;
    m = mn;
    write_p16(L, row, part, z);
    float al[4];
#pragma unroll
    for (int r = 0; r < 4; ++r) al[r] = __shfl(alpha, (quad * 4 + r) * 4);
    __syncthreads();
#pragma unroll
    for (int dt = 0; dt < 4; ++dt)
#pragma unroll
        for (int r = 0; r < 4; ++r) o[dt][r] *= al[r];
    wave_pv(L, 0, o);
    __syncthreads();
}

__device__ __forceinline__ void item_nsa(const Params& p, int it) {
    const int tid = tid__, lane = tid & 63, wave = tid >> 6, quad = lane >> 4, c = lane & 15;
    const int qb = 63 - (it >> 4), bg = it & 15, g = bg & 1, b = bg >> 1;
    const int t0 = qb * 64;
    AttnLds L = attn_lds();
    const int row = lane >> 2, part = lane & 3;
    const int t = t0 + wave * 16 + row;
    const long tokbase = (long)b * SS + t0 + wave * 16;
    float* ynf = p.ynf;
    const int nct = (2 * qb + 2 > 64) ? 2 : 1;
    const int nv = (t + 1) >> 5;
    __syncthreads();
    for (int ct = 0; ct < nct; ++ct) {
        load_k_tile(L.K, ct * 64, p.kvc + ((long)(b * 2 + g) * 128 + ct * 64) * 64, 64);
        load_v_tile(L.Vt, ct * 64, p.kvc + ((long)2048 + (b * 2 + g) * 128 + ct * 64) * 64, 64);
    }
    __syncthreads();
    float imp[2][8];
#pragma unroll
    for (int a = 0; a < 2; ++a)
#pragma unroll
        for (int j = 0; j < 8; ++j) imp[a][j] = 0.f;
#pragma unroll 1
    for (int r = 0; r < 4; ++r) {
        const float slope = exp2f(-(float)(g * 4 + r + 1));
        float m = -1e30f, l = 0.f;
        bf16x8 qfa[2];
        {
            const u16* gq = p.yb + (tokbase + c) * NIN + C_NQ + (g * 4 + r) * 64 + quad * 8;
            qfa[0] = *(const bf16x8*)gq;
            qfa[1] = *(const bf16x8*)(gq + 32);
        }
        for (int ct = 0; ct < nct; ++ct) {
            wave_qk(L, ct * 64, qfa);
            __syncthreads();
            float z[16];
            read_s16(L, row, part, z);
            float pm = -1e30f;
#pragma unroll
            for (int i = 0; i < 16; ++i) {
                const int cc = ct * 64 + part * 16 + i;
                const bool valid = cc < nv;
                z[i] = valid ? (z[i] * 0.125f - slope * (float)(t - (cc * 32 + 31))) : -1e30f;
                pm = fmaxf(pm, z[i]);
            }
            pm = row4_max(pm);
            const float mn = fmaxf(m, pm);
            float ps = 0.f;
#pragma unroll
            for (int i = 0; i < 16; ++i) ps += (z[i] > -1e29f) ? __expf(z[i] - mn) : 0.f;
            ps = row4_sum(ps);
            l = l * __expf(m - mn) + ps;
            m = mn;
            __syncthreads();
        }
        const float inv = (l > 0.f) ? 1.f / l : 0.f;
        f32x4 o[4];
#pragma unroll
        for (int dt = 0; dt < 4; ++dt) o[dt] = f32x4{0.f, 0.f, 0.f, 0.f};
#pragma unroll 1
        for (int ct = 0; ct < nct; ++ct) {
            wave_qk(L, ct * 64, qfa);
            __syncthreads();
            float z[16];
            read_s16(L, row, part, z);
#pragma unroll
            for (int i = 0; i < 16; ++i) {
                const int cc = ct * 64 + part * 16 + i;
                const bool valid = cc < nv;
                const float s = z[i] * 0.125f - slope * (float)(t - (cc * 32 + 31));
                z[i] = valid ? __expf(s - m) * inv : 0.f;
            }
            const float f0 = (ct == 0) ? 1.f : 0.f, f1 = 1.f - f0;
#pragma unroll
            for (int j = 0; j < 8; ++j) {
                const float pr = z[2 * j] + z[2 * j + 1];
                imp[0][j] += f0 * pr;
                imp[1][j] += f1 * pr;
            }
            write_p16(L, row, part, z);
            __syncthreads();
            wave_pv(L, ct * 64, o);
            __syncthreads();
        }
#pragma unroll
        for (int rr = 0; rr < 4; ++rr) {
            const long tok = tokbase + quad * 4 + rr;
            const float gt = sigmoidf_(bf2f(p.yb[tok * NIN + C_NG + (g * 4 + r) * 3 + 0]));
#pragma unroll
            for (int dt = 0; dt < 4; ++dt) ynf[tok * 512 + (g * 4 + r) * 64 + dt * 16 + c] = gt * o[dt][rr];
        }
    }
#pragma unroll
    for (int a = 0; a < 2; ++a)
#pragma unroll
        for (int j = 0; j < 8; ++j) L.S[row * SSTR + a * 32 + part * 8 + j] = imp[a][j];
    __syncthreads();
    unsigned long long un = 0ull;
#ifndef NSA_NOTOPK
#define NSA_NOTOPK 0
#endif
#pragma unroll 1
    for (int rr = 0; rr < (NSA_NOTOPK ? 0 : 16); ++rr) {
        float v = L.S[rr * SSTR + lane];
        const bool forced = (lane == 0) || (lane == qb) || (lane == qb - 1);
        const bool validb = lane <= qb;
        v = forced ? 1e6f : (validb ? v : -1e30f);
        int rank = 0;
#pragma unroll 8
        for (int i = 0; i < 64; ++i) {
            const float vi = __shfl(v, i);
            rank += ((vi > v) || (vi == v && i < lane)) ? 1 : 0;
        }
        const unsigned long long mk = __ballot((rank < 16) && validb);
        if (lane == 0) s_mask[wave][rr] = mk;
        un |= mk;
    }
    if (lane == 0) s_union[wave] = un;
    __syncthreads();
    const unsigned long long rowmask = s_mask[wave][row];
    unsigned long long umask;
    {
        const unsigned long long um_ = s_union[0] | s_union[1] | s_union[2] | s_union[3];
        const unsigned lo_ = __builtin_amdgcn_readfirstlane((unsigned)um_), hi_ = __builtin_amdgcn_readfirstlane((unsigned)(um_ >> 32));
        umask = ((unsigned long long)hi_ << 32) | lo_;
    }
#ifndef NSA_HPB
#define NSA_HPB 1
#endif
#ifndef NSA_NOBC
#define NSA_NOBC 0
#endif
#pragma unroll 1
    for (int hp = 0; hp < (NSA_NOBC ? 0 : 4 / NSA_HPB); ++hp) {
#pragma unroll 1
        for (int mode = 1; mode <= 2; ++mode) {
            f32x4 o[NSA_HPB][4];
            float m[NSA_HPB], l[NSA_HPB];
#pragma unroll
            for (int r = 0; r < NSA_HPB; ++r) {
                m[r] = -1e30f; l[r] = 0.f;
#pragma unroll
                for (int dt = 0; dt < 4; ++dt) o[r][dt] = f32x4{0.f, 0.f, 0.f, 0.f};
            }
            const int kb_lo = (mode == 1) ? 0 : ((qb - 8 > 0) ? qb - 8 : 0);
            const int colk = (mode == 1) ? C_KS : C_KW, colv = (mode == 1) ? C_VS : C_VW;
            for (int kb = kb_lo; kb <= qb; ++kb) {
                if (mode == 1 && !((umask >> kb) & 1ull)) continue;
                const u16* kbase = p.yb + (long)(b * SS + kb * 64) * NIN + g * 64;
                bf16x8 qf[NSA_HPB][2];
#pragma unroll
                for (int r = 0; r < NSA_HPB; ++r) {
                    const u16* gq = p.yb + (tokbase + c) * NIN + C_NQ + (g * 4 + hp * NSA_HPB + r) * 64 + quad * 8;
                    qf[r][0] = *(const bf16x8*)gq;
                    qf[r][1] = *(const bf16x8*)(gq + 32);
                }
                load_k_tile(L.K, 0, kbase + colk, NIN);
                load_v_tile(L.Vt, 0, kbase + colv, NIN);
                __syncthreads();
                const bool rowsel = (rowmask >> kb) & 1ull;
#pragma unroll
                for (int r = 0; r < NSA_HPB; ++r) {
                    const float slope = exp2f(-(float)(g * 4 + hp * NSA_HPB + r + 1));
                    if (mode == 1) nsa_step<1>(L, qf[r], o[r], m[r], l[r], slope, t, kb * 64, rowsel);
                    else nsa_step<2>(L, qf[r], o[r], m[r], l[r], slope, t, kb * 64, rowsel);
                }
            }
#pragma unroll
            for (int r = 0; r < NSA_HPB; ++r) {
                const int hh = g * 4 + hp * NSA_HPB + r;
#pragma unroll
                for (int rr = 0; rr < 4; ++rr) {
                    const long tok = tokbase + quad * 4 + rr;
                    const float lr = __shfl(l[r], (quad * 4 + rr) * 4);
                    const float gt = sigmoidf_(bf2f(p.yb[tok * NIN + C_NG + hh * 3 + mode])) / lr;
#pragma unroll
                    for (int dt = 0; dt < 4; ++dt) {
                        const long oi = tok * 512 + hh * 64 + dt * 16 + c;
                        const float v = ynf[oi] + gt * o[r][dt][rr];
                        if (mode == 1) ynf[oi] = v;
                        else p.ynsa[oi] = f2bf(v);
                    }
                }
            }
        }
    }
}
__device__ __forceinline__ void phase_nsa(const Params& p, unsigned* ctr) {
    WorkQ q; q.init(ctr, tid__ == 0);
    for (;;) {
        int it = q.next();
        if (it >= 1024) break;
        item_nsa(p, it);
    }
}

__device__ __forceinline__ void phase_br(const Params& p, int l, unsigned* ctr) {
    const int tid = tid__;
    XQ q; q.init(ctr, 32 * 8, tid__ == 0);
    for (;;) {
        int it = q.next();
        if (it < 0) break;
        int mt, nt; xq_decode(it, 32, 8, mt, nt);
        const int m0 = mt * 128, n0 = nt * 128;
        const u16* ap[4]; const u16* bp[4];
        f32x4 acc[4][4];
        acc_zero(acc);
#pragma unroll
        for (int i = 0; i < 4; ++i) {
            int r = (tid >> 3) + 32 * i;
            ap[i] = p.ysb + (long)(m0 + r) * 512;
            bp[i] = p.wt_brs + ((long)l * 1024 + n0 + r) * 512;
        }
        gemm_main(acc, ap, bp, 512, KId());
        EPI_COORDS
#pragma unroll
        for (int i = 0; i < 4; ++i)
#pragma unroll
            for (int j = 0; j < 4; ++j) {
                const int m = m0 + EPI_M(j), n = n0 + EPI_N(i);
                const uint2 ga = *(const uint2*)(p.yb + (long)m * NIN + C_GSB + n);
                float4 o;
                o.x = sigmoidf_(bf2f((u16)(ga.x & 0xffff))) * acc[i][j][0];
                o.y = sigmoidf_(bf2f((u16)(ga.x >> 16))) * acc[i][j][1];
                o.z = sigmoidf_(bf2f((u16)(ga.y & 0xffff))) * acc[i][j][2];
                o.w = sigmoidf_(bf2f((u16)(ga.y >> 16))) * acc[i][j][3];
                *(float4*)(p.pre1 + (long)m * 1024 + n) = o;
            }
        acc_zero(acc);
#pragma unroll
        for (int i = 0; i < 4; ++i) {
            int r = (tid >> 3) + 32 * i;
            ap[i] = p.ynsa + (long)(m0 + r) * 512;
            bp[i] = p.wt_brn + ((long)l * 1024 + n0 + r) * 512;
        }
        gemm_main(acc, ap, bp, 512, KId());
#pragma unroll
        for (int i = 0; i < 4; ++i)
#pragma unroll
            for (int j = 0; j < 4; ++j) {
                const int m = m0 + EPI_M(j), n = n0 + EPI_N(i);
                const uint2 gb = *(const uint2*)(p.yb + (long)m * NIN + C_GNSA + n);
                const float4 st = *(const float4*)(p.pre1 + (long)m * 1024 + n);
                st_bf4(p.merged + (long)m * 1024 + n,
                       st.x + sigmoidf_(bf2f((u16)(gb.x & 0xffff))) * acc[i][j][0],
                       st.y + sigmoidf_(bf2f((u16)(gb.x >> 16))) * acc[i][j][1],
                       st.z + sigmoidf_(bf2f((u16)(gb.y & 0xffff))) * acc[i][j][2],
                       st.w + sigmoidf_(bf2f((u16)(gb.y >> 16))) * acc[i][j][3]);
            }
    }
}
__device__ __forceinline__ void phase_wo(const Params& p, int l, unsigned* ctr) {
    const int tid = tid__;
    XQ q; q.init(ctr, 32 * 8, tid__ == 0);
    for (;;) {
        int it = q.next();
        if (it < 0) break;
        int mt, nt; xq_decode(it, 32, 8, mt, nt);
        const int m0 = mt * 128, n0 = nt * 128;
        const u16* ap[4]; const u16* bp[4];
        f32x4 acc[4][4]; acc_zero(acc);
#pragma unroll
        for (int i = 0; i < 4; ++i) {
            int r = (tid >> 3) + 32 * i;
            ap[i] = p.merged + (long)(m0 + r) * 1024;
            bp[i] = p.wt_o + ((long)l * 1024 + n0 + r) * 1024;
        }
        gemm_main(acc, ap, bp, 1024, KId());
        EPI_COORDS
#pragma unroll
        for (int i = 0; i < 4; ++i)
#pragma unroll
            for (int j = 0; j < 4; ++j) {
                const int m = m0 + EPI_M(j), n = n0 + EPI_N(i);
                const float4 hv = *(const float4*)(p.hf + (long)m * 1024 + n);
                float4 o;
                o.x = DN_ALPHA * hv.x + acc[i][j][0]; o.y = DN_ALPHA * hv.y + acc[i][j][1];
                o.z = DN_ALPHA * hv.z + acc[i][j][2]; o.w = DN_ALPHA * hv.w + acc[i][j][3];
                *(float4*)(p.pre1 + (long)m * 1024 + n) = o;
            }
    }
}
__device__ __forceinline__ float wave_sum(float v) {
#pragma unroll
    for (int s = 32; s >= 1; s >>= 1) v += __shfl_xor(v, s);
    return v;
}
__device__ __forceinline__ void phase_ln(const Params& p, int l, int mode, unsigned* ctr) {
    const int lane = tid__ & 63, wave = tid__ >> 6;
    const float* gam = (mode == 1 ? p.ln1_g : p.ln2_g) + l * 1024;
    const float* bet = (mode == 1 ? p.ln1_b : p.ln2_b) + l * 1024;
    WorkQ q; q.init(ctr, tid__ == 0);
    for (;;) {
        int it = q.next();
        if (it >= TT / 64) break;
        for (int rr = 0; rr < 16; rr += 2) {
            float v[2][16];
#pragma unroll
            for (int u = 0; u < 2; ++u) {
                const long row = (long)it * 64 + wave * 16 + rr + u;
#pragma unroll
                for (int i = 0; i < 4; ++i) {
                    const int col = i * 256 + lane * 4;
                    float4 a;
                    if (mode == 1) a = *(const float4*)(p.pre1 + row * 1024 + col);
                    else {
                        a = *(const float4*)(p.h1f + row * 1024 + col);
                        a.x *= DN_ALPHA; a.y *= DN_ALPHA; a.z *= DN_ALPHA; a.w *= DN_ALPHA;
                        const uint2 pl = *(const uint2*)(p.ple + row * 1024 + col);
                        a.x += bf2f((u16)(pl.x & 0xffff)); a.y += bf2f((u16)(pl.x >> 16));
                        a.z += bf2f((u16)(pl.y & 0xffff)); a.w += bf2f((u16)(pl.y >> 16));
#pragma unroll
                        for (int s4 = 0; s4 < 4; ++s4) {
                            const uint2 y = *(const uint2*)(p.y4 + (row * 4 + s4) * 1024 + col);
                            a.x += bf2f((u16)(y.x & 0xffff)); a.y += bf2f((u16)(y.x >> 16));
                            a.z += bf2f((u16)(y.y & 0xffff)); a.w += bf2f((u16)(y.y >> 16));
                        }
                    }
                    v[u][i * 4 + 0] = a.x; v[u][i * 4 + 1] = a.y; v[u][i * 4 + 2] = a.z; v[u][i * 4 + 3] = a.w;
                }
            }
#pragma unroll
            for (int u = 0; u < 2; ++u) {
                const long row = (long)it * 64 + wave * 16 + rr + u;
                float sm = 0.f;
#pragma unroll
                for (int i = 0; i < 16; ++i) sm += v[u][i];
                const float mean = wave_sum(sm) * (1.f / 1024.f);
                float s2 = 0.f;
#pragma unroll
                for (int i = 0; i < 16; ++i) { v[u][i] -= mean; s2 += v[u][i] * v[u][i]; }
                const float rstd = rsqrtf(wave_sum(s2) * (1.f / 1024.f) + 1e-5f);
#pragma unroll
                for (int i = 0; i < 4; ++i) {
                    const int col = i * 256 + lane * 4;
                    const float4 gg = *(const float4*)(gam + col), bb = *(const float4*)(bet + col);
                    float4 y;
                    y.x = v[u][i * 4 + 0] * rstd * gg.x + bb.x; y.y = v[u][i * 4 + 1] * rstd * gg.y + bb.y;
                    y.z = v[u][i * 4 + 2] * rstd * gg.z + bb.z; y.w = v[u][i * 4 + 3] * rstd * gg.w + bb.w;
                    if (mode == 1) {
                        *(float4*)(p.h1f + row * 1024 + col) = y;
                        const u16 h0 = f2bf(y.x), h1 = f2bf(y.y), h2 = f2bf(y.z), h3 = f2bf(y.w);
                        uint2 uu; uu.x = (unsigned)h0 | ((unsigned)h1 << 16); uu.y = (unsigned)h2 | ((unsigned)h3 << 16);
                        *(uint2*)(p.h1b + row * 1024 + col) = uu;
                        st_bf4(p.h1lo + row * 1024 + col, y.x - bf2f(h0), y.y - bf2f(h1), y.z - bf2f(h2), y.w - bf2f(h3));
                    } else {
                        if (l == 3) *(float4*)(p.out + row * 1024 + col) = y;
                        else {
                            *(float4*)(p.hf + row * 1024 + col) = y;
                            st_bf4(p.hb + row * 1024 + col, y.x, y.y, y.z, y.w);
                        }
                    }
                }
            }
        }
    }
}
struct KRouter {
    long dlo;
    __device__ __forceinline__ long operator()(int k) const { return (k < 2048) ? (long)(k & 1023) : (dlo + (k - 2048)); }
};
__device__ __forceinline__ void phase_router_ple(const Params& p, int l, unsigned* ctr) {
    const int tid = tid__;
    XQ q; q.init(ctr, 32 * 9, tid__ == 0);
    for (;;) {
        int it = q.next();
        if (it < 0) break;
        int mt, nt; xq_decode(it, 32, 9, mt, nt);
        const u16* ap[4]; const u16* bp[4];
        if (nt == 8) {
            const int m0 = mt * 128;
            f32x4 acc[4][4]; acc_zero(acc);
#pragma unroll
            for (int i = 0; i < 4; ++i) {
                int r = (tid >> 3) + 32 * i;
                ap[i] = p.h1b + (long)(m0 + r) * 1024;
                bp[i] = p.wt_r + ((long)l * 32 + (r & 31)) * 3072;
            }
            KRouter kr; kr.dlo = (long)(p.h1lo - p.h1b);
            gemm_main(acc, ap, bp, 3072, kr);
            EPI_COORDS
#pragma unroll
            for (int i = 0; i < 4; ++i)
#pragma unroll
                for (int j = 0; j < 4; ++j) {
                    const int m = m0 + EPI_M(j), n = EPI_N(i);
                    if (n < 32) {
                        const float4 bb = *(const float4*)(p.b_router + l * 32 + n);
                        float4 o; o.x = acc[i][j][0] + bb.x; o.y = acc[i][j][1] + bb.y; o.z = acc[i][j][2] + bb.z; o.w = acc[i][j][3] + bb.w;
                        *(float4*)(p.logits + (long)m * 32 + n) = o;
                    }
                }
        } else {
            const int m0 = mt * 128, n0 = nt * 128;
            f32x4 acc[4][4];
            acc_zero(acc);
#pragma unroll
            for (int i = 0; i < 4; ++i) {
                int r = (tid >> 3) + 32 * i;
                ap[i] = p.pb + ((long)l * TT + m0 + r) * 256;
                bp[i] = p.wt_pp + ((long)l * 1024 + n0 + r) * 256;
            }
            gemm_main(acc, ap, bp, 256, KId());
            EPI_COORDS
#pragma unroll
            for (int i = 0; i < 4; ++i)
#pragma unroll
                for (int j = 0; j < 4; ++j) {
                    const int m = m0 + EPI_M(j), n = n0 + EPI_N(i);
                    float4 o; o.x = acc[i][j][0]; o.y = acc[i][j][1]; o.z = acc[i][j][2]; o.w = acc[i][j][3];
                    *(float4*)(p.pre1 + (long)m * 1024 + n) = o;
                }
            acc_zero(acc);
#pragma unroll
            for (int i = 0; i < 4; ++i) {
                int r = (tid >> 3) + 32 * i;
                ap[i] = p.h1b + (long)(m0 + r) * 1024;
                bp[i] = p.wt_pg + ((long)l * 1024 + n0 + r) * 1024;
            }
            gemm_main(acc, ap, bp, 1024, KId());
#pragma unroll
            for (int i = 0; i < 4; ++i)
#pragma unroll
                for (int j = 0; j < 4; ++j) {
                    const int m = m0 + EPI_M(j), n = n0 + EPI_N(i);
                    const float4 st = *(const float4*)(p.pre1 + (long)m * 1024 + n);
                    st_bf4(p.ple + (long)m * 1024 + n, sigmoidf_(acc[i][j][0]) * st.x, sigmoidf_(acc[i][j][1]) * st.y,
                           sigmoidf_(acc[i][j][2]) * st.z, sigmoidf_(acc[i][j][3]) * st.w);
                }
        }
    }
}
__device__ __forceinline__ void phase_route(const Params& p, int l, unsigned* ctr) {
    const int tid = tid__;
    int* s_cnt = s_misc;
    int* s_base = s_misc + 32;
    WorkQ q; q.init(ctr, tid__ == 0);
    for (;;) {
        int it = q.next();
        if (it >= TT / 256) break;
        if (tid < 32) s_cnt[tid] = 0;
        __syncthreads();
        const int t = it * 256 + tid;
        float lg[32];
#pragma unroll
        for (int i = 0; i < 8; ++i) {
            const float4 v = *(const float4*)(p.logits + (long)t * 32 + i * 4);
            lg[i * 4 + 0] = v.x; lg[i * 4 + 1] = v.y; lg[i * 4 + 2] = v.z; lg[i * 4 + 3] = v.w;
        }
        unsigned taken = 0u;
        int ek[4]; float vk[4];
#pragma unroll
        for (int k = 0; k < 4; ++k) {
            float best = -3.0e38f; int bi = 0;
#pragma unroll
            for (int e = 0; e < 32; ++e) {
                const bool ok = !((taken >> e) & 1u) && (lg[e] > best);
                best = ok ? lg[e] : best;
                bi = ok ? e : bi;
            }
            taken |= 1u << bi;
            ek[k] = bi; vk[k] = best;
        }
        float wsum = 0.f;
        float v0 = -3.0e38f, v1 = 0.f, v2 = 0.f, v3 = 0.f;
#pragma unroll
        for (int e = 0; e < 32; ++e) {
            v0 = (e == ek[0]) ? lg[e] : v0;
            v1 = (e == ek[1]) ? lg[e] : v1;
            v2 = (e == ek[2]) ? lg[e] : v2;
            v3 = (e == ek[3]) ? lg[e] : v3;
        }
        vk[0] = 1.f; vk[1] = __expf(v1 - v0); vk[2] = __expf(v2 - v0); vk[3] = __expf(v3 - v0);
        wsum = vk[0] + vk[1] + vk[2] + vk[3];
        const float winv = 1.f / wsum;
        int lp[4];
#pragma unroll
        for (int k = 0; k < 4; ++k) lp[k] = atomicAdd(&s_cnt[ek[k]], 1);
        __syncthreads();
        if (tid < 32) s_base[tid] = (int)atomicAdd(&p.ecnt[l * 32 + tid], (unsigned)s_cnt[tid]);
        __syncthreads();
#pragma unroll
        for (int k = 0; k < 4; ++k) {
            const long idx = (long)ek[k] * TT + s_base[ek[k]] + lp[k];
            p.ent_id[idx] = t * 4 + k;
            p.ent_w[idx] = vk[k] * winv;
        }
    }
}
__device__ __forceinline__ void moe_prefix(const Params& p, int l) {
    __syncthreads();
    if (tid__ == 0) {
        int acc = 0;
        for (int e = 0; e < 32; ++e) {
            const int n = (int)__hip_atomic_load(&p.ecnt[l * 32 + e], __ATOMIC_RELAXED, __HIP_MEMORY_SCOPE_AGENT);
            s_misc[e] = acc;
            s_misc[40 + e] = n;
            acc += (n + 127) >> 7;
        }
        s_misc[32] = acc;
    }
    __syncthreads();
}
__device__ __forceinline__ void phase_moe_gu(const Params& p, int l, unsigned* ctr) {
    const int tid = tid__;
    moe_prefix(p, l);
    const int mtotal = s_misc[32];
    const int mpx = (((mtotal + 7) >> 3) + 7) & ~7;
    XQ q; q.init(ctr, mpx * 16, tid__ == 0);
    for (;;) {
        int it = q.next();
        if (it < 0) break;
        int mtg, nt; xq_decode(it, mpx, 16, mtg, nt);
        if (mtg >= mtotal) continue;
        int e = 0;
        for (int i = 1; i < 32; ++i) e = (s_misc[i] <= mtg) ? i : e;
        const int mt = mtg - s_misc[e], ne = s_misc[40 + e];
        const u16* ap[4]; const u16* bp[4];
#pragma unroll
        for (int i = 0; i < 4; ++i) {
            const int r = (tid >> 3) + 32 * i;
            int idx = mt * 128 + r; if (idx > ne - 1) idx = ne - 1;
            const int tok = p.ent_id[(long)e * TT + idx] >> 2;
            ap[i] = p.h1b + (long)tok * 1024;
            const int isup = (r >> 5) & 1, col = (r >> 6) * 32 + (r & 31);
            bp[i] = p.wt_gu + (((long)l * 32 + e) * 2048 + isup * 1024 + nt * 64 + col) * 1024;
        }
        f32x4 acc[4][4]; acc_zero(acc);
        gemm_main(acc, ap, bp, 1024, KId());
        EPI_COORDS
        const float* bg = p.b_gu + ((long)l * 32 + e) * 2048;
#pragma unroll
        for (int i = 0; i < 2; ++i)
#pragma unroll
            for (int j = 0; j < 4; ++j) {
                const long rowa = (long)mtg * 128 + EPI_M(j);
                const int col = nt * 64 + wn_ * 32 + i * 16 + (lane_ >> 4) * 4;
                float v[4];
#pragma unroll
                for (int r = 0; r < 4; ++r) {
                    float gate = acc[i][j][r] + bg[col + r];
                    float up = acc[i + 2][j][r] + bg[1024 + col + r];
                    gate = fminf(gate, 7.f);
                    up = fminf(fmaxf(up, -7.f), 7.f);
                    v[r] = (up + 1.f) * gate * sigmoidf_(1.702f * gate);
                }
                st_bf4(p.act + rowa * 1024 + col, v[0], v[1], v[2], v[3]);
            }
    }
}
__device__ __forceinline__ void phase_moe_down(const Params& p, int l, unsigned* ctr) {
    const int tid = tid__;
    moe_prefix(p, l);
    const int mtotal = s_misc[32];
    const int mpx = (((mtotal + 7) >> 3) + 7) & ~7;
    XQ q; q.init(ctr, mpx * 8, tid__ == 0);
    for (;;) {
        int it = q.next();
        if (it < 0) break;
        int mtg, nt; xq_decode(it, mpx, 8, mtg, nt);
        if (mtg >= mtotal) continue;
        int e = 0;
        for (int i = 1; i < 32; ++i) e = (s_misc[i] <= mtg) ? i : e;
        const int mt = mtg - s_misc[e], ne = s_misc[40 + e];
        const u16* ap[4]; const u16* bp[4];
#pragma unroll
        for (int i = 0; i < 4; ++i) {
            const int r = (tid >> 3) + 32 * i;
            ap[i] = p.act + ((long)mtg * 128 + r) * 1024;
            bp[i] = p.wt_dn + (((long)l * 32 + e) * 1024 + nt * 128 + r) * 1024;
        }
        f32x4 acc[4][4]; acc_zero(acc);
        gemm_main(acc, ap, bp, 1024, KId());
        EPI_COORDS
        const float* bd = p.b_down + ((long)l * 32 + e) * 1024;
#pragma unroll
        for (int j = 0; j < 4; ++j) {
            const int idx = mt * 128 + EPI_M(j);
            if (idx < ne) {
                const int id = p.ent_id[(long)e * TT + idx];
                const float cw = p.ent_w[(long)e * TT + idx];
#pragma unroll
                for (int i = 0; i < 4; ++i) {
                    const int n = nt * 128 + EPI_N(i);
                    const float4 bb = *(const float4*)(bd + n);
                    st_bf4(p.y4 + (long)id * 1024 + n, cw * (acc[i][j][0] + bb.x), cw * (acc[i][j][1] + bb.y),
                           cw * (acc[i][j][2] + bb.z), cw * (acc[i][j][3] + bb.w));
                }
            }
        }
    }
}

};
#ifndef PH0_EN
#define PH0_EN 1
#endif
__device__ __forceinline__ void run_phase(const Params& p, int ph, int coff, int wv) {
    unsigned* ctr = p.ctr + (ph + coff) * 8;
    Ctx cx;
    {
        int t_ = wv * 64 + (int)__lane_id();
        asm volatile("" : "+v"(t_));
        cx.tid__ = t_;
    }
    if (ph == 0) { if (PH0_EN) cx.phase_prologue(p, ctr); return; }
    const int l = (ph - 1) / NPH_LAYER, s = (ph - 1) % NPH_LAYER;
#ifndef ONLY_S
#define ONLY_S -1
#endif
#ifndef SKIP_S
#define SKIP_S -1
#endif
#define PH_EN(x) ((ONLY_S < 0 || ONLY_S == (x)) && SKIP_S != (x))
    if (PH_EN(0) && s == 0) cx.phase_gemm_in(p, l, ctr);
    if (PH_EN(1) && s == 1) cx.phase_cmp1_sb(p, l, ctr);
    if (PH_EN(2) && s == 2) cx.phase_cmp2(p, l, ctr);
    if (PH_EN(3) && s == 3) cx.phase_nsa(p, ctr);
    if (PH_EN(4) && s == 4) cx.phase_br(p, l, ctr);
    if (PH_EN(5) && s == 5) cx.phase_wo(p, l, ctr);
    if (PH_EN(6) && s == 6) cx.phase_ln(p, l, 1, ctr);
    if (PH_EN(7) && s == 7) cx.phase_router_ple(p, l, ctr);
    if (PH_EN(8) && s == 8) cx.phase_route(p, l, ctr);
    if (PH_EN(9) && s == 9) cx.phase_moe_gu(p, l, ctr);
    if (PH_EN(10) && s == 10) cx.phase_moe_down(p, l, ctr);
    if (PH_EN(11) && s == 11) cx.phase_ln(p, l, 2, ctr);
}

__global__ void __launch_bounds__(256, 2) mega_kernel(Params p, int ph0, int ph1) {
    __shared__ uint4 xb_words;
    const int wv = __builtin_amdgcn_readfirstlane((int)(threadIdx.x >> 6));
    const bool t0 = (threadIdx.x == 0);
    if (t0) xb_words = make_uint4(0u, 0u, 0u, 0u);
    __syncthreads();
    __shared__ Params s_p;
    if (t0) {
        const void* const* src_ = (const void* const*)&p;
        const void** dst_ = (const void**)&s_p;
#pragma unroll
        for (int i = 0; i < (int)(sizeof(Params) / sizeof(void*)); ++i) dst_[i] = src_[i];
    }
    __syncthreads();
    XcdBarrier bar = xcd_barrier_post(p.bar, (volatile LAS unsigned*)&xb_words, t0);
    for (int ph = ph0; ph < ph1; ++ph) {
        const bool t0p = (wv == 0) && (__lane_id() == 0);
        if (ph > ph0) xcd_barrier(bar, t0p);
        asm volatile("" ::: "memory");
        run_phase(s_p, ph, 0, wv);
#if REP_MASK
        if (ph > 0 && ((REP_MASK >> ((ph - 1) % NPH_LAYER)) & 1)) {
            xcd_barrier(bar, t0p);
            asm volatile("" ::: "memory");
            run_phase(s_p, ph, 64, wv);
        }
#endif
    }
}

#ifndef REP_MASK
#define REP_MASK 0
#endif
#ifndef MK_SPLIT
#define MK_SPLIT 0
#endif

extern "C" void kernel_launch(void* const* d_in, const int* in_sizes, int n_in, void* d_out, int out_size, void* d_ws,
                              size_t ws_size, hipStream_t stream) {
    static int grid = 0;
    if (!grid) {
        int dev = 0, cus = 0, per_cu = 0;
        hipGetDevice(&dev);
        hipDeviceGetAttribute(&cus, hipDeviceAttributeMultiprocessorCount, dev);
        hipOccupancyMaxActiveBlocksPerMultiprocessor(&per_cu, mega_kernel, 256, 0);
        if (per_cu < 1) per_cu = 1;
        grid = cus * (per_cu < 2 ? per_cu : 2);
    }
    Params p;
    memset(&p, 0, sizeof(p));
    const float** pin = (const float**)&p;
    for (int i = 0; i < 21; ++i) pin[i] = (const float*)d_in[i];
    p.out = (float*)d_out;
    char* w = (char*)d_ws;
    size_t off = 0;
    auto take = [&](size_t bytes) { char* r = w + off; off += (bytes + 255) & ~(size_t)255; return r; };
    const size_t sync_bytes = (XCD_BAR_WORDS + 1024 + 128) * sizeof(unsigned);
    p.bar = (unsigned*)take(sync_bytes);
    p.ctr = p.bar + XCD_BAR_WORDS;
    p.ecnt = p.ctr + 1024;
    p.wt_in = (u16*)take((size_t)4 * NIN * 1024 * 2);
    p.wt_brs = (u16*)take((size_t)4 * 512 * 1024 * 2);
    p.wt_brn = (u16*)take((size_t)4 * 512 * 1024 * 2);
    p.wt_o = (u16*)take((size_t)4 * 1024 * 1024 * 2);
    p.wt_pg = (u16*)take((size_t)4 * 1024 * 1024 * 2);
    p.wt_pp = (u16*)take((size_t)4 * 256 * 1024 * 2);
    p.wt_gu = (u16*)take((size_t)128 * 2048 * 1024 * 2);
    p.wt_dn = (u16*)take((size_t)128 * 1024 * 1024 * 2);
    p.wt_c1 = (u16*)take((size_t)8 * 128 * 2048 * 2);
    p.wt_c2 = (u16*)take((size_t)8 * 64 * 128 * 2);
    p.wt_r = (u16*)take((size_t)4 * 32 * 3072 * 2);
    p.cbias = (float*)take(1024 * 4);
    p.hf = (float*)take((size_t)TT * 1024 * 4);
    p.pre1 = (float*)take((size_t)TT * 1024 * 4);
    p.h1f = (float*)take((size_t)TT * 1024 * 4);
    p.logits = (float*)take((size_t)TT * 32 * 4);
    p.ynf = (float*)take((size_t)TT * 512 * 4);
    p.ent_w = (float*)take((size_t)32 * TT * 4);
    p.hb = (u16*)take((size_t)TT * 1024 * 2);
    p.pb = (u16*)take((size_t)4 * TT * 256 * 2);
    p.yb = (u16*)take((size_t)TT * NIN * 2);
    p.ysb = (u16*)take((size_t)TT * 512 * 2);
    p.ynsa = (u16*)take((size_t)TT * 512 * 2);
    p.merged = (u16*)take((size_t)TT * 1024 * 2);
    p.h1b = (u16*)take((size_t)TT * 1024 * 2);
    p.h1lo = (u16*)take((size_t)TT * 1024 * 2);
    p.ple = (u16*)take((size_t)TT * 1024 * 2);
    p.hid = (u16*)take((size_t)2 * 2048 * 128 * 2);
    p.kvc = (u16*)take((size_t)2 * 2048 * 64 * 2);
    p.act = (u16*)take((size_t)(TT * 4 + 32 * 128) * 1024 * 2);
    p.y4 = (u16*)take((size_t)TT * 4 * 1024 * 2);
    p.ent_id = (int*)take((size_t)32 * TT * 4);
    if (off > ws_size) { fprintf(stderr, "workspace too small: need %zu have %zu\n", off, ws_size); return; }
    hipMemsetAsync(p.bar, 0, sync_bytes, stream);
#if MK_SPLIT
    for (int ph = 0; ph < NPHASE; ++ph) mega_kernel<<<dim3(grid), dim3(256), 0, stream>>>(p, ph, ph + 1);
#else
    mega_kernel<<<dim3(grid), dim3(256), 0, stream>>>(p, 0, NPHASE);
#endif
}
```

```cpp
#define NSA_HPB 2
#include <hip/hip_runtime.h>
#include <stdint.h>
#include <cstdio>
#include <cstring>
#include <cstdlib>
#include <vector>

#define XB_TMO      128
#define XB_XCNT(j)  (256  + 64 * (j))
#define XB_XSUB(j)  (1280 + 64 * (j))
#define XB_XGEN(j)  (2304 + 64 * (j))
#define XB_TOP      3328
#define XB_TOPGEN   3392
#define XCD_BAR_WORDS 3456
#define XB_SPIN_CAP (1u << 18)
#define LAS __attribute__((address_space(3)))

__device__ __forceinline__ unsigned xb_ld(unsigned* p)              { return __hip_atomic_load(p, __ATOMIC_RELAXED, __HIP_MEMORY_SCOPE_AGENT); }
__device__ __forceinline__ unsigned xb_add(unsigned* p, unsigned v) { return __hip_atomic_fetch_add(p, v, __ATOMIC_RELAXED, __HIP_MEMORY_SCOPE_AGENT); }
__device__ __forceinline__ unsigned xb_xcc_id() { return (unsigned)__builtin_amdgcn_s_getreg((3 << 11) | 20) & 0xFu; }
#define XB_SPIN(cond, bar) do { unsigned _sp = 0; while (cond) { __builtin_amdgcn_s_sleep(1); \
    if ((++_sp & 255u) == 0u) { if (xb_ld(&(bar)[XB_TMO])) break; if (_sp > XB_SPIN_CAP) { atomicAdd(&(bar)[XB_TMO], 1u); break; } } } } while (0)

struct XcdBarrier {
    unsigned* bar; unsigned x;
    volatile LAS unsigned* st;
};

__device__ __forceinline__ XcdBarrier xcd_barrier_post(unsigned* bar, volatile LAS unsigned* st, const bool xb_t0) {
    XcdBarrier b; b.bar = bar; b.x = xb_xcc_id(); b.st = st;
    if (xb_t0) (void)xb_add(&bar[XB_XCNT(b.x)], 1u);
    return b;
}
__device__ __forceinline__ void xcd_barrier_complete(unsigned* bar, unsigned x, unsigned& nloc, unsigned& nx) {
    const unsigned G = gridDim.x * gridDim.y * gridDim.z;
    unsigned sum, cnt, mine, sp = 0u;
    for (;;) {
        sum = 0u; cnt = 0u; mine = 0u;
#pragma unroll
        for (unsigned j = 0; j < 16; ++j) { const unsigned c = xb_ld(&bar[XB_XCNT(j)]); sum += c; cnt += (c > 0u) ? 1u : 0u; mine = (j == x) ? c : mine; }
        if (sum == G) break;
        __builtin_amdgcn_s_sleep(1);
        if ((++sp & 255u) == 0u) { if (xb_ld(&bar[XB_TMO])) break; if (sp > XB_SPIN_CAP) { atomicAdd(&bar[XB_TMO], 1u); break; } }
    }
    nloc = mine > 0u ? mine : 1u; nx = cnt > 0u ? cnt : 1u;
}

__device__ __forceinline__ void xcd_barrier(const XcdBarrier& b, const bool xb_t0) {
    asm volatile("s_waitcnt vmcnt(0)" ::: "memory");
    __syncthreads();
    if (xb_t0) {
        unsigned* bar = b.bar;
        __builtin_amdgcn_s_waitcnt(0);
        unsigned nloc = b.st[0], nx = b.st[1];
        if (nloc == 0u) { xcd_barrier_complete(bar, b.x, nloc, nx); b.st[0] = nloc; b.st[1] = nx; }
        const unsigned old = xb_add(&bar[XB_XSUB(b.x)], 1u);
        const unsigned gen = old / nloc;
        if (old + 1u == (gen + 1u) * nloc) {
            __builtin_amdgcn_fence(__ATOMIC_RELEASE, "agent");
            asm volatile("s_waitcnt vmcnt(0)" ::: "memory");
            const unsigned og = xb_add(&bar[XB_TOP], 1u);
            const unsigned tg = og / nx;
            if (og + 1u == (tg + 1u) * nx) xb_add(&bar[XB_TOPGEN], 1u);
            else XB_SPIN(xb_ld(&bar[XB_TOPGEN]) == tg, bar);
            __builtin_amdgcn_fence(__ATOMIC_ACQUIRE, "agent");
            xb_add(&bar[XB_XGEN(b.x)], 1u);
            asm volatile("s_waitcnt vmcnt(0)" ::: "memory");
        } else {
            XB_SPIN(xb_ld(&bar[XB_XGEN(b.x)]) == gen, bar);
            __builtin_amdgcn_fence(__ATOMIC_ACQUIRE, "agent");
            asm volatile("s_waitcnt vmcnt(0)" ::: "memory");
        }
    }
    __syncthreads();
}


#ifndef REP_MASK
#define REP_MASK 0
#endif
typedef unsigned short u16;
typedef __attribute__((ext_vector_type(8))) short bf16x8;
typedef __attribute__((ext_vector_type(4))) float f32x4;
typedef __attribute__((ext_vector_type(4))) unsigned u32x4;
#define MFMA(a, b, c) __builtin_amdgcn_mfma_f32_16x16x32_bf16(a, b, c, 0, 0, 0)

#define TT 32768
#define SS 4096
#define DD 1024
#define NIN 4888
#define C_SBQ 0
#define C_SBK 512
#define C_SBV 1024
#define C_NQ 1536
#define C_KC 2048
#define C_VC 2176
#define C_KS 2304
#define C_VS 2432
#define C_KW 2560
#define C_VW 2688
#define C_NG 2816
#define C_GSB 2840
#define C_GNSA 3864
#define DN_ALPHA 1.681792830507429f
#define NPH_LAYER 12
#define NPHASE (1 + 4 * NPH_LAYER)
#define KSTR 72
#define VSTR 136
#define SSTR 68

struct Params {
    const float *x, *p, *w_in, *w_cmp1, *w_cmp2, *pe_cmp, *w_br_sb, *w_br_nsa, *w_o, *ln1_g, *ln1_b, *ln2_g, *ln2_b,
        *w_router, *b_router, *w_gu, *b_gu, *w_down, *b_down, *w_ple_gate, *w_ple_proj;
    float* out;
    unsigned *bar, *ctr, *ecnt;
    u16 *wt_in, *wt_brs, *wt_brn, *wt_o, *wt_pg, *wt_pp, *wt_gu, *wt_dn, *wt_c1, *wt_c2, *wt_r;
    float *cbias, *hf, *pre1, *h1f, *logits, *ynf, *ent_w;
    u16 *hb, *pb, *yb, *ysb, *ynsa, *merged, *h1b, *h1lo, *ple, *hid, *kvc, *act, *y4;
    int* ent_id;
};

__device__ __forceinline__ u16 f2bf(float f) {
    unsigned u = __float_as_uint(f);
    u += 0x7fffu + ((u >> 16) & 1u);
    return (u16)(u >> 16);
}
__device__ __forceinline__ float bf2f(u16 h) { return __uint_as_float(((unsigned)h) << 16); }
__device__ __forceinline__ void st_bf4(u16* p, float a, float b, float c, float d) {
    uint2 u;
    u.x = (unsigned)f2bf(a) | ((unsigned)f2bf(b) << 16);
    u.y = (unsigned)f2bf(c) | ((unsigned)f2bf(d) << 16);
    *(uint2*)p = u;
}
__device__ __forceinline__ float sigmoidf_(float x) { return 1.f / (1.f + __expf(-x)); }

__shared__ __attribute__((aligned(16))) unsigned char g_smem[62464];
__shared__ int s_item;
__shared__ int s_misc[80];
__shared__ unsigned long long s_mask[4][16];
__shared__ unsigned long long s_union[4];

struct WorkQ {
    unsigned* ctr;
    int nxt;
    bool t0;
    __device__ __forceinline__ void init(unsigned* c, bool t0_) {
        ctr = c;
        nxt = 0;
        t0 = t0_;
        if (t0) nxt = (int)atomicAdd(ctr, 1u);
    }
    __device__ __forceinline__ int next() {
        __syncthreads();
        if (t0) s_item = nxt;
        __syncthreads();
        int it = s_item;
        if (t0) nxt = (int)atomicAdd(ctr, 1u);
        return it;
    }
};


struct XQ {
    unsigned* ctr;
    int per, x0, k, nxt;
    bool t0;
    __device__ __forceinline__ void init(unsigned* c, int per_, bool t0_) {
        ctr = c; per = per_; k = 0; nxt = 0; t0 = t0_;
        x0 = (int)(xb_xcc_id() & 7u);
        if (t0) nxt = (int)atomicAdd(&ctr[x0], 1u);
    }
    __device__ __forceinline__ int next() {
        __syncthreads();
        if (t0) {
            int v = nxt;
            while (v >= per && k < 8) {
                ++k;
                if (k < 8) v = (int)atomicAdd(&ctr[(x0 + k) & 7], 1u);
            }
            if (k < 8) {
                s_item = ((x0 + k) & 7) * per + v;
                nxt = (int)atomicAdd(&ctr[(x0 + k) & 7], 1u);
            } else s_item = -1;
        }
        __syncthreads();
        return s_item;
    }
};
__device__ __forceinline__ void xq_decode(int item, int mpx, int NT, int& mt, int& nt) {
    const int per = mpx * NT;
    const int q = item / per, idx = item - q * per;
    const int sm = idx / (8 * NT), rem = idx - sm * (8 * NT);
    nt = rem >> 3;
    mt = q * mpx + sm * 8 + (rem & 7);
}
struct Ctx {
    int tid__;
struct KId {
    __device__ __forceinline__ long operator()(int k) const { return k; }
};
template <class KOA>
__device__ __forceinline__ void gemm_main(f32x4 (&acc)[4][4], const u16* (&ap)[4], const u16* (&bp)[4], int K, KOA koa) {
    u16* sA = (u16*)g_smem;
    u16* sB = sA + 128 * KSTR;
    const int tid = tid__, lane = tid & 63, wave = tid >> 6;
    const int wn = wave & 1, wm = wave >> 1;
    const int kc = (tid & 7) * 8;
    const int lrow = tid >> 3;
    u32x4 ra[4], rb[4];
    {
        const long oa = koa(kc);
#pragma unroll
        for (int i = 0; i < 4; ++i) {
            ra[i] = *(const u32x4*)(ap[i] + oa);
            rb[i] = *(const u32x4*)(bp[i] + kc);
        }
    }
    for (int k0 = 0; k0 < K; k0 += 64) {
        __syncthreads();
#pragma unroll
        for (int i = 0; i < 4; ++i) {
            *(u32x4*)(sA + (lrow + 32 * i) * KSTR + kc) = ra[i];
            *(u32x4*)(sB + (lrow + 32 * i) * KSTR + kc) = rb[i];
        }
        __syncthreads();
        if (k0 + 64 < K) {
            const long oa = koa(k0 + 64 + kc);
#pragma unroll
            for (int i = 0; i < 4; ++i) {
                ra[i] = *(const u32x4*)(ap[i] + oa);
                rb[i] = *(const u32x4*)(bp[i] + (k0 + 64 + kc));
            }
        }
#pragma unroll
        for (int ks = 0; ks < 2; ++ks) {
            bf16x8 af[4], bfr[4];
#pragma unroll
            for (int j = 0; j < 4; ++j)
                af[j] = *(const bf16x8*)(sA + (wm * 64 + j * 16 + (lane & 15)) * KSTR + ks * 32 + (lane >> 4) * 8);
#pragma unroll
            for (int i = 0; i < 4; ++i)
                bfr[i] = *(const bf16x8*)(sB + (wn * 64 + i * 16 + (lane & 15)) * KSTR + ks * 32 + (lane >> 4) * 8);
#pragma unroll
            for (int i = 0; i < 4; ++i)
#pragma unroll
                for (int j = 0; j < 4; ++j) acc[i][j] = MFMA(bfr[i], af[j], acc[i][j]);
        }
    }
}
__device__ __forceinline__ void acc_zero(f32x4 (&acc)[4][4]) {
#pragma unroll
    for (int i = 0; i < 4; ++i)
#pragma unroll
        for (int j = 0; j < 4; ++j) acc[i][j] = f32x4{0.f, 0.f, 0.f, 0.f};
}
#define EPI_COORDS                                         \
    const int lane_ = tid__ & 63, wave_ = tid__ >> 6; \
    const int wn_ = wave_ & 1, wm_ = wave_ >> 1;
#define EPI_M(j) (wm_ * 64 + (j) * 16 + (lane_ & 15))
#define EPI_N(i) (wn_ * 64 + (i) * 16 + (lane_ >> 4) * 4)

__device__ __forceinline__ void xjob(const Params& p, int j, const float*& src, u16*& dst, int& nb, int& K, int& N) {
    switch (j) {
        case 0: src = p.w_in; dst = p.wt_in; nb = 4; K = 1024; N = NIN; break;
        case 1: src = p.w_br_sb; dst = p.wt_brs; nb = 4; K = 512; N = 1024; break;
        case 2: src = p.w_br_nsa; dst = p.wt_brn; nb = 4; K = 512; N = 1024; break;
        case 3: src = p.w_o; dst = p.wt_o; nb = 4; K = 1024; N = 1024; break;
        case 4: src = p.w_ple_gate; dst = p.wt_pg; nb = 4; K = 1024; N = 1024; break;
        case 5: src = p.w_ple_proj; dst = p.wt_pp; nb = 4; K = 256; N = 1024; break;
        case 6: src = p.w_gu; dst = p.wt_gu; nb = 128; K = 1024; N = 2048; break;
        case 7: src = p.w_down; dst = p.wt_dn; nb = 128; K = 1024; N = 1024; break;
        case 8: src = p.w_cmp1; dst = p.wt_c1; nb = 8; K = 2048; N = 128; break;
        default: src = p.w_cmp2; dst = p.wt_c2; nb = 8; K = 128; N = 64; break;
    }
}
__device__ __forceinline__ int xjob_tiles(int nb, int K, int N) { return nb * (K / 128) * ((N + 127) / 128); }

__device__ __forceinline__ void phase_prologue(const Params& p, unsigned* ctr) {
    const int tid = tid__;
    int ntr = 0;
    for (int j = 0; j < 10; ++j) {
        const float* s; u16* d; int nb, K, N;
        xjob(p, j, s, d, nb, K, N);
        ntr += xjob_tiles(nb, K, N);
    }
    const int n_x = TT * DD / 8192, n_p = 4 * TT * 256 / 8192, n_r = 16, n_b = 16;
    const int total = ntr + n_x + n_p + n_r + n_b;
    float* st = (float*)g_smem;
    WorkQ q; q.init(ctr, tid__ == 0);
    for (;;) {
        int it = q.next();
        if (it >= total) break;
        it = (it < n_b + n_r) ? (ntr + n_x + n_p + (it < n_b ? n_r + it : it - n_b)) : it - (n_b + n_r);
        if (it < ntr) {
            const float* src = nullptr; u16* dst = nullptr; int nb = 0, K = 0, N = 0;
            int rem = it;
            for (int j = 0; j < 10; ++j) {
                xjob(p, j, src, dst, nb, K, N);
                int nt = xjob_tiles(nb, K, N);
                if (rem < nt) break;
                rem -= nt;
            }
            const int ktn = K / 128, ntn = (N + 127) / 128;
            const int tpm = ktn * ntn;
            const int b = rem / tpm; rem -= b * tpm;
            const int kt = rem % ktn, nt = rem / ktn;
            src += (long)b * K * N; dst += (long)b * K * N;
            const int k0 = kt * 128, n0 = nt * 128;
            u16* st16 = (u16*)g_smem;
            float4 v[16];
#pragma unroll
            for (int i = 0; i < 16; ++i) {
                const int k = (tid >> 5) + 8 * i, n = (tid & 31) * 4;
                v[i] = make_float4(0.f, 0.f, 0.f, 0.f);
                if (n0 + n < N) v[i] = *(const float4*)(src + (long)(k0 + k) * N + n0 + n);
            }
#pragma unroll
            for (int i = 0; i < 16; ++i) {
                const int k = (tid >> 5) + 8 * i, n = (tid & 31) * 4;
                st_bf4(st16 + k * 136 + n, v[i].x, v[i].y, v[i].z, v[i].w);
            }
            __syncthreads();
#pragma unroll
            for (int i = 0; i < 8; ++i) {
                const int n = (tid >> 4) + 16 * i, k8 = (tid & 15) * 8;
                if (n0 + n < N) {
                    uint4 u;
                    u.x = (unsigned)st16[(k8 + 0) * 136 + n] | ((unsigned)st16[(k8 + 1) * 136 + n] << 16);
                    u.y = (unsigned)st16[(k8 + 2) * 136 + n] | ((unsigned)st16[(k8 + 3) * 136 + n] << 16);
                    u.z = (unsigned)st16[(k8 + 4) * 136 + n] | ((unsigned)st16[(k8 + 5) * 136 + n] << 16);
                    u.w = (unsigned)st16[(k8 + 6) * 136 + n] | ((unsigned)st16[(k8 + 7) * 136 + n] << 16);
                    *(uint4*)(dst + (long)(n0 + n) * K + k0 + k8) = u;
                }
            }
        } else if (it < ntr + n_x + n_p) {
            int e = it - ntr;
            const float* src; u16* db; float* df = nullptr;
            if (e < n_x) { src = p.x + (long)e * 8192; db = p.hb + (long)e * 8192; df = p.hf + (long)e * 8192; }
            else { e -= n_x; src = p.p + (long)e * 8192; db = p.pb + (long)e * 8192; }
#pragma unroll
            for (int i = 0; i < 8; ++i) {
                int o = i * 1024 + tid * 4;
                float4 v = *(const float4*)(src + o);
                if (df) *(float4*)(df + o) = v;
                st_bf4(db + o, v.x, v.y, v.z, v.w);
            }
        } else if (it < ntr + n_x + n_p + n_r) {
            int e0 = (it - ntr - n_x - n_p) * 8192;
            for (int i = 0; i < 32; ++i) {
                int idx = e0 + i * 256 + tid;
                int k = idx & 1023, le = idx >> 10, e = le & 31, l = le >> 5;
                float w = p.w_router[((long)l * 1024 + k) * 32 + e];
                u16 hi = f2bf(w); u16 lo = f2bf(w - bf2f(hi));
                u16* d = p.wt_r + (long)le * 3072;
                d[k] = hi; d[1024 + k] = lo; d[2048 + k] = hi;
            }
        } else {
            const int bi = it - ntr - n_x - n_p - n_r;
            const int lk = bi >> 1, h = (bi & 1) * 64 + (tid & 63), jp = tid >> 6;
            const float* pe = p.pe_cmp + (long)lk * 2048 + jp * 512;
            const float* w1 = p.w_cmp1 + ((long)lk * 2048 + jp * 512) * 128 + h;
            float sacc = 0.f;
#pragma unroll 8
            for (int j = 0; j < 512; ++j) sacc += pe[j] * w1[(long)j * 128];
            st[tid] = sacc;
            __syncthreads();
            if (tid < 64) p.cbias[lk * 128 + h] = (st[tid] + st[tid + 64]) + (st[tid + 128] + st[tid + 192]);
        }
    }
}

__device__ __forceinline__ void phase_gemm_in(const Params& p, int l, unsigned* ctr) {
    const int NTN = (NIN + 127) / 128;
    const int tid = tid__;
    const u16* W = p.wt_in + (long)l * NIN * 1024;
    XQ q; q.init(ctr, 32 * NTN, tid__ == 0);
    for (;;) {
        int it = q.next();
        if (it < 0) break;
        int mt, nt; xq_decode(it, 32, NTN, mt, nt);
        const int m0 = mt * 128, n0 = nt * 128;
        const u16* ap[4]; const u16* bp[4];
#pragma unroll
        for (int i = 0; i < 4; ++i) {
            int r = (tid >> 3) + 32 * i;
            ap[i] = p.hb + (long)(m0 + r) * 1024;
            int n = n0 + r; if (n > NIN - 1) n = NIN - 1;
            bp[i] = W + (long)n * 1024;
        }
        f32x4 acc[4][4]; acc_zero(acc);
        gemm_main(acc, ap, bp, 1024, KId());
        EPI_COORDS
#pragma unroll
        for (int i = 0; i < 4; ++i)
#pragma unroll
            for (int j = 0; j < 4; ++j) {
                int m = m0 + EPI_M(j), n = n0 + EPI_N(i);
                if (n < NIN) st_bf4(p.yb + (long)m * NIN + n, acc[i][j][0], acc[i][j][1], acc[i][j][2], acc[i][j][3]);
            }
    }
}

struct KCmp {
    __device__ __forceinline__ long operator()(int k) const { return (long)(k >> 6) * NIN + (k & 63); }
};
__device__ __forceinline__ void tile_cmp1(const Params& p, int l, int it) {
    const int tid = tid__;
    const int kv = it >> 4, mt = it & 15;
    const u16* W = p.wt_c1 + (long)(l * 2 + kv) * 128 * 2048;
    const u16* ap[4]; const u16* bp[4];
#pragma unroll
    for (int i = 0; i < 4; ++i) {
        int r = (tid >> 3) + 32 * i;
        int mrow = mt * 128 + r;
        int c = mrow & 127, bg = mrow >> 7, g = bg & 1, b = bg >> 1;
        ap[i] = p.yb + (long)(b * SS + c * 32) * NIN + (kv ? C_VC : C_KC) + g * 64;
        bp[i] = W + (long)r * 2048;
    }
    f32x4 acc[4][4]; acc_zero(acc);
    gemm_main(acc, ap, bp, 2048, KCmp());
    EPI_COORDS
    const float* cb = p.cbias + (l * 2 + kv) * 128;
#pragma unroll
    for (int i = 0; i < 4; ++i)
#pragma unroll
        for (int j = 0; j < 4; ++j) {
            int m = mt * 128 + EPI_M(j), n = EPI_N(i);
            float v[4];
#pragma unroll
            for (int r = 0; r < 4; ++r) { float a = acc[i][j][r] + cb[n + r]; v[r] = a * sigmoidf_(a); }
            st_bf4(p.hid + ((long)kv * 2048 + m) * 128 + n, v[0], v[1], v[2], v[3]);
        }
}
__device__ __forceinline__ void phase_cmp2(const Params& p, int l, unsigned* ctr) {
    const int tid = tid__;
    WorkQ q; q.init(ctr, tid__ == 0);
    for (;;) {
        int it = q.next();
        if (it >= 32) break;
        const int kv = it >> 4, mt = it & 15;
        const u16* W = p.wt_c2 + (long)(l * 2 + kv) * 64 * 128;
        const u16* ap[4]; const u16* bp[4];
#pragma unroll
        for (int i = 0; i < 4; ++i) {
            int r = (tid >> 3) + 32 * i;
            ap[i] = p.hid + ((long)kv * 2048 + mt * 128 + r) * 128;
            bp[i] = W + (long)(r & 63) * 128;
        }
        f32x4 acc[4][4]; acc_zero(acc);
        gemm_main(acc, ap, bp, 128, KId());
        EPI_COORDS
#pragma unroll
        for (int i = 0; i < 4; ++i)
#pragma unroll
            for (int j = 0; j < 4; ++j) {
                int m = mt * 128 + EPI_M(j), n = EPI_N(i);
                if (n < 64) st_bf4(p.kvc + ((long)kv * 2048 + m) * 64 + n, acc[i][j][0], acc[i][j][1], acc[i][j][2], acc[i][j][3]);
            }
    }
}

struct AttnLds {
    u16* K;
    u16* Vt;
    float* S;
    u16* P;
};
__device__ __forceinline__ AttnLds attn_lds() {
    AttnLds a;
    a.K = (u16*)g_smem;
    a.Vt = (u16*)(g_smem + 18432);
    a.S = (float*)(g_smem + 18432 + 17408) + (tid__ >> 6) * 16 * SSTR;
    a.P = (u16*)(g_smem + 18432 + 17408 + 17408) + (tid__ >> 6) * 16 * KSTR;
    return a;
}
__device__ __forceinline__ void load_k_tile(u16* sK, int koff, const u16* base, long stride) {
    const int tid = tid__, key = tid >> 2, ch = (tid & 3) * 16;
    const u16* g = base + (long)key * stride + ch;
    uint4 a = *(const uint4*)g, b = *(const uint4*)(g + 8);
    *(uint4*)(sK + (koff + key) * KSTR + ch) = a;
    *(uint4*)(sK + (koff + key) * KSTR + ch + 8) = b;
}
__device__ __forceinline__ void load_v_tile(u16* sVt, int koff, const u16* base, long stride) {
    const int tid = tid__, key = tid & 63, d0 = (tid >> 6) * 16;
    const u16* g = base + (long)key * stride + d0;
    uint4 a = *(const uint4*)g, b = *(const uint4*)(g + 8);
    unsigned w[8] = {a.x, a.y, a.z, a.w, b.x, b.y, b.z, b.w};
#pragma unroll
    for (int i = 0; i < 8; ++i) {
        sVt[(d0 + 2 * i) * VSTR + koff + key] = (u16)(w[i] & 0xffffu);
        sVt[(d0 + 2 * i + 1) * VSTR + koff + key] = (u16)(w[i] >> 16);
    }
}
__device__ __forceinline__ void ldg_k(const u16* base, long stride, u32x4& a, u32x4& b) {
    const int tid = tid__, key = tid >> 2, ch = (tid & 3) * 16;
    const u16* g = base + (long)key * stride + ch;
    a = *(const u32x4*)g; b = *(const u32x4*)(g + 8);
}
__device__ __forceinline__ void sts_k(u16* sK, const u32x4& a, const u32x4& b) {
    const int tid = tid__, key = tid >> 2, ch = (tid & 3) * 16;
    *(u32x4*)(sK + key * KSTR + ch) = a;
    *(u32x4*)(sK + key * KSTR + ch + 8) = b;
}
__device__ __forceinline__ void ldg_v(const u16* base, long stride, u32x4& a, u32x4& b) {
    const int tid = tid__, key = tid & 63, d0 = (tid >> 6) * 16;
    const u16* g = base + (long)key * stride + d0;
    a = *(const u32x4*)g; b = *(const u32x4*)(g + 8);
}
__device__ __forceinline__ void sts_v(u16* sVt, const u32x4& a, const u32x4& b) {
    const int tid = tid__, key = tid & 63, d0 = (tid >> 6) * 16;
#pragma unroll
    for (int i = 0; i < 4; ++i) {
        sVt[(d0 + 2 * i) * VSTR + key] = (u16)(a[i] & 0xffffu);
        sVt[(d0 + 2 * i + 1) * VSTR + key] = (u16)(a[i] >> 16);
        sVt[(d0 + 8 + 2 * i) * VSTR + key] = (u16)(b[i] & 0xffffu);
        sVt[(d0 + 8 + 2 * i + 1) * VSTR + key] = (u16)(b[i] >> 16);
    }
}
__device__ __forceinline__ void wave_qk(const AttnLds& L, int koff, const bf16x8 (&qf)[2]) {
    const int lane = tid__ & 63, quad = lane >> 4, c = lane & 15;
#pragma unroll
    for (int nt = 0; nt < 4; ++nt) {
        f32x4 a = {0.f, 0.f, 0.f, 0.f};
#pragma unroll
        for (int ks = 0; ks < 2; ++ks) {
            bf16x8 kf = *(const bf16x8*)(L.K + (koff + nt * 16 + c) * KSTR + ks * 32 + quad * 8);
            a = MFMA(qf[ks], kf, a);
        }
#pragma unroll
        for (int r = 0; r < 4; ++r) L.S[(quad * 4 + r) * SSTR + nt * 16 + c] = a[r];
    }
}
__device__ __forceinline__ void wave_pv(const AttnLds& L, int koff, f32x4 (&o)[4]) {
    const int lane = tid__ & 63, quad = lane >> 4, c = lane & 15;
#pragma unroll
    for (int ks = 0; ks < 2; ++ks) {
        bf16x8 pf = *(const bf16x8*)(L.P + c * KSTR + ks * 32 + quad * 8);
#pragma unroll
        for (int dt = 0; dt < 4; ++dt) {
            bf16x8 vf = *(const bf16x8*)(L.Vt + (dt * 16 + c) * VSTR + koff + ks * 32 + quad * 8);
            o[dt] = MFMA(pf, vf, o[dt]);
        }
    }
}
__device__ __forceinline__ void read_s16(const AttnLds& L, int row, int part, float (&z)[16]) {
#pragma unroll
    for (int i = 0; i < 4; ++i) {
        float4 v = *(const float4*)(L.S + row * SSTR + part * 16 + i * 4);
        z[i * 4 + 0] = v.x; z[i * 4 + 1] = v.y; z[i * 4 + 2] = v.z; z[i * 4 + 3] = v.w;
    }
}
__device__ __forceinline__ void write_p16(const AttnLds& L, int row, int part, const float (&pv)[16]) {
    uint4 a, b;
    a.x = (unsigned)f2bf(pv[0]) | ((unsigned)f2bf(pv[1]) << 16);
    a.y = (unsigned)f2bf(pv[2]) | ((unsigned)f2bf(pv[3]) << 16);
    a.z = (unsigned)f2bf(pv[4]) | ((unsigned)f2bf(pv[5]) << 16);
    a.w = (unsigned)f2bf(pv[6]) | ((unsigned)f2bf(pv[7]) << 16);
    b.x = (unsigned)f2bf(pv[8]) | ((unsigned)f2bf(pv[9]) << 16);
    b.y = (unsigned)f2bf(pv[10]) | ((unsigned)f2bf(pv[11]) << 16);
    b.z = (unsigned)f2bf(pv[12]) | ((unsigned)f2bf(pv[13]) << 16);
    b.w = (unsigned)f2bf(pv[14]) | ((unsigned)f2bf(pv[15]) << 16);
    *(uint4*)(L.P + row * KSTR + part * 16) = a;
    *(uint4*)(L.P + row * KSTR + part * 16 + 8) = b;
}
__device__ __forceinline__ float row4_max(float v) {
    v = fmaxf(v, __shfl_xor(v, 1));
    v = fmaxf(v, __shfl_xor(v, 2));
    return v;
}
__device__ __forceinline__ float row4_sum(float v) {
    v += __shfl_xor(v, 1);
    v += __shfl_xor(v, 2);
    return v;
}

__device__ __forceinline__ void item_sb(const Params& p, int it) {
    const int tid = tid__, lane = tid & 63, wave = tid >> 6, quad = lane >> 4, c = lane & 15;
    const int qb = it & 63, h = (it >> 6) & 7, b = it >> 9;
    const int t0 = qb * 64;
    AttnLds L = attn_lds();
    bf16x8 qf[2];
    {
        const u16* g = p.yb + (long)(b * SS + t0 + wave * 16 + c) * NIN + C_SBQ + h * 64 + quad * 8;
        qf[0] = *(const bf16x8*)g;
        qf[1] = *(const bf16x8*)(g + 32);
    }
    const int row = lane >> 2, part = lane & 3;
    const int t = t0 + wave * 16 + row;
    float R = 0.f;
    f32x4 o[4];
#pragma unroll
    for (int dt = 0; dt < 4; ++dt) o[dt] = f32x4{0.f, 0.f, 0.f, 0.f};
    u32x4 pk0, pk1, pv0, pv1;
    {
        const u16* kbase = p.yb + (long)(b * SS + qb * 64) * NIN + h * 64;
        ldg_k(kbase + C_SBK, NIN, pk0, pk1);
        ldg_v(kbase + C_SBV, NIN, pv0, pv1);
    }
    for (int kb = qb; kb >= 0; --kb) {
        __syncthreads();
        sts_k(L.K, pk0, pk1);
        sts_v(L.Vt, pv0, pv1);
        __syncthreads();
        if (kb > 0) {
            const u16* kbase = p.yb + (long)(b * SS + (kb - 1) * 64) * NIN + h * 64;
            ldg_k(kbase + C_SBK, NIN, pk0, pk1);
            ldg_v(kbase + C_SBV, NIN, pv0, pv1);
        }
        wave_qk(L, 0, qf);
        __syncthreads();
        float z[16], lat[16];
        read_s16(L, row, part, z);
        float run = 0.f;
#pragma unroll
        for (int i = 15; i >= 0; --i) {
            const int key = kb * 64 + part * 16 + i;
            const bool valid = key < t;
            const float zz = z[i] * 0.125f;
            const float sp = fmaxf(zz, 0.f) + __logf(1.f + __expf(-fabsf(zz)));
            lat[i] = run;
            z[i] = valid ? (zz - sp) : -1e30f;
            run += valid ? -sp : 0.f;
        }
        const int lb = lane & ~3;
        const float t0_ = __shfl(run, lb), t1_ = __shfl(run, lb + 1), t2_ = __shfl(run, lb + 2), t3_ = __shfl(run, lb + 3);
        float off = R;
        if (part < 3) off += t3_;
        if (part < 2) off += t2_;
        if (part < 1) off += t1_;
        float pv[16];
#pragma unroll
        for (int i = 0; i < 16; ++i) pv[i] = (z[i] > -1e29f) ? __expf(z[i] + lat[i] + off) : 0.f;
        write_p16(L, row, part, pv);
        R += (t0_ + t1_) + (t2_ + t3_);
        const int done = __syncthreads_and(R < -110.f);
        wave_pv(L, 0, o);
        if (done) break;
    }
#pragma unroll
    for (int dt = 0; dt < 4; ++dt)
#pragma unroll
        for (int r = 0; r < 4; ++r)
            p.ysb[(long)(b * SS + t0 + wave * 16 + quad * 4 + r) * 512 + h * 64 + dt * 16 + c] = f2bf(o[dt][r]);
}

__device__ __forceinline__ void phase_cmp1_sb(const Params& p, int l, unsigned* ctr) {
    const int total = 32 + 8 * 8 * 64;
    WorkQ q; q.init(ctr, tid__ == 0);
    for (;;) {
        int it = q.next();
        if (it >= total) break;
        if (it < 32) tile_cmp1(p, l, it);
        else item_sb(p, it - 32);
    }
}

template <int MODE>
__device__ __forceinline__ void nsa_step(const AttnLds& L, const bf16x8 (&qf)[2], f32x4 (&o)[4], float& m, float& l,
                                         float slope, int t, int kpos0, bool rowsel) {
    const int lane = tid__ & 63, quad = lane >> 4;
    const int row = lane >> 2, part = lane & 3;
    wave_qk(L, 0, qf);
    __syncthreads();
    float z[16];
    read_s16(L, row, part, z);
    float pm = -1e30f;
#pragma unroll
    for (int i = 0; i < 16; ++i) {
        const int dist = t - (kpos0 + part * 16 + i);
        bool valid = dist >= 0;
        if (MODE == 1) valid = valid && rowsel;
        if (MODE == 2) valid = valid && (dist < 512);
        z[i] = valid ? (z[i] * 0.125f - slope * (float)dist) : -1e30f;
        pm = fmaxf(pm, z[i]);
    }
    pm = row4_max(pm);
    const float mn = fmaxf(m, pm);
    const float alpha = __expf(m - mn);
    float ps = 0.f;
#pragma unroll
    for (int i = 0; i < 16; ++i) {
        z[i] = (z[i] > -1e29f) ? __expf(z[i] - mn) : 0.f;
        ps += z[i];
    }
    ps = row4_sum(ps);
    l = l * alpha + ps;
    m = mn;
    write_p16(L, row, part, z);
    float al[4];
#pragma unroll
    for (int r = 0; r < 4; ++r) al[r] = __shfl(alpha, (quad * 4 + r) * 4);
    __syncthreads();
#pragma unroll
    for (int dt = 0; dt < 4; ++dt)
#pragma unroll
        for (int r = 0; r < 4; ++r) o[dt][r] *= al[r];
    wave_pv(L, 0, o);
    __syncthreads();
}

__device__ __forceinline__ void item_nsa(const Params& p, int it) {
    const int tid = tid__, lane = tid & 63, wave = tid >> 6, quad = lane >> 4, c = lane & 15;
    const int qb = 63 - (it >> 4), bg = it & 15, g = bg & 1, b = bg >> 1;
    const int t0 = qb * 64;
    AttnLds L = attn_lds();
    const int row = lane >> 2, part = lane & 3;
    const int t = t0 + wave * 16 + row;
    const long tokbase = (long)b * SS + t0 + wave * 16;
    float* ynf = p.ynf;
    const int nct = (2 * qb + 2 > 64) ? 2 : 1;
    const int nv = (t + 1) >> 5;
    __syncthreads();
    for (int ct = 0; ct < nct; ++ct) {
        load_k_tile(L.K, ct * 64, p.kvc + ((long)(b * 2 + g) * 128 + ct * 64) * 64, 64);
        load_v_tile(L.Vt, ct * 64, p.kvc + ((long)2048 + (b * 2 + g) * 128 + ct * 64) * 64, 64);
    }
    __syncthreads();
    float imp[2][8];
#pragma unroll
    for (int a = 0; a < 2; ++a)
#pragma unroll
        for (int j = 0; j < 8; ++j) imp[a][j] = 0.f;
#pragma unroll 1
    for (int r = 0; r < 4; ++r) {
        const float slope = exp2f(-(float)(g * 4 + r + 1));
        float m = -1e30f, l = 0.f;
        bf16x8 qfa[2];
        {
            const u16* gq = p.yb + (tokbase + c) * NIN + C_NQ + (g * 4 + r) * 64 + quad * 8;
            qfa[0] = *(const bf16x8*)gq;
            qfa[1] = *(const bf16x8*)(gq + 32);
        }
        for (int ct = 0; ct < nct; ++ct) {
            wave_qk(L, ct * 64, qfa);
            __syncthreads();
            float z[16];
            read_s16(L, row, part, z);
            float pm = -1e30f;
#pragma unroll
            for (int i = 0; i < 16; ++i) {
                const int cc = ct * 64 + part * 16 + i;
                const bool valid = cc < nv;
                z[i] = valid ? (z[i] * 0.125f - slope * (float)(t - (cc * 32 + 31))) : -1e30f;
                pm = fmaxf(pm, z[i]);
            }
            pm = row4_max(pm);
            const float mn = fmaxf(m, pm);
            float ps = 0.f;
#pragma unroll
            for (int i = 0; i < 16; ++i) ps += (z[i] > -1e29f) ? __expf(z[i] - mn) : 0.f;
            ps = row4_sum(ps);
            l = l * __expf(m - mn) + ps;
            m = mn;
            __syncthreads();
        }
        const float inv = (l > 0.f) ? 1.f / l : 0.f;
        f32x4 o[4];
#pragma unroll
        for (int dt = 0; dt < 4; ++dt) o[dt] = f32x4{0.f, 0.f, 0.f, 0.f};
#pragma unroll 1
        for (int ct = 0; ct < nct; ++ct) {
            wave_qk(L, ct * 64, qfa);
            __syncthreads();
            float z[16];
            read_s16(L, row, part, z);
#pragma unroll
            for (int i = 0; i < 16; ++i) {
                const int cc = ct * 64 + part * 16 + i;
                const bool valid = cc < nv;
                const float s = z[i] * 0.125f - slope * (float)(t - (cc * 32 + 31));
                z[i] = valid ? __expf(s - m) * inv : 0.f;
            }
            const float f0 = (ct == 0) ? 1.f : 0.f, f1 = 1.f - f0;
#pragma unroll
            for (int j = 0; j < 8; ++j) {
                const float pr = z[2 * j] + z[2 * j + 1];
                imp[0][j] += f0 * pr;
                imp[1][j] += f1 * pr;
            }
            write_p16(L, row, part, z);
            __syncthreads();
            wave_pv(L, ct * 64, o);
            __syncthreads();
        }
#pragma unroll
        for (int rr = 0; rr < 4; ++rr) {
            const long tok = tokbase + quad * 4 + rr;
            const float gt = sigmoidf_(bf2f(p.yb[tok * NIN + C_NG + (g * 4 + r) * 3 + 0]));
#pragma unroll
            for (int dt = 0; dt < 4; ++dt) ynf[tok * 512 + (g * 4 + r) * 64 + dt * 16 + c] = gt * o[dt][rr];
        }
    }
#pragma unroll
    for (int a = 0; a < 2; ++a)
#pragma unroll
        for (int j = 0; j < 8; ++j) L.S[row * SSTR + a * 32 + part * 8 + j] = imp[a][j];
    __syncthreads();
    unsigned long long un = 0ull;
#ifndef NSA_NOTOPK
#define NSA_NOTOPK 0
#endif
#pragma unroll 1
    for (int rr = 0; rr < (NSA_NOTOPK ? 0 : 16); ++rr) {
        float v = L.S[rr * SSTR + lane];
        const bool forced = (lane == 0) || (lane == qb) || (lane == qb - 1);
        const bool validb = lane <= qb;
        v = forced ? 1e6f : (validb ? v : -1e30f);
        int rank = 0;
#pragma unroll 8
        for (int i = 0; i < 64; ++i) {
            const float vi = __shfl(v, i);
            rank += ((vi > v) || (vi == v && i < lane)) ? 1 : 0;
        }
        const unsigned long long mk = __ballot((rank < 16) && validb);
        if (lane == 0) s_mask[wave][rr] = mk;
        un |= mk;
    }
    if (lane == 0) s_union[wave] = un;
    __syncthreads();
    const unsigned long long rowmask = s_mask[wave][row];
    unsigned long long umask;
    {
        const unsigned long long um_ = s_union[0] | s_union[1] | s_union[2] | s_union[3];
        const unsigned lo_ = __builtin_amdgcn_readfirstlane((unsigned)um_), hi_ = __builtin_amdgcn_readfirstlane((unsigned)(um_ >> 32));
        umask = ((unsigned long long)hi_ << 32) | lo_;
    }
#ifndef NSA_HPB
#define NSA_HPB 1
#endif
#ifndef NSA_NOBC
#define NSA_NOBC 0
#endif
#pragma unroll 1
    for (int hp = 0; hp < (NSA_NOBC ? 0 : 4 / NSA_HPB); ++hp) {
#pragma unroll 1
        for (int mode = 1; mode <= 2; ++mode) {
            f32x4 o[NSA_HPB][4];
            float m[NSA_HPB], l[NSA_HPB];
#pragma unroll
            for (int r = 0; r < NSA_HPB; ++r) {
                m[r] = -1e30f; l[r] = 0.f;
#pragma unroll
                for (int dt = 0; dt < 4; ++dt) o[r][dt] = f32x4{0.f, 0.f, 0.f, 0.f};
            }
            const int kb_lo = (mode == 1) ? 0 : ((qb - 8 > 0) ? qb - 8 : 0);
            const int colk = (mode == 1) ? C_KS : C_KW, colv = (mode == 1) ? C_VS : C_VW;
            for (int kb = kb_lo; kb <= qb; ++kb) {
                if (mode == 1 && !((umask >> kb) & 1ull)) continue;
                const u16* kbase = p.yb + (long)(b * SS + kb * 64) * NIN + g * 64;
                bf16x8 qf[NSA_HPB][2];
#pragma unroll
                for (int r = 0; r < NSA_HPB; ++r) {
                    const u16* gq = p.yb + (tokbase + c) * NIN + C_NQ + (g * 4 + hp * NSA_HPB + r) * 64 + quad * 8;
                    qf[r][0] = *(const bf16x8*)gq;
                    qf[r][1] = *(const bf16x8*)(gq + 32);
                }
                load_k_tile(L.K, 0, kbase + colk, NIN);
                load_v_tile(L.Vt, 0, kbase + colv, NIN);
                __syncthreads();
                const bool rowsel = (rowmask >> kb) & 1ull;
#pragma unroll
                for (int r = 0; r < NSA_HPB; ++r) {
                    const float slope = exp2f(-(float)(g * 4 + hp * NSA_HPB + r + 1));
                    if (mode == 1) nsa_step<1>(L, qf[r], o[r], m[r], l[r], slope, t, kb * 64, rowsel);
                    else nsa_step<2>(L, qf[r], o[r], m[r], l[r], slope, t, kb * 64, rowsel);
                }
            }
#pragma unroll
            for (int r = 0; r < NSA_HPB; ++r) {
                const int hh = g * 4 + hp * NSA_HPB + r;
#pragma unroll
                for (int rr = 0; rr < 4; ++rr) {
                    const long tok = tokbase + quad * 4 + rr;
                    const float lr = __shfl(l[r], (quad * 4 + rr) * 4);
                    const float gt = sigmoidf_(bf2f(p.yb[tok * NIN + C_NG + hh * 3 + mode])) / lr;
#pragma unroll
                    for (int dt = 0; dt < 4; ++dt) {
                        const long oi = tok * 512 + hh * 64 + dt * 16 + c;
                        const float v = ynf[oi] + gt * o[r][dt][rr];
                        if (mode == 1) ynf[oi] = v;
                        else p.ynsa[oi] = f2bf(v);
                    }
                }
            }
        }
    }
}
__device__ __forceinline__ void phase_nsa(const Params& p, unsigned* ctr) {
    WorkQ q; q.init(ctr, tid__ == 0);
    for (;;) {
        int it = q.next();
        if (it >= 1024) break;
        item_nsa(p, it);
    }
}

__device__ __forceinline__ void phase_br(const Params& p, int l, unsigned* ctr) {
    const int tid = tid__;
    XQ q; q.init(ctr, 32 * 8, tid__ == 0);
    for (;;) {
        int it = q.next();
        if (it < 0) break;
        int mt, nt; xq_decode(it, 32, 8, mt, nt);
        const int m0 = mt * 128, n0 = nt * 128;
        const u16* ap[4]; const u16* bp[4];
        f32x4 acc[4][4];
        acc_zero(acc);
#pragma unroll
        for (int i = 0; i < 4; ++i) {
            int r = (tid >> 3) + 32 * i;
            ap[i] = p.ysb + (long)(m0 + r) * 512;
            bp[i] = p.wt_brs + ((long)l * 1024 + n0 + r) * 512;
        }
        gemm_main(acc, ap, bp, 512, KId());
        EPI_COORDS
#pragma unroll
        for (int i = 0; i < 4; ++i)
#pragma unroll
            for (int j = 0; j < 4; ++j) {
                const int m = m0 + EPI_M(j), n = n0 + EPI_N(i);
                const uint2 ga = *(const uint2*)(p.yb + (long)m * NIN + C_GSB + n);
                float4 o;
                o.x = sigmoidf_(bf2f((u16)(ga.x & 0xffff))) * acc[i][j][0];
                o.y = sigmoidf_(bf2f((u16)(ga.x >> 16))) * acc[i][j][1];
                o.z = sigmoidf_(bf2f((u16)(ga.y & 0xffff))) * acc[i][j][2];
                o.w = sigmoidf_(bf2f((u16)(ga.y >> 16))) * acc[i][j][3];
                *(float4*)(p.pre1 + (long)m * 1024 + n) = o;
            }
        acc_zero(acc);
#pragma unroll
        for (int i = 0; i < 4; ++i) {
            int r = (tid >> 3) + 32 * i;
            ap[i] = p.ynsa + (long)(m0 + r) * 512;
            bp[i] = p.wt_brn + ((long)l * 1024 + n0 + r) * 512;
        }
        gemm_main(acc, ap, bp, 512, KId());
#pragma unroll
        for (int i = 0; i < 4; ++i)
#pragma unroll
            for (int j = 0; j < 4; ++j) {
                const int m = m0 + EPI_M(j), n = n0 + EPI_N(i);
                const uint2 gb = *(const uint2*)(p.yb + (long)m * NIN + C_GNSA + n);
                const float4 st = *(const float4*)(p.pre1 + (long)m * 1024 + n);
                st_bf4(p.merged + (long)m * 1024 + n,
                       st.x + sigmoidf_(bf2f((u16)(gb.x & 0xffff))) * acc[i][j][0],
                       st.y + sigmoidf_(bf2f((u16)(gb.x >> 16))) * acc[i][j][1],
                       st.z + sigmoidf_(bf2f((u16)(gb.y & 0xffff))) * acc[i][j][2],
                       st.w + sigmoidf_(bf2f((u16)(gb.y >> 16))) * acc[i][j][3]);
            }
    }
}
__device__ __forceinline__ void phase_wo(const Params& p, int l, unsigned* ctr) {
    const int tid = tid__;
    XQ q; q.init(ctr, 32 * 8, tid__ == 0);
    for (;;) {
        int it = q.next();
        if (it < 0) break;
        int mt, nt; xq_decode(it, 32, 8, mt, nt);
        const int m0 = mt * 128, n0 = nt * 128;
        const u16* ap[4]; const u16* bp[4];
        f32x4 acc[4][4]; acc_zero(acc);
#pragma unroll
        for (int i = 0; i < 4; ++i) {
            int r = (tid >> 3) + 32 * i;
            ap[i] = p.merged + (long)(m0 + r) * 1024;
            bp[i] = p.wt_o + ((long)l * 1024 + n0 + r) * 1024;
        }
        gemm_main(acc, ap, bp, 1024, KId());
        EPI_COORDS
#pragma unroll
        for (int i = 0; i < 4; ++i)
#pragma unroll
            for (int j = 0; j < 4; ++j) {
                const int m = m0 + EPI_M(j), n = n0 + EPI_N(i);
                const float4 hv = *(const float4*)(p.hf + (long)m * 1024 + n);
                float4 o;
                o.x = DN_ALPHA * hv.x + acc[i][j][0]; o.y = DN_ALPHA * hv.y + acc[i][j][1];
                o.z = DN_ALPHA * hv.z + acc[i][j][2]; o.w = DN_ALPHA * hv.w + acc[i][j][3];
                *(float4*)(p.pre1 + (long)m * 1024 + n) = o;
            }
    }
}
__device__ __forceinline__ float wave_sum(float v) {
#pragma unroll
    for (int s = 32; s >= 1; s >>= 1) v += __shfl_xor(v, s);
    return v;
}
__device__ __forceinline__ void phase_ln(const Params& p, int l, int mode, unsigned* ctr) {
    const int lane = tid__ & 63, wave = tid__ >> 6;
    const float* gam = (mode == 1 ? p.ln1_g : p.ln2_g) + l * 1024;
    const float* bet = (mode == 1 ? p.ln1_b : p.ln2_b) + l * 1024;
    WorkQ q; q.init(ctr, tid__ == 0);
    for (;;) {
        int it = q.next();
        if (it >= TT / 64) break;
        for (int rr = 0; rr < 16; rr += 2) {
            float v[2][16];
#pragma unroll
            for (int u = 0; u < 2; ++u) {
                const long row = (long)it * 64 + wave * 16 + rr + u;
#pragma unroll
                for (int i = 0; i < 4; ++i) {
                    const int col = i * 256 + lane * 4;
                    float4 a;
                    if (mode == 1) a = *(const float4*)(p.pre1 + row * 1024 + col);
                    else {
                        a = *(const float4*)(p.h1f + row * 1024 + col);
                        a.x *= DN_ALPHA; a.y *= DN_ALPHA; a.z *= DN_ALPHA; a.w *= DN_ALPHA;
                        const uint2 pl = *(const uint2*)(p.ple + row * 1024 + col);
                        a.x += bf2f((u16)(pl.x & 0xffff)); a.y += bf2f((u16)(pl.x >> 16));
                        a.z += bf2f((u16)(pl.y & 0xffff)); a.w += bf2f((u16)(pl.y >> 16));
#pragma unroll
                        for (int s4 = 0; s4 < 4; ++s4) {
                            const uint2 y = *(const uint2*)(p.y4 + (row * 4 + s4) * 1024 + col);
                            a.x += bf2f((u16)(y.x & 0xffff)); a.y += bf2f((u16)(y.x >> 16));
                            a.z += bf2f((u16)(y.y & 0xffff)); a.w += bf2f((u16)(y.y >> 16));
                        }
                    }
                    v[u][i * 4 + 0] = a.x; v[u][i * 4 + 1] = a.y; v[u][i * 4 + 2] = a.z; v[u][i * 4 + 3] = a.w;
                }
            }
#pragma unroll
            for (int u = 0; u < 2; ++u) {
                const long row = (long)it * 64 + wave * 16 + rr + u;
                float sm = 0.f;
#pragma unroll
                for (int i = 0; i < 16; ++i) sm += v[u][i];
                const float mean = wave_sum(sm) * (1.f / 1024.f);
                float s2 = 0.f;
#pragma unroll
                for (int i = 0; i < 16; ++i) { v[u][i] -= mean; s2 += v[u][i] * v[u][i]; }
                const float rstd = rsqrtf(wave_sum(s2) * (1.f / 1024.f) + 1e-5f);
#pragma unroll
                for (int i = 0; i < 4; ++i) {
                    const int col = i * 256 + lane * 4;
                    const float4 gg = *(const float4*)(gam + col), bb = *(const float4*)(bet + col);
                    float4 y;
                    y.x = v[u][i * 4 + 0] * rstd * gg.x + bb.x; y.y = v[u][i * 4 + 1] * rstd * gg.y + bb.y;
                    y.z = v[u][i * 4 + 2] * rstd * gg.z + bb.z; y.w = v[u][i * 4 + 3] * rstd * gg.w + bb.w;
                    if (mode == 1) {
                        *(float4*)(p.h1f + row * 1024 + col) = y;
                        const u16 h0 = f2bf(y.x), h1 = f2bf(y.y), h2 = f2bf(y.z), h3 = f2bf(y.w);
                        uint2 uu; uu.x = (unsigned)h0 | ((unsigned)h1 << 16); uu.y = (unsigned)h2 | ((unsigned)h3 << 16);
                        *(uint2*)(p.h1b + row * 1024 + col) = uu;
                        st_bf4(p.h1lo + row * 1024 + col, y.x - bf2f(h0), y.y - bf2f(h1), y.z - bf2f(h2), y.w - bf2f(h3));
                    } else {
                        if (l == 3) *(float4*)(p.out + row * 1024 + col) = y;
                        else {
                            *(float4*)(p.hf + row * 1024 + col) = y;
                            st_bf4(p.hb + row * 1024 + col, y.x, y.y, y.z, y.w);
                        }
                    }
                }
            }
        }
    }
}
struct KRouter {
    long dlo;
    __device__ __forceinline__ long operator()(int k) const { return (k < 2048) ? (long)(k & 1023) : (dlo + (k - 2048)); }
};
__device__ __forceinline__ void phase_router_ple(const Params& p, int l, unsigned* ctr) {
    const int tid = tid__;
    XQ q; q.init(ctr, 32 * 9, tid__ == 0);
    for (;;) {
        int it = q.next();
        if (it < 0) break;
        int mt, nt; xq_decode(it, 32, 9, mt, nt);
        const u16* ap[4]; const u16* bp[4];
        if (nt == 8) {
            const int m0 = mt * 128;
            f32x4 acc[4][4]; acc_zero(acc);
#pragma unroll
            for (int i = 0; i < 4; ++i) {
                int r = (tid >> 3) + 32 * i;
                ap[i] = p.h1b + (long)(m0 + r) * 1024;
                bp[i] = p.wt_r + ((long)l * 32 + (r & 31)) * 3072;
            }
            KRouter kr; kr.dlo = (long)(p.h1lo - p.h1b);
            gemm_main(acc, ap, bp, 3072, kr);
            EPI_COORDS
#pragma unroll
            for (int i = 0; i < 4; ++i)
#pragma unroll
                for (int j = 0; j < 4; ++j) {
                    const int m = m0 + EPI_M(j), n = EPI_N(i);
                    if (n < 32) {
                        const float4 bb = *(const float4*)(p.b_router + l * 32 + n);
                        float4 o; o.x = acc[i][j][0] + bb.x; o.y = acc[i][j][1] + bb.y; o.z = acc[i][j][2] + bb.z; o.w = acc[i][j][3] + bb.w;
                        *(float4*)(p.logits + (long)m * 32 + n) = o;
                    }
                }
        } else {
            const int m0 = mt * 128, n0 = nt * 128;
            f32x4 acc[4][4];
            acc_zero(acc);
#pragma unroll
            for (int i = 0; i < 4; ++i) {
                int r = (tid >> 3) + 32 * i;
                ap[i] = p.pb + ((long)l * TT + m0 + r) * 256;
                bp[i] = p.wt_pp + ((long)l * 1024 + n0 + r) * 256;
            }
            gemm_main(acc, ap, bp, 256, KId());
            EPI_COORDS
#pragma unroll
            for (int i = 0; i < 4; ++i)
#pragma unroll
                for (int j = 0; j < 4; ++j) {
                    const int m = m0 + EPI_M(j), n = n0 + EPI_N(i);
                    float4 o; o.x = acc[i][j][0]; o.y = acc[i][j][1]; o.z = acc[i][j][2]; o.w = acc[i][j][3];
                    *(float4*)(p.pre1 + (long)m * 1024 + n) = o;
                }
            acc_zero(acc);
#pragma unroll
            for (int i = 0; i < 4; ++i) {
                int r = (tid >> 3) + 32 * i;
                ap[i] = p.h1b + (long)(m0 + r) * 1024;
                bp[i] = p.wt_pg + ((long)l * 1024 + n0 + r) * 1024;
            }
            gemm_main(acc, ap, bp, 1024, KId());
#pragma unroll
            for (int i = 0; i < 4; ++i)
#pragma unroll
                for (int j = 0; j < 4; ++j) {
                    const int m = m0 + EPI_M(j), n = n0 + EPI_N(i);
                    const float4 st = *(const float4*)(p.pre1 + (long)m * 1024 + n);
                    st_bf4(p.ple + (long)m * 1024 + n, sigmoidf_(acc[i][j][0]) * st.x, sigmoidf_(acc[i][j][1]) * st.y,
                           sigmoidf_(acc[i][j][2]) * st.z, sigmoidf_(acc[i][j][3]) * st.w);
                }
        }
    }
}
__device__ __forceinline__ void phase_route(const Params& p, int l, unsigned* ctr) {
    const int tid = tid__;
    int* s_cnt = s_misc;
    int* s_base = s_misc + 32;
    WorkQ q; q.init(ctr, tid__ == 0);
    for (;;) {
        int it = q.next();
        if (it >= TT / 256) break;
        if (tid < 32) s_cnt[tid] = 0;
        __syncthreads();
        const int t = it * 256 + tid;
        float lg[32];
#pragma unroll
        for (int i = 0; i < 8; ++i) {
            const float4 v = *(const float4*)(p.logits + (long)t * 32 + i * 4);
            lg[i * 4 + 0] = v.x; lg[i * 4 + 1] = v.y; lg[i * 4 + 2] = v.z; lg[i * 4 + 3] = v.w;
        }
        unsigned taken = 0u;
        int ek[4]; float vk[4];
#pragma unroll
        for (int k = 0; k < 4; ++k) {
            float best = -3.0e38f; int bi = 0;
#pragma unroll
            for (int e = 0; e < 32; ++e) {
                const bool ok = !((taken >> e) & 1u) && (lg[e] > best);
                best = ok ? lg[e] : best;
                bi = ok ? e : bi;
            }
            taken |= 1u << bi;
            ek[k] = bi; vk[k] = best;
        }
        float wsum = 0.f;
        float v0 = -3.0e38f, v1 = 0.f, v2 = 0.f, v3 = 0.f;
#pragma unroll
        for (int e = 0; e < 32; ++e) {
            v0 = (e == ek[0]) ? lg[e] : v0;
            v1 = (e == ek[1]) ? lg[e] : v1;
            v2 = (e == ek[2]) ? lg[e] : v2;
            v3 = (e == ek[3]) ? lg[e] : v3;
        }
        vk[0] = 1.f; vk[1] = __expf(v1 - v0); vk[2] = __expf(v2 - v0); vk[3] = __expf(v3 - v0);
        wsum = vk[0] + vk[1] + vk[2] + vk[3];
        const float winv = 1.f / wsum;
        int lp[4];
#pragma unroll
        for (int k = 0; k < 4; ++k) lp[k] = atomicAdd(&s_cnt[ek[k]], 1);
        __syncthreads();
        if (tid < 32) s_base[tid] = (int)atomicAdd(&p.ecnt[l * 32 + tid], (unsigned)s_cnt[tid]);
        __syncthreads();
#pragma unroll
        for (int k = 0; k < 4; ++k) {
            const long idx = (long)ek[k] * TT + s_base[ek[k]] + lp[k];
            p.ent_id[idx] = t * 4 + k;
            p.ent_w[idx] = vk[k] * winv;
        }
    }
}
__device__ __forceinline__ void moe_prefix(const Params& p, int l) {
    __syncthreads();
    if (tid__ == 0) {
        int acc = 0;
        for (int e = 0; e < 32; ++e) {
            const int n = (int)__hip_atomic_load(&p.ecnt[l * 32 + e], __ATOMIC_RELAXED, __HIP_MEMORY_SCOPE_AGENT);
            s_misc[e] = acc;
            s_misc[40 + e] = n;
            acc += (n + 127) >> 7;
        }
        s_misc[32] = acc;
    }
    __syncthreads();
}
__device__ __forceinline__ void phase_moe_gu(const Params& p, int l, unsigned* ctr) {
    const int tid = tid__;
    moe_prefix(p, l);
    const int mtotal = s_misc[32];
    const int mpx = (((mtotal + 7) >> 3) + 7) & ~7;
    XQ q; q.init(ctr, mpx * 16, tid__ == 0);
    for (;;) {
        int it = q.next();
        if (it < 0) break;
        int mtg, nt; xq_decode(it, mpx, 16, mtg, nt);
        if (mtg >= mtotal) continue;
        int e = 0;
        for (int i = 1; i < 32; ++i) e = (s_misc[i] <= mtg) ? i : e;
        const int mt = mtg - s_misc[e], ne = s_misc[40 + e];
        const u16* ap[4]; const u16* bp[4];
#pragma unroll
        for (int i = 0; i < 4; ++i) {
            const int r = (tid >> 3) + 32 * i;
            int idx = mt * 128 + r; if (idx > ne - 1) idx = ne - 1;
            const int tok = p.ent_id[(long)e * TT + idx] >> 2;
            ap[i] = p.h1b + (long)tok * 1024;
            const int isup = (r >> 5) & 1, col = (r >> 6) * 32 + (r & 31);
            bp[i] = p.wt_gu + (((long)l * 32 + e) * 2048 + isup * 1024 + nt * 64 + col) * 1024;
        }
        f32x4 acc[4][4]; acc_zero(acc);
        gemm_main(acc, ap, bp, 1024, KId());
        EPI_COORDS
        const float* bg = p.b_gu + ((long)l * 32 + e) * 2048;
#pragma unroll
        for (int i = 0; i < 2; ++i)
#pragma unroll
            for (int j = 0; j < 4; ++j) {
                const long rowa = (long)mtg * 128 + EPI_M(j);
                const int col = nt * 64 + wn_ * 32 + i * 16 + (lane_ >> 4) * 4;
                float v[4];
#pragma unroll
                for (int r = 0; r < 4; ++r) {
                    float gate = acc[i][j][r] + bg[col + r];
                    float up = acc[i + 2][j][r] + bg[1024 + col + r];
                    gate = fminf(gate, 7.f);
                    up = fminf(fmaxf(up, -7.f), 7.f);
                    v[r] = (up + 1.f) * gate * sigmoidf_(1.702f * gate);
                }
                st_bf4(p.act + rowa * 1024 + col, v[0], v[1], v[2], v[3]);
            }
    }
}
__device__ __forceinline__ void phase_moe_down(const Params& p, int l, unsigned* ctr) {
    const int tid = tid__;
    moe_prefix(p, l);
    const int mtotal = s_misc[32];
    const int mpx = (((mtotal + 7) >> 3) + 7) & ~7;
    XQ q; q.init(ctr, mpx * 8, tid__ == 0);
    for (;;) {
        int it = q.next();
        if (it < 0) break;
        int mtg, nt; xq_decode(it, mpx, 8, mtg, nt);
        if (mtg >= mtotal) continue;
        int e = 0;
        for (int i = 1; i < 32; ++i) e = (s_misc[i] <= mtg) ? i : e;
        const int mt = mtg - s_misc[e], ne = s_misc[40 + e];
        const u16* ap[4]; const u16* bp[4];
#pragma unroll
        for (int i = 0; i < 4; ++i) {
            const int r = (tid >> 3) + 32 * i;
            ap[i] = p.act + ((long)mtg * 128 + r) * 1024;
            bp[i] = p.wt_dn + (((long)l * 32 + e) * 1024 + nt * 128 + r) * 1024;
        }
        f32x4 acc[4][4]; acc_zero(acc);
        gemm_main(acc, ap, bp, 1024, KId());
        EPI_COORDS
        const float* bd = p.b_down + ((long)l * 32 + e) * 1024;
#pragma unroll
        for (int j = 0; j < 4; ++j) {
            const int idx = mt * 128 + EPI_M(j);
            if (idx < ne) {
                const int id = p.ent_id[(long)e * TT + idx];
                const float cw = p.ent_w[(long)e * TT + idx];
#pragma unroll
                for (int i = 0; i < 4; ++i) {
                    const int n = nt * 128 + EPI_N(i);
                    const float4 bb = *(const float4*)(bd + n);
                    st_bf4(p.y4 + (long)id * 1024 + n, cw * (acc[i][j][0] + bb.x), cw * (acc[i][j][1] + bb.y),
                           cw * (acc[i][j][2] + bb.z), cw * (acc[i][j][3] + bb.w));
                }
            }
        }
    }
}

};
#ifndef PH0_EN
#define PH0_EN 1
#endif
__device__ __forceinline__ void run_phase(const Params& p, int ph, int coff, int wv) {
    unsigned* ctr = p.ctr + (ph + coff) * 8;
    Ctx cx;
    {
        int t_ = wv * 64 + (int)__lane_id();
        asm volatile("" : "+v"(t_));
        cx.tid__ = t_;
    }
    if (ph == 0) { if (PH0_EN) cx.phase_prologue(p, ctr); return; }
    const int l = (ph - 1) / NPH_LAYER, s = (ph - 1) % NPH_LAYER;
#ifndef ONLY_S
#define ONLY_S -1
#endif
#ifndef SKIP_S
#define SKIP_S -1
#endif
#define PH_EN(x) ((ONLY_S < 0 || ONLY_S == (x)) && SKIP_S != (x))
    if (PH_EN(0) && s == 0) cx.phase_gemm_in(p, l, ctr);
    if (PH_EN(1) && s == 1) cx.phase_cmp1_sb(p, l, ctr);
    if (PH_EN(2) && s == 2) cx.phase_cmp2(p, l, ctr);
    if (PH_EN(3) && s == 3) cx.phase_nsa(p, ctr);
    if (PH_EN(4) && s == 4) cx.phase_br(p, l, ctr);
    if (PH_EN(5) && s == 5) cx.phase_wo(p, l, ctr);
    if (PH_EN(6) && s == 6) cx.phase_ln(p, l, 1, ctr);
    if (PH_EN(7) && s == 7) cx.phase_router_ple(p, l, ctr);
    if (PH_EN(8) && s == 8) cx.phase_route(p, l, ctr);
    if (PH_EN(9) && s == 9) cx.phase_moe_gu(p, l, ctr);
    if (PH_EN(10) && s == 10) cx.phase_moe_down(p, l, ctr);
    if (PH_EN(11) && s == 11) cx.phase_ln(p, l, 2, ctr);
}

__global__ void __launch_bounds__(256, 2) mega_kernel(Params p, int ph0, int ph1) {
    __shared__ uint4 xb_words;
    const int wv = __builtin_amdgcn_readfirstlane((int)(threadIdx.x >> 6));
    const bool t0 = (threadIdx.x == 0);
    if (t0) xb_words = make_uint4(0u, 0u, 0u, 0u);
    __syncthreads();
    __shared__ Params s_p;
    if (t0) {
        const void* const* src_ = (const void* const*)&p;
        const void** dst_ = (const void**)&s_p;
#pragma unroll
        for (int i = 0; i < (int)(sizeof(Params) / sizeof(void*)); ++i) dst_[i] = src_[i];
    }
    __syncthreads();
    XcdBarrier bar = xcd_barrier_post(p.bar, (volatile LAS unsigned*)&xb_words, t0);
    for (int ph = ph0; ph < ph1; ++ph) {
        const bool t0p = (wv == 0) && (__lane_id() == 0);
        if (ph > ph0) xcd_barrier(bar, t0p);
        asm volatile("" ::: "memory");
        run_phase(s_p, ph, 0, wv);
#if REP_MASK
        if (ph > 0 && ((REP_MASK >> ((ph - 1) % NPH_LAYER)) & 1)) {
            xcd_barrier(bar, t0p);
            asm volatile("" ::: "memory");
            run_phase(s_p, ph, 64, wv);
        }
#endif
    }
}

#ifndef REP_MASK
#define REP_MASK 0
#endif
#ifndef MK_SPLIT
#define MK_SPLIT 0
#endif

extern "C" void kernel_launch(void* const* d_in, const int* in_sizes, int n_in, void* d_out, int out_size, void* d_ws,
                              size_t ws_size, hipStream_t stream) {
    static int grid = 0;
    if (!grid) {
        int dev = 0, cus = 0, per_cu = 0;
        hipGetDevice(&dev);
        hipDeviceGetAttribute(&cus, hipDeviceAttributeMultiprocessorCount, dev);
        hipOccupancyMaxActiveBlocksPerMultiprocessor(&per_cu, mega_kernel, 256, 0);
        if (per_cu < 1) per_cu = 1;
        grid = cus * (per_cu < 2 ? per_cu : 2);
    }
    Params p;
    memset(&p, 0, sizeof(p));
    const float** pin = (const float**)&p;
    for (int i = 0; i < 21; ++i) pin[i] = (const float*)d_in[i];
    p.out = (float*)d_out;
    char* w = (char*)d_ws;
    size_t off = 0;
    auto take = [&](size_t bytes) { char* r = w + off; off += (bytes + 255) & ~(size_t)255; return r; };
    const size_t sync_bytes = (XCD_BAR_WORDS + 1024 + 128) * sizeof(unsigned);
    p.bar = (unsigned*)take(sync_bytes);
    p.ctr = p.bar + XCD_BAR_WORDS;
    p.ecnt = p.ctr + 1024;
    p.wt_in = (u16*)take((size_t)4 * NIN * 1024 * 2);
    p.wt_brs = (u16*)take((size_t)4 * 512 * 1024 * 2);
    p.wt_brn = (u16*)take((size_t)4 * 512 * 1024 * 2);
    p.wt_o = (u16*)take((size_t)4 * 1024 * 1024 * 2);
    p.wt_pg = (u16*)take((size_t)4 * 1024 * 1024 * 2);
    p.wt_pp = (u16*)take((size_t)4 * 256 * 1024 * 2);
    p.wt_gu = (u16*)take((size_t)128 * 2048 * 1024 * 2);
    p.wt_dn = (u16*)take((size_t)128 * 1024 * 1024 * 2);
    p.wt_c1 = (u16*)take((size_t)8 * 128 * 2048 * 2);
    p.wt_c2 = (u16*)take((size_t)8 * 64 * 128 * 2);
    p.wt_r = (u16*)take((size_t)4 * 32 * 3072 * 2);
    p.cbias = (float*)take(1024 * 4);
    p.hf = (float*)take((size_t)TT * 1024 * 4);
    p.pre1 = (float*)take((size_t)TT * 1024 * 4);
    p.h1f = (float*)take((size_t)TT * 1024 * 4);
    p.logits = (float*)take((size_t)TT * 32 * 4);
    p.ynf = (float*)take((size_t)TT * 512 * 4);
    p.ent_w = (float*)take((size_t)32 * TT * 4);
    p.hb = (u16*)take((size_t)TT * 1024 * 2);
    p.pb = (u16*)take((size_t)4 * TT * 256 * 2);
    p.yb = (u16*)take((size_t)TT * NIN * 2);
    p.ysb = (u16*)take((size_t)TT * 512 * 2);
    p.ynsa = (u16*)take((size_t)TT * 512 * 2);
    p.merged = (u16*)take((size_t)TT * 1024 * 2);
    p.h1b = (u16*)take((size_t)TT * 1024 * 2);
    p.h1lo = (u16*)take((size_t)TT * 1024 * 2);
    p.ple = (u16*)take((size_t)TT * 1024 * 2);
    p.hid = (u16*)take((size_t)2 * 2048 * 128 * 2);
    p.kvc = (u16*)take((size_t)2 * 2048 * 64 * 2);
    p.act = (u16*)take((size_t)(TT * 4 + 32 * 128) * 1024 * 2);
    p.y4 = (u16*)take((size_t)TT * 4 * 1024 * 2);
    p.ent_id = (int*)take((size_t)32 * TT * 4);
    if (off > ws_size) { fprintf(stderr, "workspace too small: need %zu have %zu\n", off, ws_size); return; }
    hipMemsetAsync(p.bar, 0, sync_bytes, stream);
#if MK_SPLIT
    for (int ph = 0; ph < NPHASE; ++ph) mega_kernel<<<dim3(grid), dim3(256), 0, stream>>>(p, ph, ph + 1);
#else
    mega_kernel<<<dim3(grid), dim3(256), 0, stream>>>(p, 0, NPHASE);
#endif
}
```

```cpp
#define NSA_HPB 2
#include <hip/hip_runtime.h>
#include <stdint.h>
#include <cstdio>
#include <cstring>
#include <cstdlib>
#include <vector>

#define XB_TMO      128
#define XB_XCNT(j)  (256  + 64 * (j))
#define XB_XSUB(j)  (1280 + 64 * (j))
#define XB_XGEN(j)  (2304 + 64 * (j))
#define XB_TOP      3328
#define XB_TOPGEN   3392
#define XCD_BAR_WORDS 3456
#define XB_SPIN_CAP (1u << 18)
#define LAS __attribute__((address_space(3)))

__device__ __forceinline__ unsigned xb_ld(unsigned* p)              { return __hip_atomic_load(p, __ATOMIC_RELAXED, __HIP_MEMORY_SCOPE_AGENT); }
__device__ __forceinline__ unsigned xb_add(unsigned* p, unsigned v) { return __hip_atomic_fetch_add(p, v, __ATOMIC_RELAXED, __HIP_MEMORY_SCOPE_AGENT); }
__device__ __forceinline__ unsigned xb_xcc_id() { return (unsigned)__builtin_amdgcn_s_getreg((3 << 11) | 20) & 0xFu; }
#define XB_SPIN(cond, bar) do { unsigned _sp = 0; while (cond) { __builtin_amdgcn_s_sleep(1); \
    if ((++_sp & 255u) == 0u) { if (xb_ld(&(bar)[XB_TMO])) break; if (_sp > XB_SPIN_CAP) { atomicAdd(&(bar)[XB_TMO], 1u); break; } } } } while (0)

struct XcdBarrier {
    unsigned* bar; unsigned x;
    volatile LAS unsigned* st;
};

__device__ __forceinline__ XcdBarrier xcd_barrier_post(unsigned* bar, volatile LAS unsigned* st, const bool xb_t0) {
    XcdBarrier b; b.bar = bar; b.x = xb_xcc_id(); b.st = st;
    if (xb_t0) (void)xb_add(&bar[XB_XCNT(b.x)], 1u);
    return b;
}
__device__ __forceinline__ void xcd_barrier_complete(unsigned* bar, unsigned x, unsigned& nloc, unsigned& nx) {
    const unsigned G = gridDim.x * gridDim.y * gridDim.z;
    unsigned sum, cnt, mine, sp = 0u;
    for (;;) {
        sum = 0u; cnt = 0u; mine = 0u;
#pragma unroll
        for (unsigned j = 0; j < 16; ++j) { const unsigned c = xb_ld(&bar[XB_XCNT(j)]); sum += c; cnt += (c > 0u) ? 1u : 0u; mine = (j == x) ? c : mine; }
        if (sum == G) break;
        __builtin_amdgcn_s_sleep(1);
        if ((++sp & 255u) == 0u) { if (xb_ld(&bar[XB_TMO])) break; if (sp > XB_SPIN_CAP) { atomicAdd(&bar[XB_TMO], 1u); break; } }
    }
    nloc = mine > 0u ? mine : 1u; nx = cnt > 0u ? cnt : 1u;
}

__device__ __forceinline__ void xcd_barrier(const XcdBarrier& b, const bool xb_t0) {
    asm volatile("s_waitcnt vmcnt(0)" ::: "memory");
    __syncthreads();
    if (xb_t0) {
        unsigned* bar = b.bar;
        __builtin_amdgcn_s_waitcnt(0);
        unsigned nloc = b.st[0], nx = b.st[1];
        if (nloc == 0u) { xcd_barrier_complete(bar, b.x, nloc, nx); b.st[0] = nloc; b.st[1] = nx; }
        const unsigned old = xb_add(&bar[XB_XSUB(b.x)], 1u);
        const unsigned gen = old / nloc;
        if (old + 1u == (gen + 1u) * nloc) {
            __builtin_amdgcn_fence(__ATOMIC_RELEASE, "agent");
            asm volatile("s_waitcnt vmcnt(0)" ::: "memory");
            const unsigned og = xb_add(&bar[XB_TOP], 1u);
            const unsigned tg = og / nx;
            if (og + 1u == (tg + 1u) * nx) xb_add(&bar[XB_TOPGEN], 1u);
            else XB_SPIN(xb_ld(&bar[XB_TOPGEN]) == tg, bar);
            __builtin_amdgcn_fence(__ATOMIC_ACQUIRE, "agent");
            xb_add(&bar[XB_XGEN(b.x)], 1u);
            asm volatile("s_waitcnt vmcnt(0)" ::: "memory");
        } else {
            XB_SPIN(xb_ld(&bar[XB_XGEN(b.x)]) == gen, bar);
            __builtin_amdgcn_fence(__ATOMIC_ACQUIRE, "agent");
            asm volatile("s_waitcnt vmcnt(0)" ::: "memory");
        }
    }
    __syncthreads();
}


#ifndef REP_MASK
#define REP_MASK 0
#endif
typedef unsigned short u16;
typedef __attribute__((ext_vector_type(8))) short bf16x8;
typedef __attribute__((ext_vector_type(4))) float f32x4;
typedef __attribute__((ext_vector_type(4))) unsigned u32x4;
#define MFMA(a, b, c) __builtin_amdgcn_mfma_f32_16x16x32_bf16(a, b, c, 0, 0, 0)

#define TT 32768
#define SS 4096
#define DD 1024
#define NIN 4888
#define C_SBQ 0
#define C_SBK 512
#define C_SBV 1024
#define C_NQ 1536
#define C_KC 2048
#define C_VC 2176
#define C_KS 2304
#define C_VS 2432
#define C_KW 2560
#define C_VW 2688
#define C_NG 2816
#define C_GSB 2840
#define C_GNSA 3864
#define DN_ALPHA 1.681792830507429f
#define NPH_LAYER 12
#define NPHASE (1 + 4 * NPH_LAYER)
#define KSTR 72
#define VSTR 136
#define SSTR 68

struct Params {
    const float *x, *p, *w_in, *w_cmp1, *w_cmp2, *pe_cmp, *w_br_sb, *w_br_nsa, *w_o, *ln1_g, *ln1_b, *ln2_g, *ln2_b,
        *w_router, *b_router, *w_gu, *b_gu, *w_down, *b_down, *w_ple_gate, *w_ple_proj;
    float* out;
    unsigned *bar, *ctr, *ecnt;
    u16 *wt_in, *wt_brs, *wt_brn, *wt_o, *wt_pg, *wt_pp, *wt_gu, *wt_dn, *wt_c1, *wt_c2, *wt_r;
    float *cbias, *hf, *pre1, *h1f, *logits, *ynf, *ent_w;
    u16 *hb, *pb, *yb, *ysb, *ynsa, *merged, *h1b, *h1lo, *ple, *hid, *kvc, *act, *y4;
    int* ent_id;
};

__device__ __forceinline__ u16 f2bf(float f) {
    unsigned u = __float_as_uint(f);
    u += 0x7fffu + ((u >> 16) & 1u);
    return (u16)(u >> 16);
}
__device__ __forceinline__ float bf2f(u16 h) { return __uint_as_float(((unsigned)h) << 16); }
__device__ __forceinline__ void st_bf4(u16* p, float a, float b, float c, float d) {
    uint2 u;
    u.x = (unsigned)f2bf(a) | ((unsigned)f2bf(b) << 16);
    u.y = (unsigned)f2bf(c) | ((unsigned)f2bf(d) << 16);
    *(uint2*)p = u;
}
__device__ __forceinline__ float sigmoidf_(float x) { return 1.f / (1.f + __expf(-x)); }

__shared__ __attribute__((aligned(16))) unsigned char g_smem[62464];
__shared__ int s_item;
__shared__ int s_misc[80];
__shared__ unsigned long long s_mask[4][16];
__shared__ unsigned long long s_union[4];

struct WorkQ {
    unsigned* ctr;
    int nxt;
    bool t0;
    __device__ __forceinline__ void init(unsigned* c, bool t0_) {
        ctr = c;
        nxt = 0;
        t0 = t0_;
        if (t0) nxt = (int)atomicAdd(ctr, 1u);
    }
    __device__ __forceinline__ int next() {
        __syncthreads();
        if (t0) s_item = nxt;
        __syncthreads();
        int it = s_item;
        if (t0) nxt = (int)atomicAdd(ctr, 1u);
        return it;
    }
};


struct XQ {
    unsigned* ctr;
    int per, x0, k, nxt;
    bool t0;
    __device__ __forceinline__ void init(unsigned* c, int per_, bool t0_) {
        ctr = c; per = per_; k = 0; nxt = 0; t0 = t0_;
        x0 = (int)(xb_xcc_id() & 7u);
        if (t0) nxt = (int)atomicAdd(&ctr[x0], 1u);
    }
    __device__ __forceinline__ int next() {
        __syncthreads();
        if (t0) {
            int v = nxt;
            while (v >= per && k < 8) {
                ++k;
                if (k < 8) v = (int)atomicAdd(&ctr[(x0 + k) & 7], 1u);
            }
            if (k < 8) {
                s_item = ((x0 + k) & 7) * per + v;
                nxt = (int)atomicAdd(&ctr[(x0 + k) & 7], 1u);
            } else s_item = -1;
        }
        __syncthreads();
        return s_item;
    }
};
__device__ __forceinline__ void xq_decode(int item, int mpx, int NT, int& mt, int& nt) {
    const int per = mpx * NT;
    const int q = item / per, idx = item - q * per;
    const int sm = idx / (8 * NT), rem = idx - sm * (8 * NT);
    nt = rem >> 3;
    mt = q * mpx + sm * 8 + (rem & 7);
}
struct Ctx {
    int tid__;
struct KId {
    __device__ __forceinline__ long operator()(int k) const { return k; }
};
template <class KOA>
__device__ __forceinline__ void gemm_main(f32x4 (&acc)[4][4], const u16* (&ap)[4], const u16* (&bp)[4], int K, KOA koa) {
    u16* sA = (u16*)g_smem;
    u16* sB = sA + 128 * KSTR;
    const int tid = tid__, lane = tid & 63, wave = tid >> 6;
    const int wn = wave & 1, wm = wave >> 1;
    const int kc = (tid & 7) * 8;
    const int lrow = tid >> 3;
    u32x4 ra[4], rb[4];
    {
        const long oa = koa(kc);
#pragma unroll
        for (int i = 0; i < 4; ++i) {
            ra[i] = *(const u32x4*)(ap[i] + oa);
            rb[i] = *(const u32x4*)(bp[i] + kc);
        }
    }
    for (int k0 = 0; k0 < K; k0 += 64) {
        __syncthreads();
#pragma unroll
        for (int i = 0; i < 4; ++i) {
            *(u32x4*)(sA + (lrow + 32 * i) * KSTR + kc) = ra[i];
            *(u32x4*)(sB + (lrow + 32 * i) * KSTR + kc) = rb[i];
        }
        if (k0 + 64 < K) {
            const long oa = koa(k0 + 64 + kc);
#pragma unroll
            for (int i = 0; i < 4; ++i) {
                ra[i] = *(const u32x4*)(ap[i] + oa);
                rb[i] = *(const u32x4*)(bp[i] + (k0 + 64 + kc));
            }
        }
        __syncthreads();
#pragma unroll
        for (int ks = 0; ks < 2; ++ks) {
            bf16x8 af[4], bfr[4];
#pragma unroll
            for (int j = 0; j < 4; ++j)
                af[j] = *(const bf16x8*)(sA + (wm * 64 + j * 16 + (lane & 15)) * KSTR + ks * 32 + (lane >> 4) * 8);
#pragma unroll
            for (int i = 0; i < 4; ++i)
                bfr[i] = *(const bf16x8*)(sB + (wn * 64 + i * 16 + (lane & 15)) * KSTR + ks * 32 + (lane >> 4) * 8);
#pragma unroll
            for (int i = 0; i < 4; ++i)
#pragma unroll
                for (int j = 0; j < 4; ++j) acc[i][j] = MFMA(bfr[i], af[j], acc[i][j]);
        }
    }
}
__device__ __forceinline__ void acc_zero(f32x4 (&acc)[4][4]) {
#pragma unroll
    for (int i = 0; i < 4; ++i)
#pragma unroll
        for (int j = 0; j < 4; ++j) acc[i][j] = f32x4{0.f, 0.f, 0.f, 0.f};
}
#define EPI_COORDS                                         \
    const int lane_ = tid__ & 63, wave_ = tid__ >> 6; \
    const int wn_ = wave_ & 1, wm_ = wave_ >> 1;
#define EPI_M(j) (wm_ * 64 + (j) * 16 + (lane_ & 15))
#define EPI_N(i) (wn_ * 64 + (i) * 16 + (lane_ >> 4) * 4)

__device__ __forceinline__ void xjob(const Params& p, int j, const float*& src, u16*& dst, int& nb, int& K, int& N) {
    switch (j) {
        case 0: src = p.w_in; dst = p.wt_in; nb = 4; K = 1024; N = NIN; break;
        case 1: src = p.w_br_sb; dst = p.wt_brs; nb = 4; K = 512; N = 1024; break;
        case 2: src = p.w_br_nsa; dst = p.wt_brn; nb = 4; K = 512; N = 1024; break;
        case 3: src = p.w_o; dst = p.wt_o; nb = 4; K = 1024; N = 1024; break;
        case 4: src = p.w_ple_gate; dst = p.wt_pg; nb = 4; K = 1024; N = 1024; break;
        case 5: src = p.w_ple_proj; dst = p.wt_pp; nb = 4; K = 256; N = 1024; break;
        case 6: src = p.w_gu; dst = p.wt_gu; nb = 128; K = 1024; N = 2048; break;
        case 7: src = p.w_down; dst = p.wt_dn; nb = 128; K = 1024; N = 1024; break;
        case 8: src = p.w_cmp1; dst = p.wt_c1; nb = 8; K = 2048; N = 128; break;
        default: src = p.w_cmp2; dst = p.wt_c2; nb = 8; K = 128; N = 64; break;
    }
}
__device__ __forceinline__ int xjob_tiles(int nb, int K, int N) { return nb * (K / 128) * ((N + 127) / 128); }

__device__ __forceinline__ void phase_prologue(const Params& p, unsigned* ctr) {
    const int tid = tid__;
    int ntr = 0;
    for (int j = 0; j < 10; ++j) {
        const float* s; u16* d; int nb, K, N;
        xjob(p, j, s, d, nb, K, N);
        ntr += xjob_tiles(nb, K, N);
    }
    const int n_x = TT * DD / 8192, n_p = 4 * TT * 256 / 8192, n_r = 16, n_b = 16;
    const int total = ntr + n_x + n_p + n_r + n_b;
    float* st = (float*)g_smem;
    WorkQ q; q.init(ctr, tid__ == 0);
    for (;;) {
        int it = q.next();
        if (it >= total) break;
        it = (it < n_b + n_r) ? (ntr + n_x + n_p + (it < n_b ? n_r + it : it - n_b)) : it - (n_b + n_r);
        if (it < ntr) {
            const float* src = nullptr; u16* dst = nullptr; int nb = 0, K = 0, N = 0;
            int rem = it;
            for (int j = 0; j < 10; ++j) {
                xjob(p, j, src, dst, nb, K, N);
                int nt = xjob_tiles(nb, K, N);
                if (rem < nt) break;
                rem -= nt;
            }
            const int ktn = K / 128, ntn = (N + 127) / 128;
            const int tpm = ktn * ntn;
            const int b = rem / tpm; rem -= b * tpm;
            const int kt = rem % ktn, nt = rem / ktn;
            src += (long)b * K * N; dst += (long)b * K * N;
            const int k0 = kt * 128, n0 = nt * 128;
            u16* st16 = (u16*)g_smem;
            float4 v[16];
#pragma unroll
            for (int i = 0; i < 16; ++i) {
                const int k = (tid >> 5) + 8 * i, n = (tid & 31) * 4;
                v[i] = make_float4(0.f, 0.f, 0.f, 0.f);
                if (n0 + n < N) v[i] = *(const float4*)(src + (long)(k0 + k) * N + n0 + n);
            }
#pragma unroll
            for (int i = 0; i < 16; ++i) {
                const int k = (tid >> 5) + 8 * i, n = (tid & 31) * 4;
                st_bf4(st16 + k * 136 + n, v[i].x, v[i].y, v[i].z, v[i].w);
            }
            __syncthreads();
#pragma unroll
            for (int i = 0; i < 8; ++i) {
                const int n = (tid >> 4) + 16 * i, k8 = (tid & 15) * 8;
                if (n0 + n < N) {
                    uint4 u;
                    u.x = (unsigned)st16[(k8 + 0) * 136 + n] | ((unsigned)st16[(k8 + 1) * 136 + n] << 16);
                    u.y = (unsigned)st16[(k8 + 2) * 136 + n] | ((unsigned)st16[(k8 + 3) * 136 + n] << 16);
                    u.z = (unsigned)st16[(k8 + 4) * 136 + n] | ((unsigned)st16[(k8 + 5) * 136 + n] << 16);
                    u.w = (unsigned)st16[(k8 + 6) * 136 + n] | ((unsigned)st16[(k8 + 7) * 136 + n] << 16);
                    *(uint4*)(dst + (long)(n0 + n) * K + k0 + k8) = u;
                }
            }
        } else if (it < ntr + n_x + n_p) {
            int e = it - ntr;
            const float* src; u16* db; float* df = nullptr;
            if (e < n_x) { src = p.x + (long)e * 8192; db = p.hb + (long)e * 8192; df = p.hf + (long)e * 8192; }
            else { e -= n_x; src = p.p + (long)e * 8192; db = p.pb + (long)e * 8192; }
#pragma unroll
            for (int i = 0; i < 8; ++i) {
                int o = i * 1024 + tid * 4;
                float4 v = *(const float4*)(src + o);
                if (df) *(float4*)(df + o) = v;
                st_bf4(db + o, v.x, v.y, v.z, v.w);
            }
        } else if (it < ntr + n_x + n_p + n_r) {
            int e0 = (it - ntr - n_x - n_p) * 8192;
            for (int i = 0; i < 32; ++i) {
                int idx = e0 + i * 256 + tid;
                int k = idx & 1023, le = idx >> 10, e = le & 31, l = le >> 5;
                float w = p.w_router[((long)l * 1024 + k) * 32 + e];
                u16 hi = f2bf(w); u16 lo = f2bf(w - bf2f(hi));
                u16* d = p.wt_r + (long)le * 3072;
                d[k] = hi; d[1024 + k] = lo; d[2048 + k] = hi;
            }
        } else {
            const int bi = it - ntr - n_x - n_p - n_r;
            const int lk = bi >> 1, h = (bi & 1) * 64 + (tid & 63), jp = tid >> 6;
            const float* pe = p.pe_cmp + (long)lk * 2048 + jp * 512;
            const float* w1 = p.w_cmp1 + ((long)lk * 2048 + jp * 512) * 128 + h;
            float sacc = 0.f;
#pragma unroll 8
            for (int j = 0; j < 512; ++j) sacc += pe[j] * w1[(long)j * 128];
            st[tid] = sacc;
            __syncthreads();
            if (tid < 64) p.cbias[lk * 128 + h] = (st[tid] + st[tid + 64]) + (st[tid + 128] + st[tid + 192]);
        }
    }
}

__device__ __forceinline__ void phase_gemm_in(const Params& p, int l, unsigned* ctr) {
    const int NTN = (NIN + 127) / 128;
    const int tid = tid__;
    const u16* W = p.wt_in + (long)l * NIN * 1024;
    XQ q; q.init(ctr, 32 * NTN, tid__ == 0);
    for (;;) {
        int it = q.next();
        if (it < 0) break;
        int mt, nt; xq_decode(it, 32, NTN, mt, nt);
        const int m0 = mt * 128, n0 = nt * 128;
        const u16* ap[4]; const u16* bp[4];
#pragma unroll
        for (int i = 0; i < 4; ++i) {
            int r = (tid >> 3) + 32 * i;
            ap[i] = p.hb + (long)(m0 + r) * 1024;
            int n = n0 + r; if (n > NIN - 1) n = NIN - 1;
            bp[i] = W + (long)n * 1024;
        }
        f32x4 acc[4][4]; acc_zero(acc);
        gemm_main(acc, ap, bp, 1024, KId());
        EPI_COORDS
#pragma unroll
        for (int i = 0; i < 4; ++i)
#pragma unroll
            for (int j = 0; j < 4; ++j) {
                int m = m0 + EPI_M(j), n = n0 + EPI_N(i);
                if (n < NIN) st_bf4(p.yb + (long)m * NIN + n, acc[i][j][0], acc[i][j][1], acc[i][j][2], acc[i][j][3]);
            }
    }
}

struct KCmp {
    __device__ __forceinline__ long operator()(int k) const { return (long)(k >> 6) * NIN + (k & 63); }
};
__device__ __forceinline__ void tile_cmp1(const Params& p, int l, int it) {
    const int tid = tid__;
    const int kv = it >> 4, mt = it & 15;
    const u16* W = p.wt_c1 + (long)(l * 2 + kv) * 128 * 2048;
    const u16* ap[4]; const u16* bp[4];
#pragma unroll
    for (int i = 0; i < 4; ++i) {
        int r = (tid >> 3) + 32 * i;
        int mrow = mt * 128 + r;
        int c = mrow & 127, bg = mrow >> 7, g = bg & 1, b = bg >> 1;
        ap[i] = p.yb + (long)(b * SS + c * 32) * NIN + (kv ? C_VC : C_KC) + g * 64;
        bp[i] = W + (long)r * 2048;
    }
    f32x4 acc[4][4]; acc_zero(acc);
    gemm_main(acc, ap, bp, 2048, KCmp());
    EPI_COORDS
    const float* cb = p.cbias + (l * 2 + kv) * 128;
#pragma unroll
    for (int i = 0; i < 4; ++i)
#pragma unroll
        for (int j = 0; j < 4; ++j) {
            int m = mt * 128 + EPI_M(j), n = EPI_N(i);
            float v[4];
#pragma unroll
            for (int r = 0; r < 4; ++r) { float a = acc[i][j][r] + cb[n + r]; v[r] = a * sigmoidf_(a); }
            st_bf4(p.hid + ((long)kv * 2048 + m) * 128 + n, v[0], v[1], v[2], v[3]);
        }
}
__device__ __forceinline__ void phase_cmp2(const Params& p, int l, unsigned* ctr) {
    const int tid = tid__;
    WorkQ q; q.init(ctr, tid__ == 0);
    for (;;) {
        int it = q.next();
        if (it >= 32) break;
        const int kv = it >> 4, mt = it & 15;
        const u16* W = p.wt_c2 + (long)(l * 2 + kv) * 64 * 128;
        const u16* ap[4]; const u16* bp[4];
#pragma unroll
        for (int i = 0; i < 4; ++i) {
            int r = (tid >> 3) + 32 * i;
            ap[i] = p.hid + ((long)kv * 2048 + mt * 128 + r) * 128;
            bp[i] = W + (long)(r & 63) * 128;
        }
        f32x4 acc[4][4]; acc_zero(acc);
        gemm_main(acc, ap, bp, 128, KId());
        EPI_COORDS
#pragma unroll
        for (int i = 0; i < 4; ++i)
#pragma unroll
            for (int j = 0; j < 4; ++j) {
                int m = mt * 128 + EPI_M(j), n = EPI_N(i);
                if (n < 64) st_bf4(p.kvc + ((long)kv * 2048 + m) * 64 + n, acc[i][j][0], acc[i][j][1], acc[i][j][2], acc[i][j][3]);
            }
    }
}

struct AttnLds {
    u16* K;
    u16* Vt;
    float* S;
    u16* P;
};
__device__ __forceinline__ AttnLds attn_lds() {
    AttnLds a;
    a.K = (u16*)g_smem;
    a.Vt = (u16*)(g_smem + 18432);
    a.S = (float*)(g_smem + 18432 + 17408) + (tid__ >> 6) * 16 * SSTR;
    a.P = (u16*)(g_smem + 18432 + 17408 + 17408) + (tid__ >> 6) * 16 * KSTR;
    return a;
}
__device__ __forceinline__ void load_k_tile(u16* sK, int koff, const u16* base, long stride) {
    const int tid = tid__, key = tid >> 2, ch = (tid & 3) * 16;
    const u16* g = base + (long)key * stride + ch;
    uint4 a = *(const uint4*)g, b = *(const uint4*)(g + 8);
    *(uint4*)(sK + (koff + key) * KSTR + ch) = a;
    *(uint4*)(sK + (koff + key) * KSTR + ch + 8) = b;
}
__device__ __forceinline__ void load_v_tile(u16* sVt, int koff, const u16* base, long stride) {
    const int tid = tid__, key = tid & 63, d0 = (tid >> 6) * 16;
    const u16* g = base + (long)key * stride + d0;
    uint4 a = *(const uint4*)g, b = *(const uint4*)(g + 8);
    unsigned w[8] = {a.x, a.y, a.z, a.w, b.x, b.y, b.z, b.w};
#pragma unroll
    for (int i = 0; i < 8; ++i) {
        sVt[(d0 + 2 * i) * VSTR + koff + key] = (u16)(w[i] & 0xffffu);
        sVt[(d0 + 2 * i + 1) * VSTR + koff + key] = (u16)(w[i] >> 16);
    }
}
__device__ __forceinline__ void ldg_k(const u16* base, long stride, u32x4& a, u32x4& b) {
    const int tid = tid__, key = tid >> 2, ch = (tid & 3) * 16;
    const u16* g = base + (long)key * stride + ch;
    a = *(const u32x4*)g; b = *(const u32x4*)(g + 8);
}
__device__ __forceinline__ void sts_k(u16* sK, const u32x4& a, const u32x4& b) {
    const int tid = tid__, key = tid >> 2, ch = (tid & 3) * 16;
    *(u32x4*)(sK + key * KSTR + ch) = a;
    *(u32x4*)(sK + key * KSTR + ch + 8) = b;
}
__device__ __forceinline__ void ldg_v(const u16* base, long stride, u32x4& a, u32x4& b) {
    const int tid = tid__, key = tid & 63, d0 = (tid >> 6) * 16;
    const u16* g = base + (long)key * stride + d0;
    a = *(const u32x4*)g; b = *(const u32x4*)(g + 8);
}
__device__ __forceinline__ void sts_v(u16* sVt, const u32x4& a, const u32x4& b) {
    const int tid = tid__, key = tid & 63, d0 = (tid >> 6) * 16;
#pragma unroll
    for (int i = 0; i < 4; ++i) {
        sVt[(d0 + 2 * i) * VSTR + key] = (u16)(a[i] & 0xffffu);
        sVt[(d0 + 2 * i + 1) * VSTR + key] = (u16)(a[i] >> 16);
        sVt[(d0 + 8 + 2 * i) * VSTR + key] = (u16)(b[i] & 0xffffu);
        sVt[(d0 + 8 + 2 * i + 1) * VSTR + key] = (u16)(b[i] >> 16);
    }
}
__device__ __forceinline__ void wave_qk(const AttnLds& L, int koff, const bf16x8 (&qf)[2]) {
    const int lane = tid__ & 63, quad = lane >> 4, c = lane & 15;
#pragma unroll
    for (int nt = 0; nt < 4; ++nt) {
        f32x4 a = {0.f, 0.f, 0.f, 0.f};
#pragma unroll
        for (int ks = 0; ks < 2; ++ks) {
            bf16x8 kf = *(const bf16x8*)(L.K + (koff + nt * 16 + c) * KSTR + ks * 32 + quad * 8);
            a = MFMA(qf[ks], kf, a);
        }
#pragma unroll
        for (int r = 0; r < 4; ++r) L.S[(quad * 4 + r) * SSTR + nt * 16 + c] = a[r];
    }
}
__device__ __forceinline__ void wave_pv(const AttnLds& L, int koff, f32x4 (&o)[4]) {
    const int lane = tid__ & 63, quad = lane >> 4, c = lane & 15;
#pragma unroll
    for (int ks = 0; ks < 2; ++ks) {
        bf16x8 pf = *(const bf16x8*)(L.P + c * KSTR + ks * 32 + quad * 8);
#pragma unroll
        for (int dt = 0; dt < 4; ++dt) {
            bf16x8 vf = *(const bf16x8*)(L.Vt + (dt * 16 + c) * VSTR + koff + ks * 32 + quad * 8);
            o[dt] = MFMA(pf, vf, o[dt]);
        }
    }
}
__device__ __forceinline__ void read_s16(const AttnLds& L, int row, int part, float (&z)[16]) {
#pragma unroll
    for (int i = 0; i < 4; ++i) {
        float4 v = *(const float4*)(L.S + row * SSTR + part * 16 + i * 4);
        z[i * 4 + 0] = v.x; z[i * 4 + 1] = v.y; z[i * 4 + 2] = v.z; z[i * 4 + 3] = v.w;
    }
}
__device__ __forceinline__ void write_p16(const AttnLds& L, int row, int part, const float (&pv)[16]) {
    uint4 a, b;
    a.x = (unsigned)f2bf(pv[0]) | ((unsigned)f2bf(pv[1]) << 16);
    a.y = (unsigned)f2bf(pv[2]) | ((unsigned)f2bf(pv[3]) << 16);
    a.z = (unsigned)f2bf(pv[4]) | ((unsigned)f2bf(pv[5]) << 16);
    a.w = (unsigned)f2bf(pv[6]) | ((unsigned)f2bf(pv[7]) << 16);
    b.x = (unsigned)f2bf(pv[8]) | ((unsigned)f2bf(pv[9]) << 16);
    b.y = (unsigned)f2bf(pv[10]) | ((unsigned)f2bf(pv[11]) << 16);
    b.z = (unsigned)f2bf(pv[12]) | ((unsigned)f2bf(pv[13]) << 16);
    b.w = (unsigned)f2bf(pv[14]) | ((unsigned)f2bf(pv[15]) << 16);
    *(uint4*)(L.P + row * KSTR + part * 16) = a;
    *(uint4*)(L.P + row * KSTR + part * 16 + 8) = b;
}
__device__ __forceinline__ float row4_max(float v) {
    v = fmaxf(v, __shfl_xor(v, 1));
    v = fmaxf(v, __shfl_xor(v, 2));
    return v;
}
__device__ __forceinline__ float row4_sum(float v) {
    v += __shfl_xor(v, 1);
    v += __shfl_xor(v, 2);
    return v;
}

__device__ __forceinline__ void item_sb(const Params& p, int it) {
    const int tid = tid__, lane = tid & 63, wave = tid >> 6, quad = lane >> 4, c = lane & 15;
    const int qb = it & 63, h = (it >> 6) & 7, b = it >> 9;
    const int t0 = qb * 64;
    AttnLds L = attn_lds();
    bf16x8 qf[2];
    {
        const u16* g = p.yb + (long)(b * SS + t0 + wave * 16 + c) * NIN + C_SBQ + h * 64 + quad * 8;
        qf[0] = *(const bf16x8*)g;
        qf[1] = *(const bf16x8*)(g + 32);
    }
    const int row = lane >> 2, part = lane & 3;
    const int t = t0 + wave * 16 + row;
    float R = 0.f;
    f32x4 o[4];
#pragma unroll
    for (int dt = 0; dt < 4; ++dt) o[dt] = f32x4{0.f, 0.f, 0.f, 0.f};
    u32x4 pk0, pk1, pv0, pv1;
    {
        const u16* kbase = p.yb + (long)(b * SS + qb * 64) * NIN + h * 64;
        ldg_k(kbase + C_SBK, NIN, pk0, pk1);
        ldg_v(kbase + C_SBV, NIN, pv0, pv1);
    }
    for (int kb = qb; kb >= 0; --kb) {
        __syncthreads();
        sts_k(L.K, pk0, pk1);
        sts_v(L.Vt, pv0, pv1);
        __syncthreads();
        if (kb > 0) {
            const u16* kbase = p.yb + (long)(b * SS + (kb - 1) * 64) * NIN + h * 64;
            ldg_k(kbase + C_SBK, NIN, pk0, pk1);
            ldg_v(kbase + C_SBV, NIN, pv0, pv1);
        }
        wave_qk(L, 0, qf);
        __syncthreads();
        float z[16], lat[16];
        read_s16(L, row, part, z);
        float run = 0.f;
#pragma unroll
        for (int i = 15; i >= 0; --i) {
            const int key = kb * 64 + part * 16 + i;
            const bool valid = key < t;
            const float zz = z[i] * 0.125f;
            const float sp = fmaxf(zz, 0.f) + __logf(1.f + __expf(-fabsf(zz)));
            lat[i] = run;
            z[i] = valid ? (zz - sp) : -1e30f;
            run += valid ? -sp : 0.f;
        }
        const int lb = lane & ~3;
        const float t0_ = __shfl(run, lb), t1_ = __shfl(run, lb + 1), t2_ = __shfl(run, lb + 2), t3_ = __shfl(run, lb + 3);
        float off = R;
        if (part < 3) off += t3_;
        if (part < 2) off += t2_;
        if (part < 1) off += t1_;
        float pv[16];
#pragma unroll
        for (int i = 0; i < 16; ++i) pv[i] = (z[i] > -1e29f) ? __expf(z[i] + lat[i] + off) : 0.f;
        write_p16(L, row, part, pv);
        R += (t0_ + t1_) + (t2_ + t3_);
        const int done = __syncthreads_and(R < -110.f);
        wave_pv(L, 0, o);
        if (done) break;
    }
#pragma unroll
    for (int dt = 0; dt < 4; ++dt)
#pragma unroll
        for (int r = 0; r < 4; ++r)
            p.ysb[(long)(b * SS + t0 + wave * 16 + quad * 4 + r) * 512 + h * 64 + dt * 16 + c] = f2bf(o[dt][r]);
}

__device__ __forceinline__ void phase_cmp1_sb(const Params& p, int l, unsigned* ctr) {
    const int total = 32 + 8 * 8 * 64;
    WorkQ q; q.init(ctr, tid__ == 0);
    for (;;) {
        int it = q.next();
        if (it >= total) break;
        if (it < 32) tile_cmp1(p, l, it);
        else item_sb(p, it - 32);
    }
}

template <int MODE>
__device__ __forceinline__ void nsa_step(const AttnLds& L, const bf16x8 (&qf)[2], f32x4 (&o)[4], float& m, float& l,
                                         float slope, int t, int kpos0, bool rowsel) {
    const int lane = tid__ & 63, quad = lane >> 4;
    const int row = lane >> 2, part = lane & 3;
    wave_qk(L, 0, qf);
    __syncthreads();
    float z[16];
    read_s16(L, row, part, z);
    float pm = -1e30f;
#pragma unroll
    for (int i = 0; i < 16; ++i) {
        const int dist = t - (kpos0 + part * 16 + i);
        bool valid = dist >= 0;
        if (MODE == 1) valid = valid && rowsel;
        if (MODE == 2) valid = valid && (dist < 512);
        z[i] = valid ? (z[i] * 0.125f - slope * (float)dist) : -1e30f;
        pm = fmaxf(pm, z[i]);
    }
    pm = row4_max(pm);
    const float mn = fmaxf(m, pm);
    const float alpha = __expf(m - mn);
    float ps = 0.f;
#pragma unroll
    for (int i = 0; i < 16; ++i) {
        z[i] = (z[i] > -1e29f) ? __expf(z[i] - mn) : 0.f;
        ps += z[i];
    }
    ps = row4_sum(ps);
    l = l * alpha + ps;
    m = mn;
    write_p16(L, row, part, z);
    float al[4];
#pragma unroll
    for (int r = 0; r < 4; ++r) al[r] = __shfl(alpha, (quad * 4 + r) * 4);
    __syncthreads();
#pragma unroll
    for (int dt = 0; dt < 4; ++dt)
#pragma unroll
        for (int r = 0; r < 4; ++r) o[dt][r] *= al[r];
    wave_pv(L, 0, o);
    __syncthreads();
}

__device__ __forceinline__ void item_nsa(const Params& p, int it) {
    const int tid = tid__, lane = tid & 63, wave = tid >> 6, quad = lane >> 4, c = lane & 15;
    const int qb = 63 - (it >> 4), bg = it & 15, g = bg & 1, b = bg >> 1;
    const int t0 = qb * 64;
    AttnLds L = attn_lds();
    const int row = lane >> 2, part = lane & 3;
    const int t = t0 + wave * 16 + row;
    const long tokbase = (long)b * SS + t0 + wave * 16;
    float* ynf = p.ynf;
    const int nct = (2 * qb + 2 > 64) ? 2 : 1;
    const int nv = (t + 1) >> 5;
    __syncthreads();
    for (int ct = 0; ct < nct; ++ct) {
        load_k_tile(L.K, ct * 64, p.kvc + ((long)(b * 2 + g) * 128 + ct * 64) * 64, 64);
        load_v_tile(L.Vt, ct * 64, p.kvc + ((long)2048 + (b * 2 + g) * 128 + ct * 64) * 64, 64);
    }
    __syncthreads();
    float imp[2][8];
#pragma unroll
    for (int a = 0; a < 2; ++a)
#pragma unroll
        for (int j = 0; j < 8; ++j) imp[a][j] = 0.f;
#pragma unroll 1
    for (int r = 0; r < 4; ++r) {
        const float slope = exp2f(-(float)(g * 4 + r + 1));
        float m = -1e30f, l = 0.f;
        bf16x8 qfa[2];
        {
            const u16* gq = p.yb + (tokbase + c) * NIN + C_NQ + (g * 4 + r) * 64 + quad * 8;
            qfa[0] = *(const bf16x8*)gq;
            qfa[1] = *(const bf16x8*)(gq + 32);
        }
        for (int ct = 0; ct < nct; ++ct) {
            wave_qk(L, ct * 64, qfa);
            __syncthreads();
            float z[16];
            read_s16(L, row, part, z);
            float pm = -1e30f;
#pragma unroll
            for (int i = 0; i < 16; ++i) {
                const int cc = ct * 64 + part * 16 + i;
                const bool valid = cc < nv;
                z[i] = valid ? (z[i] * 0.125f - slope * (float)(t - (cc * 32 + 31))) : -1e30f;
                pm = fmaxf(pm, z[i]);
            }
            pm = row4_max(pm);
            const float mn = fmaxf(m, pm);
            float ps = 0.f;
#pragma unroll
            for (int i = 0; i < 16; ++i) ps += (z[i] > -1e29f) ? __expf(z[i] - mn) : 0.f;
            ps = row4_sum(ps);
            l = l * __expf(m - mn) + ps;
            m = mn;
            __syncthreads();
        }
        const float inv = (l > 0.f) ? 1.f / l : 0.f;
        f32x4 o[4];
#pragma unroll
        for (int dt = 0; dt < 4; ++dt) o[dt] = f32x4{0.f, 0.f, 0.f, 0.f};
#pragma unroll 1
        for (int ct = 0; ct < nct; ++ct) {
            wave_qk(L, ct * 64, qfa);
            __syncthreads();
            float z[16];
            read_s16(L, row, part, z);
#pragma unroll
            for (int i = 0; i < 16; ++i) {
                const int cc = ct * 64 + part * 16 + i;
                const bool valid = cc < nv;
                const float s = z[i] * 0.125f - slope * (float)(t - (cc * 32 + 31));
                z[i] = valid ? __expf(s - m) * inv : 0.f;
            }
            const float f0 = (ct == 0) ? 1.f : 0.f, f1 = 1.f - f0;
#pragma unroll
            for (int j = 0; j < 8; ++j) {
                const float pr = z[2 * j] + z[2 * j + 1];
                imp[0][j] += f0 * pr;
                imp[1][j] += f1 * pr;
            }
            write_p16(L, row, part, z);
            __syncthreads();
            wave_pv(L, ct * 64, o);
            __syncthreads();
        }
#pragma unroll
        for (int rr = 0; rr < 4; ++rr) {
            const long tok = tokbase + quad * 4 + rr;
            const float gt = sigmoidf_(bf2f(p.yb[tok * NIN + C_NG + (g * 4 + r) * 3 + 0]));
#pragma unroll
            for (int dt = 0; dt < 4; ++dt) ynf[tok * 512 + (g * 4 + r) * 64 + dt * 16 + c] = gt * o[dt][rr];
        }
    }
#pragma unroll
    for (int a = 0; a < 2; ++a)
#pragma unroll
        for (int j = 0; j < 8; ++j) L.S[row * SSTR + a * 32 + part * 8 + j] = imp[a][j];
    __syncthreads();
    unsigned long long un = 0ull;
#ifndef NSA_NOTOPK
#define NSA_NOTOPK 0
#endif
#pragma unroll 1
    for (int rr = 0; rr < (NSA_NOTOPK ? 0 : 16); ++rr) {
        float v = L.S[rr * SSTR + lane];
        const bool forced = (lane == 0) || (lane == qb) || (lane == qb - 1);
        const bool validb = lane <= qb;
        v = forced ? 1e6f : (validb ? v : -1e30f);
        int rank = 0;
#pragma unroll 8
        for (int i = 0; i < 64; ++i) {
            const float vi = __shfl(v, i);
            rank += ((vi > v) || (vi == v && i < lane)) ? 1 : 0;
        }
        const unsigned long long mk = __ballot((rank < 16) && validb);
        if (lane == 0) s_mask[wave][rr] = mk;
        un |= mk;
    }
    if (lane == 0) s_union[wave] = un;
    __syncthreads();
    const unsigned long long rowmask = s_mask[wave][row];
    unsigned long long umask;
    {
        const unsigned long long um_ = s_union[0] | s_union[1] | s_union[2] | s_union[3];
        const unsigned lo_ = __builtin_amdgcn_readfirstlane((unsigned)um_), hi_ = __builtin_amdgcn_readfirstlane((unsigned)(um_ >> 32));
        umask = ((unsigned long long)hi_ << 32) | lo_;
    }
#ifndef NSA_HPB
#define NSA_HPB 1
#endif
#ifndef NSA_NOBC
#define NSA_NOBC 0
#endif
#pragma unroll 1
    for (int hp = 0; hp < (NSA_NOBC ? 0 : 4 / NSA_HPB); ++hp) {
#pragma unroll 1
        for (int mode = 1; mode <= 2; ++mode) {
            f32x4 o[NSA_HPB][4];
            float m[NSA_HPB], l[NSA_HPB];
#pragma unroll
            for (int r = 0; r < NSA_HPB; ++r) {
                m[r] = -1e30f; l[r] = 0.f;
#pragma unroll
                for (int dt = 0; dt < 4; ++dt) o[r][dt] = f32x4{0.f, 0.f, 0.f, 0.f};
            }
            const int kb_lo = (mode == 1) ? 0 : ((qb - 8 > 0) ? qb - 8 : 0);
            const int colk = (mode == 1) ? C_KS : C_KW, colv = (mode == 1) ? C_VS : C_VW;
            for (int kb = kb_lo; kb <= qb; ++kb) {
                if (mode == 1 && !((umask >> kb) & 1ull)) continue;
                const u16* kbase = p.yb + (long)(b * SS + kb * 64) * NIN + g * 64;
                bf16x8 qf[NSA_HPB][2];
#pragma unroll
                for (int r = 0; r < NSA_HPB; ++r) {
                    const u16* gq = p.yb + (tokbase + c) * NIN + C_NQ + (g * 4 + hp * NSA_HPB + r) * 64 + quad * 8;
                    qf[r][0] = *(const bf16x8*)gq;
                    qf[r][1] = *(const bf16x8*)(gq + 32);
                }
                load_k_tile(L.K, 0, kbase + colk, NIN);
                load_v_tile(L.Vt, 0, kbase + colv, NIN);
                __syncthreads();
                const bool rowsel = (rowmask >> kb) & 1ull;
#pragma unroll
                for (int r = 0; r < NSA_HPB; ++r) {
                    const float slope = exp2f(-(float)(g * 4 + hp * NSA_HPB + r + 1));
                    if (mode == 1) nsa_step<1>(L, qf[r], o[r], m[r], l[r], slope, t, kb * 64, rowsel);
                    else nsa_step<2>(L, qf[r], o[r], m[r], l[r], slope, t, kb * 64, rowsel);
                }
            }
#pragma unroll
            for (int r = 0; r < NSA_HPB; ++r) {
                const int hh = g * 4 + hp * NSA_HPB + r;
#pragma unroll
                for (int rr = 0; rr < 4; ++rr) {
                    const long tok = tokbase + quad * 4 + rr;
                    const float lr = __shfl(l[r], (quad * 4 + rr) * 4);
                    const float gt = sigmoidf_(bf2f(p.yb[tok * NIN + C_NG + hh * 3 + mode])) / lr;
#pragma unroll
                    for (int dt = 0; dt < 4; ++dt) {
                        const long oi = tok * 512 + hh * 64 + dt * 16 + c;
                        const float v = ynf[oi] + gt * o[r][dt][rr];
                        if (mode == 1) ynf[oi] = v;
                        else p.ynsa[oi] = f2bf(v);
                    }
                }
            }
        }
    }
}
__device__ __forceinline__ void phase_nsa(const Params& p, unsigned* ctr) {
    WorkQ q; q.init(ctr, tid__ == 0);
    for (;;) {
        int it = q.next();
        if (it >= 1024) break;
        item_nsa(p, it);
    }
}

__device__ __forceinline__ void phase_br(const Params& p, int l, unsigned* ctr) {
    const int tid = tid__;
    XQ q; q.init(ctr, 32 * 8, tid__ == 0);
    for (;;) {
        int it = q.next();
        if (it < 0) break;
        int mt, nt; xq_decode(it, 32, 8, mt, nt);
        const int m0 = mt * 128, n0 = nt * 128;
        const u16* ap[4]; const u16* bp[4];
        f32x4 acc[4][4];
        acc_zero(acc);
#pragma unroll
        for (int i = 0; i < 4; ++i) {
            int r = (tid >> 3) + 32 * i;
            ap[i] = p.ysb + (long)(m0 + r) * 512;
            bp[i] = p.wt_brs + ((long)l * 1024 + n0 + r) * 512;
        }
        gemm_main(acc, ap, bp, 512, KId());
        EPI_COORDS
#pragma unroll
        for (int i = 0; i < 4; ++i)
#pragma unroll
            for (int j = 0; j < 4; ++j) {
                const int m = m0 + EPI_M(j), n = n0 + EPI_N(i);
                const uint2 ga = *(const uint2*)(p.yb + (long)m * NIN + C_GSB + n);
                float4 o;
                o.x = sigmoidf_(bf2f((u16)(ga.x & 0xffff))) * acc[i][j][0];
                o.y = sigmoidf_(bf2f((u16)(ga.x >> 16))) * acc[i][j][1];
                o.z = sigmoidf_(bf2f((u16)(ga.y & 0xffff))) * acc[i][j][2];
                o.w = sigmoidf_(bf2f((u16)(ga.y >> 16))) * acc[i][j][3];
                *(float4*)(p.pre1 + (long)m * 1024 + n) = o;
            }
        acc_zero(acc);
#pragma unroll
        for (int i = 0; i < 4; ++i) {
            int r = (tid >> 3) + 32 * i;
            ap[i] = p.ynsa + (long)(m0 + r) * 512;
            bp[i] = p.wt_brn + ((long)l * 1024 + n0 + r) * 512;
        }
        gemm_main(acc, ap, bp, 512, KId());
#pragma unroll
        for (int i = 0; i < 4; ++i)
#pragma unroll
            for (int j = 0; j < 4; ++j) {
                const int m = m0 + EPI_M(j), n = n0 + EPI_N(i);
                const uint2 gb = *(const uint2*)(p.yb + (long)m * NIN + C_GNSA + n);
                const float4 st = *(const float4*)(p.pre1 + (long)m * 1024 + n);
                st_bf4(p.merged + (long)m * 1024 + n,
                       st.x + sigmoidf_(bf2f((u16)(gb.x & 0xffff))) * acc[i][j][0],
                       st.y + sigmoidf_(bf2f((u16)(gb.x >> 16))) * acc[i][j][1],
                       st.z + sigmoidf_(bf2f((u16)(gb.y & 0xffff))) * acc[i][j][2],
                       st.w + sigmoidf_(bf2f((u16)(gb.y >> 16))) * acc[i][j][3]);
            }
    }
}
__device__ __forceinline__ void phase_wo(const Params& p, int l, unsigned* ctr) {
    const int tid = tid__;
    XQ q; q.init(ctr, 32 * 8, tid__ == 0);
    for (;;) {
        int it = q.next();
        if (it < 0) break;
        int mt, nt; xq_decode(it, 32, 8, mt, nt);
        const int m0 = mt * 128, n0 = nt * 128;
        const u16* ap[4]; const u16* bp[4];
        f32x4 acc[4][4]; acc_zero(acc);
#pragma unroll
        for (int i = 0; i < 4; ++i) {
            int r = (tid >> 3) + 32 * i;
            ap[i] = p.merged + (long)(m0 + r) * 1024;
            bp[i] = p.wt_o + ((long)l * 1024 + n0 + r) * 1024;
        }
        gemm_main(acc, ap, bp, 1024, KId());
        EPI_COORDS
#pragma unroll
        for (int i = 0; i < 4; ++i)
#pragma unroll
            for (int j = 0; j < 4; ++j) {
                const int m = m0 + EPI_M(j), n = n0 + EPI_N(i);
                const float4 hv = *(const float4*)(p.hf + (long)m * 1024 + n);
                float4 o;
                o.x = DN_ALPHA * hv.x + acc[i][j][0]; o.y = DN_ALPHA * hv.y + acc[i][j][1];
                o.z = DN_ALPHA * hv.z + acc[i][j][2]; o.w = DN_ALPHA * hv.w + acc[i][j][3];
                *(float4*)(p.pre1 + (long)m * 1024 + n) = o;
            }
    }
}
__device__ __forceinline__ float wave_sum(float v) {
#pragma unroll
    for (int s = 32; s >= 1; s >>= 1) v += __shfl_xor(v, s);
    return v;
}
__device__ __forceinline__ void phase_ln(const Params& p, int l, int mode, unsigned* ctr) {
    const int lane = tid__ & 63, wave = tid__ >> 6;
    const float* gam = (mode == 1 ? p.ln1_g : p.ln2_g) + l * 1024;
    const float* bet = (mode == 1 ? p.ln1_b : p.ln2_b) + l * 1024;
    WorkQ q; q.init(ctr, tid__ == 0);
    for (;;) {
        int it = q.next();
        if (it >= TT / 64) break;
        for (int rr = 0; rr < 16; rr += 2) {
            float v[2][16];
#pragma unroll
            for (int u = 0; u < 2; ++u) {
                const long row = (long)it * 64 + wave * 16 + rr + u;
#pragma unroll
                for (int i = 0; i < 4; ++i) {
                    const int col = i * 256 + lane * 4;
                    float4 a;
                    if (mode == 1) a = *(const float4*)(p.pre1 + row * 1024 + col);
                    else {
                        a = *(const float4*)(p.h1f + row * 1024 + col);
                        a.x *= DN_ALPHA; a.y *= DN_ALPHA; a.z *= DN_ALPHA; a.w *= DN_ALPHA;
                        const uint2 pl = *(const uint2*)(p.ple + row * 1024 + col);
                        a.x += bf2f((u16)(pl.x & 0xffff)); a.y += bf2f((u16)(pl.x >> 16));
                        a.z += bf2f((u16)(pl.y & 0xffff)); a.w += bf2f((u16)(pl.y >> 16));
#pragma unroll
                        for (int s4 = 0; s4 < 4; ++s4) {
                            const uint2 y = *(const uint2*)(p.y4 + (row * 4 + s4) * 1024 + col);
                            a.x += bf2f((u16)(y.x & 0xffff)); a.y += bf2f((u16)(y.x >> 16));
                            a.z += bf2f((u16)(y.y & 0xffff)); a.w += bf2f((u16)(y.y >> 16));
                        }
                    }
                    v[u][i * 4 + 0] = a.x; v[u][i * 4 + 1] = a.y; v[u][i * 4 + 2] = a.z; v[u][i * 4 + 3] = a.w;
                }
            }
#pragma unroll
            for (int u = 0; u < 2; ++u) {
                const long row = (long)it * 64 + wave * 16 + rr + u;
                float sm = 0.f;
#pragma unroll
                for (int i = 0; i < 16; ++i) sm += v[u][i];
                const float mean = wave_sum(sm) * (1.f / 1024.f);
                float s2 = 0.f;
#pragma unroll
                for (int i = 0; i < 16; ++i) { v[u][i] -= mean; s2 += v[u][i] * v[u][i]; }
                const float rstd = rsqrtf(wave_sum(s2) * (1.f / 1024.f) + 1e-5f);
#pragma unroll
                for (int i = 0; i < 4; ++i) {
                    const int col = i * 256 + lane * 4;
                    const float4 gg = *(const float4*)(gam + col), bb = *(const float4*)(bet + col);
                    float4 y;
                    y.x = v[u][i * 4 + 0] * rstd * gg.x + bb.x; y.y = v[u][i * 4 + 1] * rstd * gg.y + bb.y;
                    y.z = v[u][i * 4 + 2] * rstd * gg.z + bb.z; y.w = v[u][i * 4 + 3] * rstd * gg.w + bb.w;
                    if (mode == 1) {
                        *(float4*)(p.h1f + row * 1024 + col) = y;
                        const u16 h0 = f2bf(y.x), h1 = f2bf(y.y), h2 = f2bf(y.z), h3 = f2bf(y.w);
                        uint2 uu; uu.x = (unsigned)h0 | ((unsigned)h1 << 16); uu.y = (unsigned)h2 | ((unsigned)h3 << 16);
                        *(uint2*)(p.h1b + row * 1024 + col) = uu;
                        st_bf4(p.h1lo + row * 1024 + col, y.x - bf2f(h0), y.y - bf2f(h1), y.z - bf2f(h2), y.w - bf2f(h3));
                    } else {
                        if (l == 3) *(float4*)(p.out + row * 1024 + col) = y;
                        else {
                            *(float4*)(p.hf + row * 1024 + col) = y;
                            st_bf4(p.hb + row * 1024 + col, y.x, y.y, y.z, y.w);
                        }
                    }
                }
            }
        }
    }
}
struct KRouter {
    long dlo;
    __device__ __forceinline__ long operator()(int k) const { return (k < 2048) ? (long)(k & 1023) : (dlo + (k - 2048)); }
};
__device__ __forceinline__ void phase_router_ple(const Params& p, int l, unsigned* ctr) {
    const int tid = tid__;
    XQ q; q.init(ctr, 32 * 9, tid__ == 0);
    for (;;) {
        int it = q.next();
        if (it < 0) break;
        int mt, nt; xq_decode(it, 32, 9, mt, nt);
        const u16* ap[4]; const u16* bp[4];
        if (nt == 8) {
            const int m0 = mt * 128;
            f32x4 acc[4][4]; acc_zero(acc);
#pragma unroll
            for (int i = 0; i < 4; ++i) {
                int r = (tid >> 3) + 32 * i;
                ap[i] = p.h1b + (long)(m0 + r) * 1024;
                bp[i] = p.wt_r + ((long)l * 32 + (r & 31)) * 3072;
            }
            KRouter kr; kr.dlo = (long)(p.h1lo - p.h1b);
            gemm_main(acc, ap, bp, 3072, kr);
            EPI_COORDS
#pragma unroll
            for (int i = 0; i < 4; ++i)
#pragma unroll
                for (int j = 0; j < 4; ++j) {
                    const int m = m0 + EPI_M(j), n = EPI_N(i);
                    if (n < 32) {
                        const float4 bb = *(const float4*)(p.b_router + l * 32 + n);
                        float4 o; o.x = acc[i][j][0] + bb.x; o.y = acc[i][j][1] + bb.y; o.z = acc[i][j][2] + bb.z; o.w = acc[i][j][3] + bb.w;
                        *(float4*)(p.logits + (long)m * 32 + n) = o;
                    }
                }
        } else {
            const int m0 = mt * 128, n0 = nt * 128;
            f32x4 acc[4][4];
            acc_zero(acc);
#pragma unroll
            for (int i = 0; i < 4; ++i) {
                int r = (tid >> 3) + 32 * i;
                ap[i] = p.pb + ((long)l * TT + m0 + r) * 256;
                bp[i] = p.wt_pp + ((long)l * 1024 + n0 + r) * 256;
            }
            gemm_main(acc, ap, bp, 256, KId());
            EPI_COORDS
#pragma unroll
            for (int i = 0; i < 4; ++i)
#pragma unroll
                for (int j = 0; j < 4; ++j) {
                    const int m = m0 + EPI_M(j), n = n0 + EPI_N(i);
                    float4 o; o.x = acc[i][j][0]; o.y = acc[i][j][1]; o.z = acc[i][j][2]; o.w = acc[i][j][3];
                    *(float4*)(p.pre1 + (long)m * 1024 + n) = o;
                }
            acc_zero(acc);
#pragma unroll
            for (int i = 0; i < 4; ++i) {
                int r = (tid >> 3) + 32 * i;
                ap[i] = p.h1b + (long)(m0 + r) * 1024;
                bp[i] = p.wt_pg + ((long)l * 1024 + n0 + r) * 1024;
            }
            gemm_main(acc, ap, bp, 1024, KId());
#pragma unroll
            for (int i = 0; i < 4; ++i)
#pragma unroll
                for (int j = 0; j < 4; ++j) {
                    const int m = m0 + EPI_M(j), n = n0 + EPI_N(i);
                    const float4 st = *(const float4*)(p.pre1 + (long)m * 1024 + n);
                    st_bf4(p.ple + (long)m * 1024 + n, sigmoidf_(acc[i][j][0]) * st.x, sigmoidf_(acc[i][j][1]) * st.y,
                           sigmoidf_(acc[i][j][2]) * st.z, sigmoidf_(acc[i][j][3]) * st.w);
                }
        }
    }
}
__device__ __forceinline__ void phase_route(const Params& p, int l, unsigned* ctr) {
    const int tid = tid__;
    int* s_cnt = s_misc;
    int* s_base = s_misc + 32;
    WorkQ q; q.init(ctr, tid__ == 0);
    for (;;) {
        int it = q.next();
        if (it >= TT / 256) break;
        if (tid < 32) s_cnt[tid] = 0;
        __syncthreads();
        const int t = it * 256 + tid;
        float lg[32];
#pragma unroll
        for (int i = 0; i < 8; ++i) {
            const float4 v = *(const float4*)(p.logits + (long)t * 32 + i * 4);
            lg[i * 4 + 0] = v.x; lg[i * 4 + 1] = v.y; lg[i * 4 + 2] = v.z; lg[i * 4 + 3] = v.w;
        }
        unsigned taken = 0u;
        int ek[4]; float vk[4];
#pragma unroll
        for (int k = 0; k < 4; ++k) {
            float best = -3.0e38f; int bi = 0;
#pragma unroll
            for (int e = 0; e < 32; ++e) {
                const bool ok = !((taken >> e) & 1u) && (lg[e] > best);
                best = ok ? lg[e] : best;
                bi = ok ? e : bi;
            }
            taken |= 1u << bi;
            ek[k] = bi; vk[k] = best;
        }
        float wsum = 0.f;
        float v0 = -3.0e38f, v1 = 0.f, v2 = 0.f, v3 = 0.f;
#pragma unroll
        for (int e = 0; e < 32; ++e) {
            v0 = (e == ek[0]) ? lg[e] : v0;
            v1 = (e == ek[1]) ? lg[e] : v1;
            v2 = (e == ek[2]) ? lg[e] : v2;
            v3 = (e == ek[3]) ? lg[e] : v3;
        }
        vk[0] = 1.f; vk[1] = __expf(v1 - v0); vk[2] = __expf(v2 - v0); vk[3] = __expf(v3 - v0);
        wsum = vk[0] + vk[1] + vk[2] + vk[3];
        const float winv = 1.f / wsum;
        int lp[4];
#pragma unroll
        for (int k = 0; k < 4; ++k) lp[k] = atomicAdd(&s_cnt[ek[k]], 1);
        __syncthreads();
        if (tid < 32) s_base[tid] = (int)atomicAdd(&p.ecnt[l * 32 + tid], (unsigned)s_cnt[tid]);
        __syncthreads();
#pragma unroll
        for (int k = 0; k < 4; ++k) {
            const long idx = (long)ek[k] * TT + s_base[ek[k]] + lp[k];
            p.ent_id[idx] = t * 4 + k;
            p.ent_w[idx] = vk[k] * winv;
        }
    }
}
__device__ __forceinline__ void moe_prefix(const Params& p, int l) {
    __syncthreads();
    if (tid__ == 0) {
        int acc = 0;
        for (int e = 0; e < 32; ++e) {
            const int n = (int)__hip_atomic_load(&p.ecnt[l * 32 + e], __ATOMIC_RELAXED, __HIP_MEMORY_SCOPE_AGENT);
            s_misc[e] = acc;
            s_misc[40 + e] = n;
            acc += (n + 127) >> 7;
        }
        s_misc[32] = acc;
    }
    __syncthreads();
}
__device__ __forceinline__ void phase_moe_gu(const Params& p, int l, unsigned* ctr) {
    const int tid = tid__;
    moe_prefix(p, l);
    const int mtotal = s_misc[32];
    const int mpx = (((mtotal + 7) >> 3) + 7) & ~7;
    XQ q; q.init(ctr, mpx * 16, tid__ == 0);
    for (;;) {
        int it = q.next();
        if (it < 0) break;
        int mtg, nt; xq_decode(it, mpx, 16, mtg, nt);
        if (mtg >= mtotal) continue;
        int e = 0;
        for (int i = 1; i < 32; ++i) e = (s_misc[i] <= mtg) ? i : e;
        const int mt = mtg - s_misc[e], ne = s_misc[40 + e];
        const u16* ap[4]; const u16* bp[4];
#pragma unroll
        for (int i = 0; i < 4; ++i) {
            const int r = (tid >> 3) + 32 * i;
            int idx = mt * 128 + r; if (idx > ne - 1) idx = ne - 1;
            const int tok = p.ent_id[(long)e * TT + idx] >> 2;
            ap[i] = p.h1b + (long)tok * 1024;
            const int isup = (r >> 5) & 1, col = (r >> 6) * 32 + (r & 31);
            bp[i] = p.wt_gu + (((long)l * 32 + e) * 2048 + isup * 1024 + nt * 64 + col) * 1024;
        }
        f32x4 acc[4][4]; acc_zero(acc);
        gemm_main(acc, ap, bp, 1024, KId());
        EPI_COORDS
        const float* bg = p.b_gu + ((long)l * 32 + e) * 2048;
#pragma unroll
        for (int i = 0; i < 2; ++i)
#pragma unroll
            for (int j = 0; j < 4; ++j) {
                const long rowa = (long)mtg * 128 + EPI_M(j);
                const int col = nt * 64 + wn_ * 32 + i * 16 + (lane_ >> 4) * 4;
                float v[4];
#pragma unroll
                for (int r = 0; r < 4; ++r) {
                    float gate = acc[i][j][r] + bg[col + r];
                    float up = acc[i + 2][j][r] + bg[1024 + col + r];
                    gate = fminf(gate, 7.f);
                    up = fminf(fmaxf(up, -7.f), 7.f);
                    v[r] = (up + 1.f) * gate * sigmoidf_(1.702f * gate);
                }
                st_bf4(p.act + rowa * 1024 + col, v[0], v[1], v[2], v[3]);
            }
    }
}
__device__ __forceinline__ void phase_moe_down(const Params& p, int l, unsigned* ctr) {
    const int tid = tid__;
    moe_prefix(p, l);
    const int mtotal = s_misc[32];
    const int mpx = (((mtotal + 7) >> 3) + 7) & ~7;
    XQ q; q.init(ctr, mpx * 8, tid__ == 0);
    for (;;) {
        int it = q.next();
        if (it < 0) break;
        int mtg, nt; xq_decode(it, mpx, 8, mtg, nt);
        if (mtg >= mtotal) continue;
        int e = 0;
        for (int i = 1; i < 32; ++i) e = (s_misc[i] <= mtg) ? i : e;
        const int mt = mtg - s_misc[e], ne = s_misc[40 + e];
        const u16* ap[4]; const u16* bp[4];
#pragma unroll
        for (int i = 0; i < 4; ++i) {
            const int r = (tid >> 3) + 32 * i;
            ap[i] = p.act + ((long)mtg * 128 + r) * 1024;
            bp[i] = p.wt_dn + (((long)l * 32 + e) * 1024 + nt * 128 + r) * 1024;
        }
        f32x4 acc[4][4]; acc_zero(acc);
        gemm_main(acc, ap, bp, 1024, KId());
        EPI_COORDS
        const float* bd = p.b_down + ((long)l * 32 + e) * 1024;
#pragma unroll
        for (int j = 0; j < 4; ++j) {
            const int idx = mt * 128 + EPI_M(j);
            if (idx < ne) {
                const int id = p.ent_id[(long)e * TT + idx];
                const float cw = p.ent_w[(long)e * TT + idx];
#pragma unroll
                for (int i = 0; i < 4; ++i) {
                    const int n = nt * 128 + EPI_N(i);
                    const float4 bb = *(const float4*)(bd + n);
                    st_bf4(p.y4 + (long)id * 1024 + n, cw * (acc[i][j][0] + bb.x), cw * (acc[i][j][1] + bb.y),
                           cw * (acc[i][j][2] + bb.z), cw * (acc[i][j][3] + bb.w));
                }
            }
        }
    }
}

};
#ifndef PH0_EN
#define PH0_EN 1
#endif
__device__ __forceinline__ void run_phase(const Params& p, int ph, int coff, int wv) {
    unsigned* ctr = p.ctr + (ph + coff) * 8;
    Ctx cx;
    {
        int t_ = wv * 64 + (int)__lane_id();
        asm volatile("" : "+v"(t_));
        cx.tid__ = t_;
    }
    if (ph == 0) { if (PH0_EN) cx.phase_prologue(p, ctr); return; }
    const int l = (ph - 1) / NPH_LAYER, s = (ph - 1) % NPH_LAYER;
#ifndef ONLY_S
#define ONLY_S -1
#endif
#ifndef SKIP_S
#define SKIP_S -1
#endif
#define PH_EN(x) ((ONLY_S < 0 || ONLY_S == (x)) && SKIP_S != (x))
    if (PH_EN(0) && s == 0) cx.phase_gemm_in(p, l, ctr);
    if (PH_EN(1) && s == 1) cx.phase_cmp1_sb(p, l, ctr);
    if (PH_EN(2) && s == 2) cx.phase_cmp2(p, l, ctr);
    if (PH_EN(3) && s == 3) cx.phase_nsa(p, ctr);
    if (PH_EN(4) && s == 4) cx.phase_br(p, l, ctr);
    if (PH_EN(5) && s == 5) cx.phase_wo(p, l, ctr);
    if (PH_EN(6) && s == 6) cx.phase_ln(p, l, 1, ctr);
    if (PH_EN(7) && s == 7) cx.phase_router_ple(p, l, ctr);
    if (PH_EN(8) && s == 8) cx.phase_route(p, l, ctr);
    if (PH_EN(9) && s == 9) cx.phase_moe_gu(p, l, ctr);
    if (PH_EN(10) && s == 10) cx.phase_moe_down(p, l, ctr);
    if (PH_EN(11) && s == 11) cx.phase_ln(p, l, 2, ctr);
}

__global__ void __launch_bounds__(256, 2) mega_kernel(Params p, int ph0, int ph1) {
    __shared__ uint4 xb_words;
    const int wv = __builtin_amdgcn_readfirstlane((int)(threadIdx.x >> 6));
    const bool t0 = (threadIdx.x == 0);
    if (t0) xb_words = make_uint4(0u, 0u, 0u, 0u);
    __syncthreads();
    __shared__ Params s_p;
    if (t0) {
        const void* const* src_ = (const void* const*)&p;
        const void** dst_ = (const void**)&s_p;
#pragma unroll
        for (int i = 0; i < (int)(sizeof(Params) / sizeof(void*)); ++i) dst_[i] = src_[i];
    }
    __syncthreads();
    XcdBarrier bar = xcd_barrier_post(p.bar, (volatile LAS unsigned*)&xb_words, t0);
    for (int ph = ph0; ph < ph1; ++ph) {
        const bool t0p = (wv == 0) && (__lane_id() == 0);
        if (ph > ph0) xcd_barrier(bar, t0p);
        asm volatile("" ::: "memory");
        run_phase(s_p, ph, 0, wv);
#if REP_MASK
        if (ph > 0 && ((REP_MASK >> ((ph - 1) % NPH_LAYER)) & 1)) {
            xcd_barrier(bar, t0p);
            asm volatile("" ::: "memory");
            run_phase(s_p, ph, 64, wv);
        }
#endif
    }
}

#ifndef REP_MASK
#define REP_MASK 0
#endif
#ifndef MK_SPLIT
#define MK_SPLIT 0
#endif

extern "C" void kernel_launch(void* const* d_in, const int* in_sizes, int n_in, void* d_out, int out_size, void* d_ws,
                              size_t ws_size, hipStream_t stream) {
    static int grid = 0;
    if (!grid) {
        int dev = 0, cus = 0, per_cu = 0;
        hipGetDevice(&dev);
        hipDeviceGetAttribute(&cus, hipDeviceAttributeMultiprocessorCount, dev);
        hipOccupancyMaxActiveBlocksPerMultiprocessor(&per_cu, mega_kernel, 256, 0);
        if (per_cu < 1) per_cu = 1;
        grid = cus * (per_cu < 2 ? per_cu : 2);
    }
    Params p;
    memset(&p, 0, sizeof(p));
    const float** pin = (const float**)&p;
    for (int i = 0; i < 21; ++i) pin[i] = (const float*)d_in[i];
    p.out = (float*)d_out;
    char* w = (char*)d_ws;
    size_t off = 0;
    auto take = [&](size_t bytes) { char* r = w + off; off += (bytes + 255) & ~(size_t)255; return r; };
    const size_t sync_bytes = (XCD_BAR_WORDS + 1024 + 128) * sizeof(unsigned);
    p.bar = (unsigned*)take(sync_bytes);
    p.ctr = p.bar + XCD_BAR_WORDS;
    p.ecnt = p.ctr + 1024;
    p.wt_in = (u16*)take((size_t)4 * NIN * 1024 * 2);
    p.wt_brs = (u16*)take((size_t)4 * 512 * 1024 * 2);
    p.wt_brn = (u16*)take((size_t)4 * 512 * 1024 * 2);
    p.wt_o = (u16*)take((size_t)4 * 1024 * 1024 * 2);
    p.wt_pg = (u16*)take((size_t)4 * 1024 * 1024 * 2);
    p.wt_pp = (u16*)take((size_t)4 * 256 * 1024 * 2);
    p.wt_gu = (u16*)take((size_t)128 * 2048 * 1024 * 2);
    p.wt_dn = (u16*)take((size_t)128 * 1024 * 1024 * 2);
    p.wt_c1 = (u16*)take((size_t)8 * 128 * 2048 * 2);
    p.wt_c2 = (u16*)take((size_t)8 * 64 * 128 * 2);
    p.wt_r = (u16*)take((size_t)4 * 32 * 3072 * 2);
    p.cbias = (float*)take(1024 * 4);
    p.hf = (float*)take((size_t)TT * 1024 * 4);
    p.pre1 = (float*)take((size_t)TT * 1024 * 4);
    p.h1f = (float*)take((size_t)TT * 1024 * 4);
    p.logits = (float*)take((size_t)TT * 32 * 4);
    p.ynf = (float*)take((size_t)TT * 512 * 4);
    p.ent_w = (float*)take((size_t)32 * TT * 4);
    p.hb = (u16*)take((size_t)TT * 1024 * 2);
    p.pb = (u16*)take((size_t)4 * TT * 256 * 2);
    p.yb = (u16*)take((size_t)TT * NIN * 2);
    p.ysb = (u16*)take((size_t)TT * 512 * 2);
    p.ynsa = (u16*)take((size_t)TT * 512 * 2);
    p.merged = (u16*)take((size_t)TT * 1024 * 2);
    p.h1b = (u16*)take((size_t)TT * 1024 * 2);
    p.h1lo = (u16*)take((size_t)TT * 1024 * 2);
    p.ple = (u16*)take((size_t)TT * 1024 * 2);
    p.hid = (u16*)take((size_t)2 * 2048 * 128 * 2);
    p.kvc = (u16*)take((size_t)2 * 2048 * 64 * 2);
    p.act = (u16*)take((size_t)(TT * 4 + 32 * 128) * 1024 * 2);
    p.y4 = (u16*)take((size_t)TT * 4 * 1024 * 2);
    p.ent_id = (int*)take((size_t)32 * TT * 4);
    if (off > ws_size) { fprintf(stderr, "workspace too small: need %zu have %zu\n", off, ws_size); return; }
    hipMemsetAsync(p.bar, 0, sync_bytes, stream);
#if MK_SPLIT
    for (int ph = 0; ph < NPHASE; ++ph) mega_kernel<<<dim3(grid), dim3(256), 0, stream>>>(p, ph, ph + 1);
#else
    mega_kernel<<<dim3(grid), dim3(256), 0, stream>>>(p, 0, NPHASE);
#endif
}
```
